# Optimizing an MI355X kernel written in HIP

```python
import math
import jax
import jax.numpy as jnp
from jax import lax
import numpy as np

D_MODEL = 1024
BATCH = 16
SEQ = 2048
DEPTH = 2

A_HEADS = 4
A_DIM = 64
B_GROUPS = 4
B_GROUP_DIM = 128
B_CHUNK = 128
C_HEADS = 4
C_DIM = 128
C_IDX_HEADS = 8
C_IDX_DIM = 64
C_TOPK_MAX = 256
MEM_LEN = 256
M_HEADS = 4
M_DIM = 128
P_HEADS = 8
P_QDIM = 256
P_NKEYS = 128
P_EXPERTS = P_NKEYS * P_NKEYS
P_TOPK = 16
P_CHUNK = 128
REL_BUCKETS = 32
REL_MAX_DIST = 128
N_BIAS_HEADS = A_HEADS + C_HEADS
Q_BLOCK = 128
N_BRANCH = 3
EPS = 1e-6
BRANCH_W = 512

SPLITS = (
    A_HEADS * 2 * A_DIM,
    A_HEADS * 2 * A_DIM,
    A_HEADS * 2 * A_DIM,
    B_GROUPS * B_GROUP_DIM,
    B_GROUPS * B_GROUP_DIM,
    C_HEADS * C_DIM,
    C_DIM,
    C_DIM,
    C_IDX_HEADS * C_IDX_DIM,
    C_IDX_DIM,
    C_IDX_HEADS,
    N_BRANCH * D_MODEL,
)
D_IN = sum(SPLITS)
SPLIT_POINTS = tuple(int(v) for v in np.cumsum(SPLITS)[:-1])

kernel_name = "hybrid_diffattn_gmlp_dsa_peer"


def rmsnorm(x, g):
    xf = x.astype(jnp.float32)
    y = xf * lax.rsqrt(jnp.mean(xf * xf, axis=-1, keepdims=True) + EPS)
    return (y * g.astype(jnp.float32)).astype(x.dtype)


def t5_bucket(dist):
    n = jnp.maximum(dist, 0)
    max_exact = REL_BUCKETS // 2
    nf = jnp.maximum(n, 1).astype(jnp.float32)
    large = max_exact + (jnp.log(nf / max_exact) / math.log(REL_MAX_DIST / max_exact)
                         * (REL_BUCKETS - max_exact)).astype(jnp.int32)
    large = jnp.minimum(large, REL_BUCKETS - 1)
    return jnp.where(n < max_exact, n, large)


def diff_attention(qa, ka, va, lam, rel_bias):
    bsz, seq = qa.shape[0], qa.shape[1]
    nb = seq // Q_BLOCK
    scale = A_DIM ** -0.5
    q_blocks = qa.reshape(bsz, nb, Q_BLOCK, A_HEADS, 2, A_DIM).swapaxes(0, 1)
    starts = jnp.arange(nb, dtype=jnp.int32) * Q_BLOCK
    k_pos = jnp.arange(seq, dtype=jnp.int32)

    def block(args):
        qb, start = args
        q_pos = start + jnp.arange(Q_BLOCK, dtype=jnp.int32)
        dist = q_pos[:, None] - k_pos[None, :]
        bias = rel_bias[t5_bucket(dist)][..., :A_HEADS]
        logits = jnp.einsum('bqhmd,bkhmd->bhmqk', qb, ka).astype(jnp.float32) * scale
        logits = logits + jnp.transpose(bias, (2, 0, 1))[None, :, None].astype(jnp.float32)
        logits = jnp.where(dist >= 0, logits, -jnp.inf)
        p = jax.nn.softmax(logits, axis=-1)
        p_diff = (p[:, :, 0] - lam * p[:, :, 1]).astype(va.dtype)
        return jnp.einsum('bhqk,bkhd->bqhd', p_diff, va)

    out = lax.map(block, (q_blocks, starts))
    return out.swapaxes(0, 1).reshape(bsz, seq, A_HEADS, 2 * A_DIM)


def spatial_gating(zu, zv, v_gain, w_s, b_s):
    bsz, seq = zu.shape[0], zu.shape[1]
    nc = seq // B_CHUNK
    u = jax.nn.gelu(zu, approximate=False)
    v = jax.nn.gelu(zv, approximate=False).reshape(bsz, seq, B_GROUPS, B_GROUP_DIM)
    v = rmsnorm(v, v_gain.reshape(B_GROUPS, B_GROUP_DIM))
    v = v.reshape(bsz, nc, B_CHUNK, B_GROUPS, B_GROUP_DIM)
    w = w_s * jnp.tril(jnp.ones((B_CHUNK, B_CHUNK), dtype=w_s.dtype))
    sv = jnp.einsum('gts,bcsgd->bctgd', w, v) + b_s.T[:, :, None]
    return u * sv.reshape(bsz, seq, B_GROUPS * B_GROUP_DIM)


def dsa_attention(cq, ck, cv, iq, ik, iw, rel_bias, k_sel):
    bsz, seq = cq.shape[0], cq.shape[1]
    nb = seq // Q_BLOCK
    scale = C_DIM ** -0.5
    to_blocks = lambda a: a.reshape((bsz, nb, Q_BLOCK) + a.shape[2:]).swapaxes(0, 1)
    starts = jnp.arange(nb, dtype=jnp.int32) * Q_BLOCK
    k_pos = jnp.arange(seq, dtype=jnp.int32)
    gather = jax.vmap(lambda a, i: a[i])

    def block(args):
        qb, iqb, iwb, start = args
        q_pos = start + jnp.arange(Q_BLOCK, dtype=jnp.int32)
        dist = q_pos[:, None] - k_pos[None, :]
        score = jnp.einsum('bqhk,bqh->bqk',
                           jax.nn.relu(jnp.einsum('bqhd,bkd->bqhk', iqb, ik)),
                           iwb).astype(jnp.float32)
        score = jnp.where(dist >= 0, score, -jnp.inf)
        _, sel = lax.top_k(score, k_sel)
        k_g = gather(ck, sel)
        v_g = gather(cv, sel)
        dsel = q_pos[None, :, None] - sel
        bias = rel_bias[t5_bucket(dsel)][..., A_HEADS:]
        logits = jnp.einsum('bqhd,bqkd->bqhk', qb, k_g).astype(jnp.float32) * scale
        logits = logits + jnp.swapaxes(bias, -1, -2).astype(jnp.float32)
        logits = jnp.where(dsel[:, :, None, :] >= 0, logits, -jnp.inf)
        p = jax.nn.softmax(logits, axis=-1).astype(cv.dtype)
        return jnp.einsum('bqhk,bqkd->bqhd', p, v_g)

    out = lax.map(block, (to_blocks(cq), to_blocks(iq), to_blocks(iw), starts))
    return out.swapaxes(0, 1).reshape(bsz, seq, C_HEADS * C_DIM)


def mixer_block(xn, rel_bias, w_in, a_q_gain, a_k_gain, a_lq1, a_lk1, a_lq2, a_lk2,
                a_subln_gain, lam_init, b_v_gain, b_w_s, b_b_s, c_q_gain, c_k_gain,
                w_br_a, w_br_b, w_br_c, w_out):
    bsz, seq, _ = xn.shape
    h = xn @ w_in
    (qa, ka, va, zu, zv, cq, ck, cv, iq, ik, iw, gts) = jnp.split(h, SPLIT_POINTS, axis=-1)
    qa = rmsnorm(qa.reshape(bsz, seq, A_HEADS, 2, A_DIM), a_q_gain)
    ka = rmsnorm(ka.reshape(bsz, seq, A_HEADS, 2, A_DIM), a_k_gain)
    va = va.reshape(bsz, seq, A_HEADS, 2 * A_DIM)
    lam = (jnp.exp(jnp.sum(a_lq1.astype(jnp.float32) * a_lk1.astype(jnp.float32)))
           - jnp.exp(jnp.sum(a_lq2.astype(jnp.float32) * a_lk2.astype(jnp.float32))) + lam_init)
    ya = diff_attention(qa, ka, va, lam, rel_bias)
    ya = (rmsnorm(ya, a_subln_gain) * (1.0 - lam_init)).reshape(bsz, seq, BRANCH_W)
    yb = spatial_gating(zu, zv, b_v_gain, b_w_s, b_b_s)
    k_sel = min(C_TOPK_MAX, seq // 4)
    cq = rmsnorm(cq.reshape(bsz, seq, C_HEADS, C_DIM), c_q_gain)
    ck = rmsnorm(ck, c_k_gain)
    iq = iq.reshape(bsz, seq, C_IDX_HEADS, C_IDX_DIM)
    yc = dsa_attention(cq, ck, cv, iq, ik, iw, rel_bias, k_sel)
    g = jax.nn.sigmoid(gts).reshape(bsz, seq, N_BRANCH, D_MODEL)
    merged = (g[:, :, 0] * (ya @ w_br_a) + g[:, :, 1] * (yb @ w_br_b)
              + g[:, :, 2] * (yc @ w_br_c))
    return merged @ w_out


def memory_xattn(xn, memn, wq, wkv, q_gain, k_gain, wo):
    bsz, seq, _ = xn.shape
    mlen = memn.shape[1]
    q = rmsnorm((xn @ wq).reshape(bsz, seq, M_HEADS, M_DIM), q_gain)
    k, v = jnp.split(memn @ wkv, 2, axis=-1)
    k = rmsnorm(k.reshape(bsz, mlen, M_HEADS, M_DIM), k_gain)
    v = v.reshape(bsz, mlen, M_HEADS, M_DIM)
    logits = jnp.einsum('bqhd,bkhd->bhqk', q, k).astype(jnp.float32) * (M_DIM ** -0.5)
    p = jax.nn.softmax(logits, axis=-1).astype(v.dtype)
    o = jnp.einsum('bhqk,bkhd->bqhd', p, v).reshape(bsz, seq, M_HEADS * M_DIM)
    return o @ wo


def peer(xn, wq, sk1, sk2, u_tab, v_tab):
    bsz, seq, dm = xn.shape
    q = (xn @ wq).reshape(bsz, seq, P_HEADS, 2, P_QDIM // 2)
    s1 = jnp.einsum('bshd,nd->bshn', q[..., 0, :], sk1).astype(jnp.float32)
    s2 = jnp.einsum('bshd,nd->bshn', q[..., 1, :], sk2).astype(jnp.float32)
    v1, i1 = lax.top_k(s1, P_TOPK)
    v2, i2 = lax.top_k(s2, P_TOPK)
    cand = (v1[..., :, None] + v2[..., None, :]).reshape(bsz, seq, P_HEADS, P_TOPK * P_TOPK)
    cs, ci = lax.top_k(cand, P_TOPK)
    e1 = jnp.take_along_axis(i1, ci // P_TOPK, axis=-1)
    e2 = jnp.take_along_axis(i2, ci % P_TOPK, axis=-1)
    expert = e1 * P_NKEYS + e2
    gate = jax.nn.softmax(cs, axis=-1).astype(xn.dtype)
    n_chunk = (bsz * seq) // P_CHUNK
    xc = xn.reshape(n_chunk, P_CHUNK, dm)
    ec = expert.reshape(n_chunk, P_CHUNK, P_HEADS, P_TOPK)
    gc = gate.reshape(n_chunk, P_CHUNK, P_HEADS, P_TOPK)

    def chunk(args):
        xt, et, gt = args
        act = jax.nn.gelu(jnp.einsum('td,thkd->thk', xt, u_tab[et]), approximate=False)
        return jnp.einsum('thk,thkd->td', gt * act, v_tab[et])

    return lax.map(chunk, (xc, ec, gc)).reshape(bsz, seq, dm)


def setup_inputs(seed: int = 0) -> dict:
    key = jax.random.key(seed)
    ks = iter(jax.random.split(key, 48))
    L, D = DEPTH, D_MODEL
    nrm = lambda shape, s: jax.random.normal(next(ks), shape, jnp.float32) * s
    gain = lambda shape: 1.0 + 0.05 * jax.random.normal(next(ks), shape, jnp.float32)
    return {
        "x": nrm((BATCH, SEQ, D), 1.0),
        "mem": nrm((BATCH, MEM_LEN, D), 1.0),
        "rel_bias": nrm((REL_BUCKETS, N_BIAS_HEADS), 0.5),
        "norm_mix": gain((L, D)),
        "w_in": nrm((L, D, D_IN), D ** -0.5),
        "a_q_gain": gain((L, A_DIM)),
        "a_k_gain": gain((L, A_DIM)),
        "a_lq1": nrm((L, A_DIM), 0.1),
        "a_lk1": nrm((L, A_DIM), 0.1),
        "a_lq2": nrm((L, A_DIM), 0.1),
        "a_lk2": nrm((L, A_DIM), 0.1),
        "a_subln_gain": gain((L, 2 * A_DIM)),
        "b_v_gain": gain((L, B_GROUPS * B_GROUP_DIM)),
        "b_w_s": nrm((L, B_GROUPS, B_CHUNK, B_CHUNK), 0.5 * B_CHUNK ** -0.5),
        "b_b_s": 1.0 + nrm((L, B_GROUPS, B_CHUNK), 0.1),
        "c_q_gain": gain((L, C_DIM)),
        "c_k_gain": gain((L, C_DIM)),
        "w_br_a": nrm((L, BRANCH_W, D), BRANCH_W ** -0.5),
        "w_br_b": nrm((L, BRANCH_W, D), BRANCH_W ** -0.5),
        "w_br_c": nrm((L, BRANCH_W, D), BRANCH_W ** -0.5),
        "w_mix_out": nrm((L, D, D), D ** -0.5),
        "norm_mem": gain((L, D)),
        "norm_memsrc": gain((L, D)),
        "m_wq": nrm((L, D, M_HEADS * M_DIM), D ** -0.5),
        "m_wkv": nrm((L, D, 2 * M_HEADS * M_DIM), D ** -0.5),
        "m_q_gain": gain((L, M_DIM)),
        "m_k_gain": gain((L, M_DIM)),
        "m_wo": nrm((L, M_HEADS * M_DIM, D), (M_HEADS * M_DIM) ** -0.5),
        "norm_peer": gain((L, D)),
        "p_wq": nrm((L, D, P_HEADS * P_QDIM), D ** -0.5),
        "p_subkey1": nrm((L, P_NKEYS, P_QDIM // 2), (P_QDIM // 2) ** -0.5),
        "p_subkey2": nrm((L, P_NKEYS, P_QDIM // 2), (P_QDIM // 2) ** -0.5),
        "p_u": nrm((L, P_EXPERTS, D), D ** -0.5),
        "p_v": nrm((L, P_EXPERTS, D), P_HEADS ** -0.5),
    }


def reference(x, mem, rel_bias, norm_mix, w_in, a_q_gain, a_k_gain, a_lq1, a_lk1, a_lq2,
              a_lk2, a_subln_gain, b_v_gain, b_w_s, b_b_s, c_q_gain, c_k_gain, w_br_a,
              w_br_b, w_br_c, w_mix_out, norm_mem, norm_memsrc, m_wq, m_wkv, m_q_gain,
              m_k_gain, m_wo, norm_peer, p_wq, p_subkey1, p_subkey2, p_u, p_v):
    for l in range(DEPTH):
        lam_init = 0.8 - 0.6 * math.exp(-0.3 * l)
        x = x + mixer_block(rmsnorm(x, norm_mix[l]), rel_bias, w_in[l], a_q_gain[l],
                            a_k_gain[l], a_lq1[l], a_lk1[l], a_lq2[l], a_lk2[l],
                            a_subln_gain[l], lam_init, b_v_gain[l], b_w_s[l], b_b_s[l],
                            c_q_gain[l], c_k_gain[l], w_br_a[l], w_br_b[l], w_br_c[l],
                            w_mix_out[l])
        x = x + memory_xattn(rmsnorm(x, norm_mem[l]), rmsnorm(mem, norm_memsrc[l]), m_wq[l],
                             m_wkv[l], m_q_gain[l], m_k_gain[l], m_wo[l])
        x = x + peer(rmsnorm(x, norm_peer[l]), p_wq[l], p_subkey1[l], p_subkey2[l],
                     p_u[l], p_v[l])
    return x
```

```cpp
#define MK_MULTI 1
#include <hip/hip_runtime.h>
#include <cstdio>
#include <cstdint>
#define XB_TMO      128
#define XB_XCNT(j)  (256  + 64 * (j))
#define XB_XSUB(j)  (1280 + 64 * (j))
#define XB_XGEN(j)  (2304 + 64 * (j))
#define XB_TOP      3328
#define XB_TOPGEN   3392
#define XCD_BAR_WORDS 3456
#define XB_SPIN_CAP (1u << 18)
#define LAS __attribute__((address_space(3)))

__device__ __forceinline__ unsigned xb_ld(unsigned* p)              { return __hip_atomic_load(p, __ATOMIC_RELAXED, __HIP_MEMORY_SCOPE_AGENT); }
__device__ __forceinline__ unsigned xb_add(unsigned* p, unsigned v) { return __hip_atomic_fetch_add(p, v, __ATOMIC_RELAXED, __HIP_MEMORY_SCOPE_AGENT); }
__device__ __forceinline__ unsigned xb_xcc_id() { return (unsigned)__builtin_amdgcn_s_getreg((3 << 11) | 20) & 0xFu; }
#define XB_SPIN(cond, bar) do { unsigned _sp = 0; while (cond) { __builtin_amdgcn_s_sleep(1); \
    if ((++_sp & 255u) == 0u) { if (xb_ld(&(bar)[XB_TMO])) break; if (_sp > XB_SPIN_CAP) { atomicAdd(&(bar)[XB_TMO], 1u); break; } } } } while (0)

struct XcdBarrier {
    unsigned* bar; unsigned x;
    volatile LAS unsigned* st;
};

__device__ __forceinline__ XcdBarrier xcd_barrier_post(unsigned* bar, volatile LAS unsigned* st) {
    XcdBarrier b; b.bar = bar; b.x = xb_xcc_id(); b.st = st;
    if (threadIdx.x == 0) (void)xb_add(&bar[XB_XCNT(b.x)], 1u);
    return b;
}
__device__ __forceinline__ void xcd_barrier_complete(unsigned* bar, unsigned x, unsigned& nloc, unsigned& nx) {
    const unsigned G = gridDim.x * gridDim.y * gridDim.z;
    unsigned sum, cnt, mine, sp = 0u;
    for (;;) {
        sum = 0u; cnt = 0u; mine = 0u;
#pragma unroll
        for (unsigned j = 0; j < 16; ++j) { const unsigned c = xb_ld(&bar[XB_XCNT(j)]); sum += c; cnt += (c > 0u) ? 1u : 0u; mine = (j == x) ? c : mine; }
        if (sum == G) break;
        __builtin_amdgcn_s_sleep(1);
        if ((++sp & 255u) == 0u) { if (xb_ld(&bar[XB_TMO])) break; if (sp > XB_SPIN_CAP) { atomicAdd(&bar[XB_TMO], 1u); break; } }
    }
    nloc = mine > 0u ? mine : 1u; nx = cnt > 0u ? cnt : 1u;
}

__device__ __forceinline__ void xcd_barrier(const XcdBarrier& b) {
    asm volatile("s_waitcnt vmcnt(0)" ::: "memory");
    __syncthreads();
    if (threadIdx.x == 0) {
        unsigned* bar = b.bar;
        __builtin_amdgcn_s_waitcnt(0);
        unsigned nloc = b.st[0], nx = b.st[1];
        if (nloc == 0u) { xcd_barrier_complete(bar, b.x, nloc, nx); b.st[0] = nloc; b.st[1] = nx; }
        const unsigned old = xb_add(&bar[XB_XSUB(b.x)], 1u);
        const unsigned gen = old / nloc;
        if (old + 1u == (gen + 1u) * nloc) {
            __builtin_amdgcn_fence(__ATOMIC_RELEASE, "agent");
            asm volatile("s_waitcnt vmcnt(0)" ::: "memory");
            const unsigned og = xb_add(&bar[XB_TOP], 1u);
            const unsigned tg = og / nx;
            if (og + 1u == (tg + 1u) * nx) xb_add(&bar[XB_TOPGEN], 1u);
            else XB_SPIN(xb_ld(&bar[XB_TOPGEN]) == tg, bar);
            __builtin_amdgcn_fence(__ATOMIC_ACQUIRE, "agent");
            xb_add(&bar[XB_XGEN(b.x)], 1u);
            asm volatile("s_waitcnt vmcnt(0)" ::: "memory");
        } else {
            XB_SPIN(xb_ld(&bar[XB_XGEN(b.x)]) == gen, bar);
            __builtin_amdgcn_fence(__ATOMIC_ACQUIRE, "agent");
            asm volatile("s_waitcnt vmcnt(0)" ::: "memory");
        }
    }
    __syncthreads();
}
namespace pg8 {
#define PG8_LAS __attribute__((address_space(3)))
typedef unsigned short bf16_t;
typedef short bf16x8 __attribute__((ext_vector_type(8)));
typedef float f32x4 __attribute__((ext_vector_type(4)));
typedef unsigned u32x4 __attribute__((ext_vector_type(4)));
constexpr int BM = 256, BK = 64, HALF = 128, HTB = HALF * BK * 2  , STAGE_BYTES = 8 * HTB, NXCD = 8, WGM = 8;

__host__ __device__ __forceinline__ int lds_byte(int r, int c) { const int st = (r >> 4) * 2 + (c >> 5), rr = r & 15, cc = c & 31, ob = rr * 64 + cc * 2; return st * 1024 + (ob ^ (((ob >> 9) & 1) << 5)); }
__host__ __device__ __forceinline__ void stage_rc(int b, int& R, int& C) { const int st = b / 1024, sb = b % 1024, swz = sb ^ (((sb >> 9) & 1) << 5); R = (st >> 1) * 16 + swz / 64; C = (st & 1) * 32 + (swz % 64) / 2; }
__host__ __device__ __forceinline__ int perm32(int rho) { const int n = rho >> 4, i = rho & 15; return 8 * (i >> 2) + 4 * n + (i & 3); }

struct Unit { int pm, pn; };
struct Gemm { const bf16_t* A; const bf16_t* Bt; int M, N, K; };
struct StaticOrder {
    int nM, nN, nwg, G, c;
    __host__ __device__ void init(int M, int N, int G_, int c_) { nM = M / BM; nN = N / BM; nwg = nM * nN; G = G_; c = c_; }
    __host__ __device__ bool next(int i, Unit& u) const {
        const long L = (long)i * G + c; if (L >= nwg) return false;
        int wgid = (int)L; { const int q = nwg / NXCD, r = nwg % NXCD, xcd = wgid % NXCD, off = wgid / NXCD; wgid = (xcd < r ? xcd * (q + 1) : r * (q + 1) + (xcd - r) * q) + off; }
        const int nig = WGM * nN, gid = wgid / nig, fm = gid * WGM, gsz = (nM - fm) < WGM ? (nM - fm) : WGM;
        u.pm = fm + ((wgid % nig) % gsz); u.pn = (wgid % nig) / gsz; return true;
    }
    __device__ __forceinline__ void a_ready(const Unit&) const {}
    __device__ __forceinline__ void done(const Unit&) const {}
};
__device__ __forceinline__ unsigned cvt_pk_bf16(float lo, float hi) { unsigned r; asm volatile("v_cvt_pk_bf16_f32 %0, %1, %2" : "=v"(r) : "v"(lo), "v"(hi)); return r; }
typedef float f32x2 __attribute__((ext_vector_type(2)));
__device__ __forceinline__ f32x2 gelu_pk(f32x2 v) {
    const f32x2 av = __builtin_elementwise_abs(v), d = av * 0.2316418882f + 1.0f;
    f32x2 t; t.x = __builtin_amdgcn_rcpf(d.x); t.y = __builtin_amdgcn_rcpf(d.y);
    f32x2 q = t * 0.5307027145f + (-0.7265760135f); q = q * t + 0.7107068705f; q = q * t + (-0.142248368f); q = q * t + 0.127414796f; q = q * t;
    const f32x2 s = (v * v) * (-0.72134752044f);
    f32x2 e; e.x = __builtin_amdgcn_exp2f(s.x); e.y = __builtin_amdgcn_exp2f(s.y);
    const f32x2 m = v * (q * e), r = v - m;
    f32x2 o; o.x = v.x < 0.f ? m.x : r.x; o.y = v.y < 0.f ? m.y : r.y; return o;
}

template <class Epi, class Sched, bool STAMP = false>
__device__ __forceinline__ void gemm_phase(PG8_LAS unsigned char* lds, const Gemm g, const Sched& S, const Epi& E, unsigned long long* stamps) {
    int tid_l = threadIdx.x; asm volatile("" : "+v"(tid_l)); const int tid = tid_l, wid = __builtin_amdgcn_readfirstlane(tid >> 6), lane = tid & 63, wr = wid >> 2, wc = wid & 3, fr = lane & 15, fq = lane >> 4;
    const int K = g.K, nt = K / BK;
    int ts_lo = 0, ts_hi = 0, nts = 0; const unsigned long long rt_entry = STAMP ? (unsigned long long)wall_clock64() : 0ull;
#define PG8_STAMP() do { if (STAMP && wid == 0 && nts < 64) { const unsigned long long _c = (unsigned long long)clock64(); \
        ts_lo = (lane == nts) ? (int)(unsigned)_c : ts_lo; ts_hi = (lane == nts) ? (int)(unsigned)(_c >> 32) : ts_hi; ++nts; } } while (0)
    PG8_STAMP();
    unsigned voffA[2], voffB[2];
#pragma unroll
    for (int i = 0; i < 2; ++i) { int R, C; stage_rc(tid * 16 + i * 8192, R, C); const int Rb = Epi::PERM ? ((R & ~31) + perm32(R & 31)) : R;
        voffA[i] = (unsigned)(R * K + C) * 2u; voffB[i] = (unsigned)(Rb * K + C) * 2u; }
    const size_t kstep = (size_t)(BK * 2);
    const size_t hstep = (size_t)HALF * K * 2;
    const size_t tstep = 2 * hstep;
    const unsigned ldsw = (unsigned)wid * 1024u;
    const int aoff = lds_byte(wr * 64 + fr, fq * 8), boff = lds_byte(wc * 32 + fr, fq * 8);
#define PG8_SA(b, h) (((b) * 2 + (h)) * HTB)
#define PG8_SB(b, h) ((4 + (b) * 2 + (h)) * HTB)
#define PG8_STAGE(bufoff, gbase, voff) do { _Pragma("unroll") for (int _i = 0; _i < 2; ++_i) \
        __builtin_amdgcn_global_load_lds((const unsigned*)((const char*)(gbase) + (voff)[_i]), (PG8_LAS unsigned*)(lds + (bufoff) + ldsw + _i * 8192), 16, 0, 0); } while (0)
#define PG8_LDA(dst, b, h) do { _Pragma("unroll") for (int m = 0; m < 4; ++m) _Pragma("unroll") for (int k = 0; k < 2; ++k) dst[m][k] = *(const PG8_LAS bf16x8*)(lds + PG8_SA(b, h) + aoff + m * 2048 + k * 1024); } while (0)
#define PG8_LDB(dst, b, h) do { _Pragma("unroll") for (int n = 0; n < 2; ++n) _Pragma("unroll") for (int k = 0; k < 2; ++k) dst[n][k] = *(const PG8_LAS bf16x8*)(lds + PG8_SB(b, h) + boff + n * 2048 + k * 1024); } while (0)
#define PG8_MMA(ai, bj, At, Bt) do { __builtin_amdgcn_s_setprio(1); _Pragma("unroll") for (int m = 0; m < 4; ++m) _Pragma("unroll") for (int n = 0; n < 2; ++n) _Pragma("unroll") for (int k = 0; k < 2; ++k) \
        acc[ai][bj][m][n] = __builtin_amdgcn_mfma_f32_16x16x32_bf16(Bt[n][k], At[m][k], acc[ai][bj][m][n], 0, 0, 0); __builtin_amdgcn_s_setprio(0); } while (0)
#define PG8_WAIT_V(n) asm volatile("s_waitcnt vmcnt(" #n ")" ::: "memory")
#define PG8_WAIT_L(n) asm volatile("s_waitcnt lgkmcnt(" #n ")" ::: "memory")
#define PG8_BAR __builtin_amdgcn_s_barrier()
#define PG8_SCHED __builtin_amdgcn_sched_barrier(0)
    Unit cur, nxt; int ui = 0;
    if (!S.next(0, cur)) return;
    f32x4 acc[2][2][4][2];
#pragma unroll
    for (int a = 0; a < 2; ++a)
#pragma unroll
        for (int b = 0; b < 2; ++b)
#pragma unroll
            for (int m = 0; m < 4; ++m)
#pragma unroll
                for (int n = 0; n < 2; ++n) acc[a][b][m][n] = (f32x4){0.f, 0.f, 0.f, 0.f};
    bf16x8 At[4][2], B0[2][2], B1[2][2];
    const char* cA = (const char*)g.A + (size_t)cur.pm * tstep; const char* cB = (const char*)g.Bt + (size_t)cur.pn * tstep;
    S.a_ready(cur);
    PG8_STAGE(PG8_SB(0, 0), cB, voffB); PG8_STAGE(PG8_SA(0, 0), cA, voffA); PG8_STAGE(PG8_SB(0, 1), cB + hstep, voffB); PG8_STAGE(PG8_SA(0, 1), cA + hstep, voffA);
    if (wr == 1) PG8_BAR;
    PG8_WAIT_V(4); PG8_BAR;
    PG8_STAGE(PG8_SB(1, 0), cB + kstep, voffB); PG8_STAGE(PG8_SA(1, 0), cA + kstep, voffA); PG8_STAGE(PG8_SB(1, 1), cB + hstep + kstep, voffB);
    PG8_WAIT_V(6); PG8_BAR;
    PG8_STAMP();
    for (;;) {
        const bool has_next = S.next(ui + 1, nxt);
        const char* nA = has_next ? (const char*)g.A + (size_t)nxt.pm * tstep : cA; const char* nB = has_next ? (const char*)g.Bt + (size_t)nxt.pn * tstep : cB;
        for (int t = 0; t < nt; t += 2) {
            const bool last = (t == nt - 2);
            const char* a1 = cA + (size_t)(t + 1) * kstep;
            const char* a2 = last ? nA : cA + (size_t)(t + 2) * kstep; const char* b2 = last ? nB : cB + (size_t)(t + 2) * kstep;
            const char* a3 = a2 + kstep; const char* b3 = b2 + kstep;
            if (last && has_next) S.a_ready(nxt);
            PG8_LDB(B0, 0, 0); PG8_SCHED; PG8_LDA(At, 0, 0); PG8_STAGE(PG8_SA(1, 1), a1 + hstep, voffA);
            PG8_WAIT_L(8); PG8_BAR; PG8_WAIT_L(0); PG8_MMA(0, 0, At, B0); PG8_BAR; PG8_SCHED;
            PG8_LDB(B1, 0, 1); PG8_STAGE(PG8_SB(0, 0), b2, voffB);
            PG8_BAR; PG8_WAIT_L(0); PG8_MMA(0, 1, At, B1); PG8_BAR;
            PG8_LDA(At, 0, 1); PG8_STAGE(PG8_SA(0, 0), a2, voffA);
            PG8_BAR; PG8_WAIT_L(0); PG8_MMA(1, 0, At, B0); PG8_BAR; PG8_SCHED;
            PG8_STAGE(PG8_SB(0, 1), b2 + hstep, voffB);
            PG8_WAIT_V(6); PG8_BAR; PG8_MMA(1, 1, At, B1); PG8_BAR;
            PG8_LDB(B0, 1, 0); PG8_SCHED; PG8_LDA(At, 1, 0); PG8_STAGE(PG8_SA(0, 1), a2 + hstep, voffA);
            PG8_WAIT_L(8); PG8_BAR; PG8_WAIT_L(0); PG8_MMA(0, 0, At, B0); PG8_BAR; PG8_SCHED;
            PG8_LDB(B1, 1, 1); PG8_STAGE(PG8_SB(1, 0), b3, voffB);
            PG8_BAR; PG8_WAIT_L(0); PG8_MMA(0, 1, At, B1); PG8_BAR;
            PG8_LDA(At, 1, 1); PG8_STAGE(PG8_SA(1, 0), a3, voffA);
            PG8_BAR; PG8_WAIT_L(0); PG8_MMA(1, 0, At, B0); PG8_BAR; PG8_SCHED;
            PG8_STAGE(PG8_SB(1, 1), b3 + hstep, voffB);
            PG8_WAIT_V(6); PG8_BAR; PG8_MMA(1, 1, At, B1); PG8_BAR;
        }
        PG8_STAMP();
        if constexpr (!Epi::AFTER_DRAIN) { E(acc, cur, wr, wc, fr, fq); S.done(cur); }
        PG8_STAMP();
        if (!has_next) break;
#pragma unroll
        for (int a = 0; a < 2; ++a)
#pragma unroll
            for (int b = 0; b < 2; ++b)
#pragma unroll
                for (int m = 0; m < 4; ++m)
#pragma unroll
                    for (int n = 0; n < 2; ++n) acc[a][b][m][n] = (f32x4){0.f, 0.f, 0.f, 0.f};
        cur = nxt; cA = nA; cB = nB; ++ui;
    }
    PG8_WAIT_V(0);
    if (wr == 0) PG8_BAR;
    PG8_BAR;
    if constexpr (Epi::AFTER_DRAIN) { E.fused(acc, cur, wr, wc, fr, fq, lds, wid, lane); S.done(cur); }
    PG8_STAMP();
    if (STAMP && wid == 0) { stamps[lane] = lane < nts ? (((unsigned long long)(unsigned)ts_hi << 32) | (unsigned)ts_lo) : 0ull;
        if (lane == 62) stamps[62] = rt_entry; if (lane == 63) stamps[63] = (unsigned long long)wall_clock64(); }
#undef PG8_STAMP
#undef PG8_SA
#undef PG8_SB
#undef PG8_STAGE
#undef PG8_LDA
#undef PG8_LDB
#undef PG8_MMA
#undef PG8_WAIT_V
#undef PG8_WAIT_L
#undef PG8_BAR
#undef PG8_SCHED
}
}

using pg8::bf16_t; using pg8::bf16x8; using pg8::f32x4; using pg8::u32x4;
typedef unsigned u32x2 __attribute__((ext_vector_type(2)));
typedef __bf16 bf16x2v __attribute__((ext_vector_type(2)));
__device__ __forceinline__ unsigned cvt_pk_bf16(float lo, float hi) { bf16x2v v; v.x = (__bf16)lo; v.y = (__bf16)hi; return __builtin_bit_cast(unsigned, v); }
#define NEG_INF (-__builtin_inff())
constexpr int T_TOK = 32768, DM = 1024, SEQ = 2048, NB = 16, MEMLEN = 256;
constexpr int HN = 3328;
constexpr int HC_QA = 0, HC_KA = 512, HC_ZU = 1024, HC_ZV = 1536, HC_CQ = 2048, HC_IQ = 2560, HC_CK = 3072, HC_IK = 3200, HC_IW = 3264;
constexpr int DIN = 6984;
constexpr float EPSF = 1e-6f, LOG2E = 1.4426950408889634f;
constexpr size_t MiB = 1048576;
constexpr size_t WS_CTL = 0, CTL_BTAB = 65536, CTL_LAM = 73728;
constexpr size_t WS_WB = 1 * MiB;
constexpr size_t WB_WIN = 0, WB_WV = 6815744, WB_WG = 8 * MiB, WB_BRA = 14 * MiB, WB_BRB = 15 * MiB, WB_BRC = 16 * MiB, WB_OUT = 17 * MiB,
                 WB_MQ = 19 * MiB, WB_MK = 20 * MiB, WB_MV = 21 * MiB, WB_MO = 22 * MiB, WB_PS = 23 * MiB;
constexpr size_t WS_MEMN = 29 * MiB, WS_MK = 37 * MiB, WS_MVT = 41 * MiB, WS_MASK = 45 * MiB, WS_XN = 53 * MiB, WS_R = 117 * MiB;
constexpr size_t R_H = 0, R_VT = 208 * MiB, R_G = 0, R_MERGED = 192 * MiB, R_PS = 0;
constexpr size_t WS_YA = 373 * MiB, WS_YB = 405 * MiB, WS_YC = 437 * MiB, WS_END = 469 * MiB;
constexpr int LDS_TOTAL = 163840, LDS_BAR_OFF = 163840 - 16;

struct Params { const float* in[34]; float* out; unsigned char* ws; int ph_lo, ph_hi; };
enum { I_X = 0, I_MEM, I_RELB, I_NORM_MIX, I_W_IN, I_AQG, I_AKG, I_LQ1, I_LK1, I_LQ2, I_LK2, I_SUBLN, I_BVG, I_BWS, I_BBS, I_CQG, I_CKG, I_WBRA, I_WBRB, I_WBRC,
       I_WOUT, I_NORM_MEM, I_NORM_MEMSRC, I_MWQ, I_MWKV, I_MQG, I_MKG, I_MWO, I_NORM_PEER, I_PWQ, I_SK1, I_SK2, I_PU, I_PV };

__device__ __forceinline__ int fresh_tid() { int t = threadIdx.x; asm volatile("" : "+v"(t)); return t; }
__device__ __forceinline__ int fresh_bid() { int b = blockIdx.x; asm volatile("" : "+s"(b)); return b; }
__device__ __forceinline__ float bf_lo(unsigned w) { return __uint_as_float(w << 16); }
__device__ __forceinline__ float bf_hi(unsigned w) { return __uint_as_float(w & 0xffff0000u); }
__device__ __forceinline__ float bf2f(bf16_t b) { return __uint_as_float(((unsigned)b) << 16); }
__device__ __forceinline__ bf16_t f2bf(float f) { return (bf16_t)(cvt_pk_bf16(f, 0.f) & 0xffffu); }
__device__ __forceinline__ float wave_sum(float v) { v += __shfl_xor(v, 32); v += __shfl_xor(v, 16); v += __shfl_xor(v, 8); v += __shfl_xor(v, 4); v += __shfl_xor(v, 2); v += __shfl_xor(v, 1); return v; }
__device__ __forceinline__ float gelu1(float x) { pg8::f32x2 v; v.x = x; v.y = 0.f; return pg8::gelu_pk(v).x; }
__device__ __forceinline__ unsigned ukey(float f) { const unsigned b = __float_as_uint(f); return (b & 0x80000000u) ? ~b : (b | 0x80000000u); }

typedef f32x4 AccT[2][2][4][2];
struct EpiStore {
    static constexpr bool PERM = true, AFTER_DRAIN = false;
    bf16_t* O; int ldc;
    __device__ __forceinline__ void operator()(const f32x4 (&acc)[2][2][4][2], const pg8::Unit& u, int wr, int wc, int fr, int fq) const {
        const int row0 = u.pm * 256 + wr * 64 + fr, col0 = u.pn * 256 + wc * 32 + 8 * fq;
#pragma unroll
        for (int ai = 0; ai < 2; ++ai)
#pragma unroll
            for (int m = 0; m < 4; ++m) { bf16_t* rowp = O + (size_t)(row0 + ai * 128 + m * 16) * ldc + col0;
#pragma unroll
                for (int bj = 0; bj < 2; ++bj) { const f32x4 v0 = acc[ai][bj][m][0], v1 = acc[ai][bj][m][1];
                    u32x4 w; w.x = cvt_pk_bf16(v0[0], v0[1]); w.y = cvt_pk_bf16(v0[2], v0[3]); w.z = cvt_pk_bf16(v1[0], v1[1]); w.w = cvt_pk_bf16(v1[2], v1[3]);
                    *(u32x4*)(rowp + bj * 128) = w; } }
    }
};
struct EpiSigmoid {
    static constexpr bool PERM = true, AFTER_DRAIN = false;
    bf16_t* O; int ldc;
    __device__ __forceinline__ void operator()(const f32x4 (&acc)[2][2][4][2], const pg8::Unit& u, int wr, int wc, int fr, int fq) const {
        const int row0 = u.pm * 256 + wr * 64 + fr, col0 = u.pn * 256 + wc * 32 + 8 * fq;
#pragma unroll
        for (int ai = 0; ai < 2; ++ai)
#pragma unroll
            for (int m = 0; m < 4; ++m) { bf16_t* rowp = O + (size_t)(row0 + ai * 128 + m * 16) * ldc + col0;
#pragma unroll
                for (int bj = 0; bj < 2; ++bj) { f32x4 v0 = acc[ai][bj][m][0], v1 = acc[ai][bj][m][1];
#pragma unroll
                    for (int j = 0; j < 4; ++j) { v0[j] = __builtin_amdgcn_rcpf(1.0f + __builtin_amdgcn_exp2f(-LOG2E * v0[j])); v1[j] = __builtin_amdgcn_rcpf(1.0f + __builtin_amdgcn_exp2f(-LOG2E * v1[j])); }
                    u32x4 w; w.x = cvt_pk_bf16(v0[0], v0[1]); w.y = cvt_pk_bf16(v0[2], v0[3]); w.z = cvt_pk_bf16(v1[0], v1[1]); w.w = cvt_pk_bf16(v1[2], v1[3]);
                    *(u32x4*)(rowp + bj * 128) = w; } }
    }
};
struct EpiBranch {
    static constexpr bool PERM = true, AFTER_DRAIN = false;
    bf16_t* Mg; const bf16_t* G; int br; int first;
    __device__ __forceinline__ void operator()(const f32x4 (&acc)[2][2][4][2], const pg8::Unit& u, int wr, int wc, int fr, int fq) const {
        const int row0 = u.pm * 256 + wr * 64 + fr, col0 = u.pn * 256 + wc * 32 + 8 * fq;
#pragma unroll
        for (int ai = 0; ai < 2; ++ai)
#pragma unroll
            for (int m = 0; m < 4; ++m) { const size_t row = (size_t)(row0 + ai * 128 + m * 16);
#pragma unroll
                for (int bj = 0; bj < 2; ++bj) { const f32x4 v0 = acc[ai][bj][m][0], v1 = acc[ai][bj][m][1];
                    const u32x4 g = *(const u32x4*)(G + row * 3072 + br * 1024 + col0 + bj * 128);
                    u32x4 p; p.x = 0u; p.y = 0u; p.z = 0u; p.w = 0u;
                    if (!first) p = *(const u32x4*)(Mg + row * 1024 + col0 + bj * 128);
                    u32x4 w;
                    w.x = cvt_pk_bf16(bf_lo(p.x) + bf_lo(g.x) * v0[0], bf_hi(p.x) + bf_hi(g.x) * v0[1]);
                    w.y = cvt_pk_bf16(bf_lo(p.y) + bf_lo(g.y) * v0[2], bf_hi(p.y) + bf_hi(g.y) * v0[3]);
                    w.z = cvt_pk_bf16(bf_lo(p.z) + bf_lo(g.z) * v1[0], bf_hi(p.z) + bf_hi(g.z) * v1[1]);
                    w.w = cvt_pk_bf16(bf_lo(p.w) + bf_lo(g.w) * v1[2], bf_hi(p.w) + bf_hi(g.w) * v1[3]);
                    *(u32x4*)(Mg + row * 1024 + col0 + bj * 128) = w; } }
    }
};
struct EpiResid {
    static constexpr bool PERM = false, AFTER_DRAIN = false;
    const float* base; float* out; int ldc;
    __device__ __forceinline__ void operator()(const f32x4 (&acc)[2][2][4][2], const pg8::Unit& u, int wr, int wc, int fr, int fq) const {
        const int row0 = u.pm * 256 + wr * 64 + fr, col0 = u.pn * 256 + wc * 32 + 4 * fq;
#pragma unroll
        for (int ai = 0; ai < 2; ++ai)
#pragma unroll
            for (int m = 0; m < 4; ++m) { const size_t off = (size_t)(row0 + ai * 128 + m * 16) * ldc + col0;
#pragma unroll
                for (int bj = 0; bj < 2; ++bj)
#pragma unroll
                    for (int n = 0; n < 2; ++n) { const f32x4 b = *(const f32x4*)(base + off + bj * 128 + n * 16); *(f32x4*)(out + off + bj * 128 + n * 16) = b + acc[ai][bj][m][n]; } }
    }
};
struct EpiF32Store {
    static constexpr bool PERM = false, AFTER_DRAIN = false;
    float* C; int ldc;
    __device__ __forceinline__ void operator()(const f32x4 (&acc)[2][2][4][2], const pg8::Unit& u, int wr, int wc, int fr, int fq) const {
        const int row0 = u.pm * 256 + wr * 64 + fr, col0 = u.pn * 256 + wc * 32 + 4 * fq;
#pragma unroll
        for (int ai = 0; ai < 2; ++ai)
#pragma unroll
            for (int m = 0; m < 4; ++m) { const size_t off = (size_t)(row0 + ai * 128 + m * 16) * ldc + col0;
#pragma unroll
                for (int bj = 0; bj < 2; ++bj)
#pragma unroll
                    for (int n = 0; n < 2; ++n) *(f32x4*)(C + off + bj * 128 + n * 16) = acc[ai][bj][m][n]; }
    }
};
template <class Epi>
__device__ __forceinline__ void run_gemm(LAS unsigned char* lds, const bf16_t* A, const bf16_t* Bt, int M, int N, int K, int cshift, const Epi& E) {
    pg8::Gemm g{A, Bt, M, N, K}; pg8::StaticOrder S; S.init(M, N, (int)gridDim.x, (int)((blockIdx.x + cshift) % gridDim.x));
    pg8::gemm_phase<Epi, pg8::StaticOrder, false>(lds, g, S, E, nullptr);
    __syncthreads();
}

__device__ __forceinline__ void conv_transpose(LAS unsigned char* lds, const float* src, int ld_src, int col0, int ncols, bf16_t* dst, int K, int nrows) {
    LAS float* tl = (LAS float*)lds;
    const int tid = fresh_tid(), ntk = K / 64, ntiles = (nrows / 64) * ntk;
    for (int tile = blockIdx.x; tile < ntiles; tile += gridDim.x) {
        const int n0 = (tile / ntk) * 64, k0 = (tile % ntk) * 64;
#pragma unroll
        for (int p = 0; p < 2; ++p) { const int kk = (tid >> 4) + 32 * p, n4 = (tid & 15) * 4;
            f32x4 v = (f32x4){0.f, 0.f, 0.f, 0.f};
            if (n0 + n4 < ncols) v = *(const f32x4*)(src + (size_t)(k0 + kk) * ld_src + col0 + n0 + n4);
            tl[kk * 65 + n4 + 0] = v[0]; tl[kk * 65 + n4 + 1] = v[1]; tl[kk * 65 + n4 + 2] = v[2]; tl[kk * 65 + n4 + 3] = v[3]; }
        __syncthreads();
        { const int n = tid >> 3, kc = (tid & 7) * 8; float f[8];
#pragma unroll
            for (int j = 0; j < 8; ++j) f[j] = tl[(kc + j) * 65 + n];
            u32x4 w; w.x = cvt_pk_bf16(f[0], f[1]); w.y = cvt_pk_bf16(f[2], f[3]); w.z = cvt_pk_bf16(f[4], f[5]); w.w = cvt_pk_bf16(f[6], f[7]);
            *(u32x4*)(dst + (size_t)(n0 + n) * K + k0 + kc) = w; }
        __syncthreads();
    }
}
__device__ __forceinline__ void rmsnorm_rows(const float* x, const float* g, bf16_t* out, int rows) {
    const int tid = fresh_tid(); const int lane = tid & 63, gw = blockIdx.x * 8 + (tid >> 6), nw = gridDim.x * 8;
    f32x4 gv[4];
#pragma unroll
    for (int i = 0; i < 4; ++i) gv[i] = *(const f32x4*)(g + 4 * lane + 256 * i);
    for (int r = gw; r < rows; r += nw) {
        f32x4 v[4]; float ss = 0.f;
#pragma unroll
        for (int i = 0; i < 4; ++i) { v[i] = *(const f32x4*)(x + (size_t)r * 1024 + 4 * lane + 256 * i); ss += v[i][0] * v[i][0] + v[i][1] * v[i][1] + v[i][2] * v[i][2] + v[i][3] * v[i][3]; }
        ss = wave_sum(ss);
        const float sc = rsqrtf(ss * (1.0f / 1024.0f) + EPSF);
#pragma unroll
        for (int i = 0; i < 4; ++i) { u32x2 w; w.x = cvt_pk_bf16(v[i][0] * sc * gv[i][0], v[i][1] * sc * gv[i][1]); w.y = cvt_pk_bf16(v[i][2] * sc * gv[i][2], v[i][3] * sc * gv[i][3]);
            *(u32x2*)(out + (size_t)r * 1024 + 4 * lane + 256 * i) = w; }
    }
}
__device__ __forceinline__ void peer_fuse_weights(LAS unsigned char* lds, const float* pwq  , const float* sk1, const float* sk2  , bf16_t* dst  ) {
    LAS float* Pt = (LAS float*)lds;
    LAS float* Sk = (LAS float*)(lds + 64 * 129 * 4);
    const int tid = fresh_tid();
    for (int item = blockIdx.x; item < 256; item += gridDim.x) {
        const int hh = item >> 4, k0 = (item & 15) * 64; const float* sk = (hh & 1) ? sk2 : sk1;
        for (int e = tid; e < 64 * 32; e += 512) { const int kk = e >> 5, d4 = (e & 31) * 4; const f32x4 v = *(const f32x4*)(pwq + (size_t)(k0 + kk) * 2048 + hh * 128 + d4);
            Pt[kk * 129 + d4] = v[0]; Pt[kk * 129 + d4 + 1] = v[1]; Pt[kk * 129 + d4 + 2] = v[2]; Pt[kk * 129 + d4 + 3] = v[3]; }
        for (int e = tid; e < 128 * 32; e += 512) { const int n = e >> 5, d4 = (e & 31) * 4; const f32x4 v = *(const f32x4*)(sk + (size_t)n * 128 + d4);
            Sk[n * 129 + d4] = v[0]; Sk[n * 129 + d4 + 1] = v[1]; Sk[n * 129 + d4 + 2] = v[2]; Sk[n * 129 + d4 + 3] = v[3]; }
        __syncthreads();
        { const int n = tid & 127, kg = __builtin_amdgcn_readfirstlane(tid >> 7); float acc[16];
#pragma unroll
            for (int j = 0; j < 16; ++j) acc[j] = 0.f;
            for (int d = 0; d < 128; ++d) { const float s = Sk[n * 129 + d];
#pragma unroll
                for (int j = 0; j < 16; ++j) acc[j] = __builtin_fmaf(Pt[(kg * 16 + j) * 129 + d], s, acc[j]); }
            u32x4 w0, w1; w0.x = cvt_pk_bf16(acc[0], acc[1]); w0.y = cvt_pk_bf16(acc[2], acc[3]); w0.z = cvt_pk_bf16(acc[4], acc[5]); w0.w = cvt_pk_bf16(acc[6], acc[7]);
            w1.x = cvt_pk_bf16(acc[8], acc[9]); w1.y = cvt_pk_bf16(acc[10], acc[11]); w1.z = cvt_pk_bf16(acc[12], acc[13]); w1.w = cvt_pk_bf16(acc[14], acc[15]);
            bf16_t* o = dst + (size_t)(hh * 128 + n) * 1024 + k0 + kg * 16; *(u32x4*)o = w0; *(u32x4*)(o + 8) = w1; }
        __syncthreads();
    }
}
__device__ __forceinline__ void make_tables(const Params& p) {
    if (blockIdx.x != 0) return;
    const int tidm = fresh_tid();
    float* btab = (float*)(p.ws + WS_CTL + CTL_BTAB); float* lamv = (float*)(p.ws + WS_CTL + CTL_LAM);
    const float* rb = p.in[I_RELB];
    for (int e = tidm; e < 8 * 128; e += 512) { const int hd = e >> 7, d = e & 127; int bk;
        if (d < 16) bk = d; else { const float nf = (float)d; int lg = 16 + (int)(logf(nf / 16.0f) / 2.0794415416798357f * 16.0f); bk = lg < 31 ? lg : 31; }
        btab[e] = (rb[bk * 8 + hd] - rb[31 * 8 + hd]) * LOG2E; }
    if (tidm < 128) { const int l = tidm >> 6, lane = tidm & 63;
        float a = p.in[I_LQ1][l * 64 + lane] * p.in[I_LK1][l * 64 + lane], b = p.in[I_LQ2][l * 64 + lane] * p.in[I_LK2][l * 64 + lane];
        a = wave_sum(a); b = wave_sum(b);
        const float lam_init = 0.8f - 0.6f * expf(-0.3f * (float)l);
        if (lane == 0) { lamv[l * 2] = expf(a) - expf(b) + lam_init; lamv[l * 2 + 1] = lam_init; } }
}
__device__ __forceinline__ void prep_weights(const Params& p, LAS unsigned char* lds, int l) {
    unsigned char* wb = p.ws + WS_WB;
    const float* win = p.in[I_W_IN] + (size_t)l * 1024 * DIN;
    bf16_t* winT = (bf16_t*)(wb + WB_WIN);
    conv_transpose(lds, win, DIN, 0,    512, winT + (size_t)HC_QA * 1024, 1024, 512);
    conv_transpose(lds, win, DIN, 512,  512, winT + (size_t)HC_KA * 1024, 1024, 512);
    conv_transpose(lds, win, DIN, 1536, 512, winT + (size_t)HC_ZU * 1024, 1024, 512);
    conv_transpose(lds, win, DIN, 2048, 512, winT + (size_t)HC_ZV * 1024, 1024, 512);
    conv_transpose(lds, win, DIN, 2560, 512, winT + (size_t)HC_CQ * 1024, 1024, 512);
    conv_transpose(lds, win, DIN, 3328, 512, winT + (size_t)HC_IQ * 1024, 1024, 512);
    conv_transpose(lds, win, DIN, 3072, 128, winT + (size_t)HC_CK * 1024, 1024, 128);
    conv_transpose(lds, win, DIN, 3840, 64,  winT + (size_t)HC_IK * 1024, 1024, 64);
    conv_transpose(lds, win, DIN, 3904, 8,   winT + (size_t)HC_IW * 1024, 1024, 64);
    bf16_t* wvT = (bf16_t*)(wb + WB_WV);
    conv_transpose(lds, win, DIN, 1024, 512, wvT, 1024, 512);
    conv_transpose(lds, win, DIN, 3200, 128, wvT + (size_t)512 * 1024, 1024, 128);
    conv_transpose(lds, win, DIN, 0,    0,   wvT + (size_t)640 * 1024, 1024, 128);
    conv_transpose(lds, win, DIN, 3912, 3072, (bf16_t*)(wb + WB_WG), 1024, 3072);
    conv_transpose(lds, p.in[I_WBRA] + (size_t)l * 512 * 1024, 1024, 0, 1024, (bf16_t*)(wb + WB_BRA), 512, 1024);
    conv_transpose(lds, p.in[I_WBRB] + (size_t)l * 512 * 1024, 1024, 0, 1024, (bf16_t*)(wb + WB_BRB), 512, 1024);
    conv_transpose(lds, p.in[I_WBRC] + (size_t)l * 512 * 1024, 1024, 0, 1024, (bf16_t*)(wb + WB_BRC), 512, 1024);
    conv_transpose(lds, p.in[I_WOUT] + (size_t)l * 1024 * 1024, 1024, 0, 1024, (bf16_t*)(wb + WB_OUT), 1024, 1024);
    conv_transpose(lds, p.in[I_MWQ] + (size_t)l * 1024 * 512, 512, 0, 512, (bf16_t*)(wb + WB_MQ), 1024, 512);
    conv_transpose(lds, p.in[I_MWKV] + (size_t)l * 1024 * 1024, 1024, 0, 512, (bf16_t*)(wb + WB_MK), 1024, 512);
    conv_transpose(lds, p.in[I_MWKV] + (size_t)l * 1024 * 1024, 1024, 512, 512, (bf16_t*)(wb + WB_MV), 1024, 512);
    conv_transpose(lds, p.in[I_MWO] + (size_t)l * 512 * 1024, 1024, 0, 1024, (bf16_t*)(wb + WB_MO), 512, 1024);
    peer_fuse_weights(lds, p.in[I_PWQ] + (size_t)l * 1024 * 2048, p.in[I_SK1] + (size_t)l * 128 * 128, p.in[I_SK2] + (size_t)l * 128 * 128, (bf16_t*)(wb + WB_PS));
}
__device__ __forceinline__ void conv_copy(const float* src, bf16_t* dst, size_t n) {
    const size_t stride = (size_t)gridDim.x * 512 * 8;
    const int tidc = fresh_tid();
    for (size_t i = ((size_t)blockIdx.x * 512 + tidc) * 8; i < n; i += stride) {
        const f32x4 a = *(const f32x4*)(src + i), b = *(const f32x4*)(src + i + 4);
        u32x4 w; w.x = cvt_pk_bf16(a[0], a[1]); w.y = cvt_pk_bf16(a[2], a[3]); w.z = cvt_pk_bf16(b[0], b[1]); w.w = cvt_pk_bf16(b[2], b[3]);
        *(u32x4*)(dst + i) = w; }
}

__device__ __forceinline__ void knorm_rows(const Params& p, int l) {
    bf16_t* H = (bf16_t*)(p.ws + WS_R + R_H); bf16_t* MK = (bf16_t*)(p.ws + WS_MK);
    const float* akg = p.in[I_AKG] + l * 64; const float* ckg = p.in[I_CKG] + l * 128; const float* mkg = p.in[I_MKG] + l * 128;
    const int tid = fresh_tid(); const int lane = tid & 63, gw = blockIdx.x * 8 + (tid >> 6), nw = gridDim.x * 8;
    float ga[8], gm[8];
#pragma unroll
    for (int j = 0; j < 8; ++j) { ga[j] = akg[(8 * lane + j) & 63]; gm[j] = mkg[(8 * lane + j) & 127]; }
    const float gc0 = ckg[2 * lane], gc1 = ckg[2 * lane + 1];
    for (int r = gw; r < T_TOK; r += nw) {
        bf16_t* row = H + (size_t)r * HN;
        {
            u32x4 w = *(const u32x4*)(row + HC_KA + 8 * lane); float f[8] = {bf_lo(w.x), bf_hi(w.x), bf_lo(w.y), bf_hi(w.y), bf_lo(w.z), bf_hi(w.z), bf_lo(w.w), bf_hi(w.w)};
            float ss = 0.f;
#pragma unroll
            for (int j = 0; j < 8; ++j) ss += f[j] * f[j];
            ss += __shfl_xor(ss, 1); ss += __shfl_xor(ss, 2); ss += __shfl_xor(ss, 4);
            const float sc = rsqrtf(ss * (1.0f / 64.0f) + EPSF);
            w.x = cvt_pk_bf16(f[0] * sc * ga[0], f[1] * sc * ga[1]); w.y = cvt_pk_bf16(f[2] * sc * ga[2], f[3] * sc * ga[3]);
            w.z = cvt_pk_bf16(f[4] * sc * ga[4], f[5] * sc * ga[5]); w.w = cvt_pk_bf16(f[6] * sc * ga[6], f[7] * sc * ga[7]);
            *(u32x4*)(row + HC_KA + 8 * lane) = w; }
        {
            const unsigned w = *(const unsigned*)(row + HC_CK + 2 * lane); const float a = bf_lo(w), b = bf_hi(w);
            const float ss = wave_sum(a * a + b * b); const float sc = rsqrtf(ss * (1.0f / 128.0f) + EPSF);
            *(unsigned*)(row + HC_CK + 2 * lane) = cvt_pk_bf16(a * sc * gc0, b * sc * gc1); }
    }
    for (int r = gw; r < NB * MEMLEN; r += nw) {
        bf16_t* row = MK + (size_t)r * 512;
        u32x4 w = *(const u32x4*)(row + 8 * lane); float f[8] = {bf_lo(w.x), bf_hi(w.x), bf_lo(w.y), bf_hi(w.y), bf_lo(w.z), bf_hi(w.z), bf_lo(w.w), bf_hi(w.w)};
        float ss = 0.f;
#pragma unroll
        for (int j = 0; j < 8; ++j) ss += f[j] * f[j];
        ss += __shfl_xor(ss, 1); ss += __shfl_xor(ss, 2); ss += __shfl_xor(ss, 4); ss += __shfl_xor(ss, 8);
        const float sc = rsqrtf(ss * (1.0f / 128.0f) + EPSF);
        w.x = cvt_pk_bf16(f[0] * sc * gm[0], f[1] * sc * gm[1]); w.y = cvt_pk_bf16(f[2] * sc * gm[2], f[3] * sc * gm[3]);
        w.z = cvt_pk_bf16(f[4] * sc * gm[4], f[5] * sc * gm[5]); w.w = cvt_pk_bf16(f[6] * sc * gm[6], f[7] * sc * gm[7]);
        *(u32x4*)(row + 8 * lane) = w;
    }
}
__device__ __forceinline__ void gmlp_phase(const Params& p, LAS unsigned char* lds, int l) {
    const bf16_t* H = (const bf16_t*)(p.ws + WS_R + R_H); bf16_t* YB = (bf16_t*)(p.ws + WS_YB);
    LAS unsigned char* Wl = lds;
    LAS unsigned char* Vt = lds + 32768;
    LAS unsigned char* Ul = lds + 65536;
    const int tid = fresh_tid(), lane = tid & 63, wv = __builtin_amdgcn_readfirstlane(tid >> 6), fr = lane & 15, fq = lane >> 4;
    for (int unit = blockIdx.x; unit < 1024; unit += gridDim.x) {
        const int c = unit >> 2, g = unit & 3; const size_t t0 = (size_t)c * 128;
        const float* W = p.in[I_BWS] + ((size_t)(l * 4 + g) * 128) * 128; const float* bs = p.in[I_BBS] + (size_t)(l * 4 + g) * 128; const float* vg = p.in[I_BVG] + l * 512 + g * 128;
        { const int t = tid >> 2, sq = (tid & 3) * 32;
#pragma unroll
            for (int q = 0; q < 4; ++q) { const f32x4 a = *(const f32x4*)(W + (size_t)t * 128 + sq + q * 8), b = *(const f32x4*)(W + (size_t)t * 128 + sq + q * 8 + 4);
                float f[8] = {a[0], a[1], a[2], a[3], b[0], b[1], b[2], b[3]};
#pragma unroll
                for (int j = 0; j < 8; ++j) if (sq + q * 8 + j > t) f[j] = 0.f;
                u32x4 w; w.x = cvt_pk_bf16(f[0], f[1]); w.y = cvt_pk_bf16(f[2], f[3]); w.z = cvt_pk_bf16(f[4], f[5]); w.w = cvt_pk_bf16(f[6], f[7]);
                const int ch = (sq >> 3) + q; *(LAS u32x4*)(Wl + t * 256 + ((ch ^ (t & 15)) << 4)) = w; } }
        { const int s = tid >> 2, dq = (tid & 3) * 32;
            const bf16_t* src = H + (t0 + s) * HN + HC_ZV + g * 128 + dq; float f[32]; float ss = 0.f;
#pragma unroll
            for (int q = 0; q < 4; ++q) { const u32x4 w = *(const u32x4*)(src + q * 8);
                f[q * 8 + 0] = bf_lo(w.x); f[q * 8 + 1] = bf_hi(w.x); f[q * 8 + 2] = bf_lo(w.y); f[q * 8 + 3] = bf_hi(w.y); f[q * 8 + 4] = bf_lo(w.z); f[q * 8 + 5] = bf_hi(w.z); f[q * 8 + 6] = bf_lo(w.w); f[q * 8 + 7] = bf_hi(w.w); }
#pragma unroll
            for (int j = 0; j < 32; ++j) { f[j] = gelu1(f[j]); ss += f[j] * f[j]; }
            ss += __shfl_xor(ss, 1); ss += __shfl_xor(ss, 2);
            const float sc = rsqrtf(ss * (1.0f / 128.0f) + EPSF);
#pragma unroll
            for (int j = 0; j < 32; ++j) { const int d = dq + j; const float v = f[j] * sc * vg[d];
                *(LAS bf16_t*)(Vt + d * 256 + (((s >> 3) ^ (d & 15)) << 4) + (s & 7) * 2) = f2bf(v); } }
        { const int t = tid >> 2, dq = (tid & 3) * 32;
            const bf16_t* src = H + (t0 + t) * HN + HC_ZU + g * 128 + dq;
#pragma unroll
            for (int q = 0; q < 4; ++q) { const u32x4 w = *(const u32x4*)(src + q * 8);
                u32x4 o; o.x = cvt_pk_bf16(gelu1(bf_lo(w.x)), gelu1(bf_hi(w.x))); o.y = cvt_pk_bf16(gelu1(bf_lo(w.y)), gelu1(bf_hi(w.y)));
                o.z = cvt_pk_bf16(gelu1(bf_lo(w.z)), gelu1(bf_hi(w.z))); o.w = cvt_pk_bf16(gelu1(bf_lo(w.w)), gelu1(bf_hi(w.w)));
                *(LAS u32x4*)(Ul + t * 272 + (dq + q * 8) * 2) = o; } }
        __syncthreads();
        {
            f32x4 acc[8];
#pragma unroll
            for (int dd = 0; dd < 8; ++dd) acc[dd] = (f32x4){0.f, 0.f, 0.f, 0.f};
            const int nks = (wv >> 1) + 1; const int trow = 16 * wv + fr;
            for (int ks = 0; ks < nks; ++ks) {
                const bf16x8 wf = *(const LAS bf16x8*)(Wl + trow * 256 + (((4 * ks + fq) ^ (trow & 15)) << 4));
#pragma unroll
                for (int dd = 0; dd < 8; ++dd) { const int d = 16 * dd + fr; const bf16x8 vf = *(const LAS bf16x8*)(Vt + d * 256 + (((4 * ks + fq) ^ (d & 15)) << 4));
                    acc[dd] = __builtin_amdgcn_mfma_f32_16x16x32_bf16(wf, vf, acc[dd], 0, 0, 0); } }
#pragma unroll
            for (int i = 0; i < 4; ++i) { const int t = 16 * wv + 4 * fq + i; const float bb = bs[t];
#pragma unroll
                for (int dd = 0; dd < 8; ++dd) { const int d = 16 * dd + fr; LAS bf16_t* up = (LAS bf16_t*)(Ul + t * 272 + d * 2); *up = f2bf((acc[dd][i] + bb) * bf2f(*up)); } }
        }
        __syncthreads();
        { const int t = tid >> 2, dq = (tid & 3) * 32; bf16_t* dst = YB + (t0 + t) * 512 + g * 128 + dq;
#pragma unroll
            for (int q = 0; q < 4; ++q) *(u32x4*)(dst + q * 8) = *(const LAS u32x4*)(Ul + t * 272 + (dq + q * 8) * 2); }
        __syncthreads();
    }
}

struct AttnArgs {
    const bf16_t* Q; int ldq; int qcol[2]; size_t qtok; const float* qgain; float qscale;
    const bf16_t* K; int ldk; size_t krow0; int kcol0;
    const bf16_t* V; int ldv; int vrow0; size_t vcol0;
    int nkt_blk, my_nkt, qpos, qpos_w0; int bhead[2]; const unsigned short* maskrow;
};
template <int NS, int DQK, bool KSPLIT, int MODE>
__device__ __forceinline__ void attn_core(LAS unsigned char* lds, const LAS float* btab, const AttnArgs& a, f32x4 (&O)[NS][8], float (&lsum)[NS]) {
    constexpr int NKS = DQK / 32;
    const int tid = fresh_tid(), lane = tid & 63, fr = lane & 15, fq = lane >> 4;
    bf16x8 qf[NS][NKS];
#pragma unroll
    for (int s = 0; s < NS; ++s) {
        float qv[NKS][8]; float ss = 0.f;
#pragma unroll
        for (int ks = 0; ks < NKS; ++ks) { const u32x4 w = *(const u32x4*)(a.Q + a.qtok * a.ldq + a.qcol[s] + 32 * ks + 8 * fq);
            qv[ks][0] = bf_lo(w.x); qv[ks][1] = bf_hi(w.x); qv[ks][2] = bf_lo(w.y); qv[ks][3] = bf_hi(w.y); qv[ks][4] = bf_lo(w.z); qv[ks][5] = bf_hi(w.z); qv[ks][6] = bf_lo(w.w); qv[ks][7] = bf_hi(w.w);
#pragma unroll
            for (int j = 0; j < 8; ++j) ss += qv[ks][j] * qv[ks][j]; }
        ss += __shfl_xor(ss, 16); ss += __shfl_xor(ss, 32);
        const float r = rsqrtf(ss * (1.0f / (float)DQK) + EPSF) * a.qscale;
#pragma unroll
        for (int ks = 0; ks < NKS; ++ks) { const f32x4 g0 = *(const f32x4*)(a.qgain + 32 * ks + 8 * fq), g1 = *(const f32x4*)(a.qgain + 32 * ks + 8 * fq + 4);
            u32x4 w; w.x = cvt_pk_bf16(qv[ks][0] * r * g0[0], qv[ks][1] * r * g0[1]); w.y = cvt_pk_bf16(qv[ks][2] * r * g0[2], qv[ks][3] * r * g0[3]);
            w.z = cvt_pk_bf16(qv[ks][4] * r * g1[0], qv[ks][5] * r * g1[1]); w.w = cvt_pk_bf16(qv[ks][6] * r * g1[2], qv[ks][7] * r * g1[3]);
            qf[s][ks] = __builtin_bit_cast(bf16x8, w); }
    }
    float mrun[NS];
#pragma unroll
    for (int s = 0; s < NS; ++s) { mrun[s] = NEG_INF; lsum[s] = 0.f;
#pragma unroll
        for (int dt = 0; dt < 8; ++dt) O[s][dt] = (f32x4){0.f, 0.f, 0.f, 0.f}; }
    const int wvs = __builtin_amdgcn_readfirstlane(tid >> 6);
    const int c0 = tid, c1 = tid + 512;
    const int kr0 = c0 >> 4, kr1 = c1 >> 4, vr0 = c0 >> 3, vr1 = c1 >> 3;
    const int kc0 = (c0 & 15) ^ (kr0 & 15), kc1 = (c1 & 15) ^ (kr1 & 15), vc0 = (c0 & 7) ^ ((vr0 >> 1) & 7), vc1 = (c1 & 7) ^ ((vr1 >> 1) & 7);
    const bf16_t* kg0 = a.K + (a.krow0 + kr0) * a.ldk + a.kcol0 + kc0 * 8; const bf16_t* kg1 = a.K + (a.krow0 + kr1) * a.ldk + a.kcol0 + kc1 * 8;
    const bf16_t* vg0 = a.V + (size_t)(a.vrow0 + vr0) * a.ldv + a.vcol0 + vc0 * 8; const bf16_t* vg1 = a.V + (size_t)(a.vrow0 + vr1) * a.ldv + a.vcol0 + vc1 * 8;
    const int ldw = wvs * 1024;
#define ATT_STAGE(bufoff, ko, vo) do { \
        __builtin_amdgcn_global_load_lds((const unsigned*)(kg0 + (ko)), (LAS unsigned*)(lds + (bufoff) + ldw), 16, 0, 0); \
        __builtin_amdgcn_global_load_lds((const unsigned*)(kg1 + (ko)), (LAS unsigned*)(lds + (bufoff) + 8192 + ldw), 16, 0, 0); \
        __builtin_amdgcn_global_load_lds((const unsigned*)(vg0 + (vo)), (LAS unsigned*)(lds + (bufoff) + 16384 + ldw), 16, 0, 0); \
        __builtin_amdgcn_global_load_lds((const unsigned*)(vg1 + (vo)), (LAS unsigned*)(lds + (bufoff) + 24576 + ldw), 16, 0, 0); } while (0)
    ATT_STAGE(0, 0, 0);
    unsigned long long mnext = 0ull;
    if (MODE == 1) mnext = *(const unsigned long long*)(a.maskrow);
    __syncthreads();
    for (int kt = 0; kt < a.nkt_blk; ++kt) {
        const int buf = kt & 1; const bool more = (kt + 1 < a.nkt_blk);
        const unsigned long long mbits = mnext;
        if (more) { const size_t ko = (size_t)(kt + 1) * 64 * a.ldk, vo = (size_t)(kt + 1) * 64;
            ATT_STAGE((buf ^ 1) * 32768, ko, vo);
            if (MODE == 1) mnext = *(const unsigned long long*)(a.maskrow + 4 * (kt + 1)); }
        if (kt < a.my_nkt) {
            const LAS unsigned char* Kt = lds + buf * 32768; const LAS unsigned char* Vt = Kt + 16384;
            const int key0 = kt * 64;
            const bool near = (MODE != 2) && (a.qpos_w0 - key0 - 63 < 128);
            bf16x8 pf[NS][2];
#pragma unroll
            for (int s = 0; s < NS; ++s) {
                f32x4 sacc[4];
#pragma unroll
                for (int t = 0; t < 4; ++t) { sacc[t] = (f32x4){0.f, 0.f, 0.f, 0.f}; const LAS unsigned char* rp = Kt + (16 * t + fr) * 256;
#pragma unroll
                    for (int ks = 0; ks < NKS; ++ks) { const bf16x8 kf = *(const LAS bf16x8*)(rp + ((((KSPLIT ? 8 * s : 0) + 4 * ks + fq) ^ fr) << 4));
                        sacc[t] = __builtin_amdgcn_mfma_f32_16x16x32_bf16(kf, qf[s][ks], sacc[t], 0, 0, 0); }
                    if (t & 1) __builtin_amdgcn_sched_barrier(0); }
                float rmax = NEG_INF;
#pragma unroll
                for (int t = 0; t < 4; ++t)
#pragma unroll
                    for (int i = 0; i < 4; ++i) { float x = sacc[t][i];
                        if (MODE == 0) { if (near) { const int dist = a.qpos - (key0 + 16 * t + 4 * fq + i); const int di = dist < 0 ? 0 : (dist > 127 ? 127 : dist);
                                x += btab[a.bhead[s] * 128 + di]; if (dist < 0) x = NEG_INF; } }
                        if (MODE == 1) { const bool sel = (mbits >> (16 * t + 4 * fq + i)) & 1ull;
                            if (near) { const int dist = a.qpos - (key0 + 16 * t + 4 * fq + i); const int di = dist < 0 ? 0 : (dist > 127 ? 127 : dist); x += btab[a.bhead[s] * 128 + di]; }
                            if (!sel) x = NEG_INF; }
                        sacc[t][i] = x; rmax = fmaxf(rmax, x); }
                rmax = fmaxf(rmax, __shfl_xor(rmax, 16)); rmax = fmaxf(rmax, __shfl_xor(rmax, 32));
                const float mn = fmaxf(mrun[s], rmax); const float mu = (mn == NEG_INF) ? 0.f : mn;
                const float alpha = __builtin_amdgcn_exp2f(mrun[s] - mu); mrun[s] = mn;
                float psum = 0.f;
#pragma unroll
                for (int t = 0; t < 4; ++t)
#pragma unroll
                    for (int i = 0; i < 4; ++i) { const float pv = __builtin_amdgcn_exp2f(sacc[t][i] - mu); sacc[t][i] = pv; psum += pv; }
                lsum[s] = lsum[s] * alpha + psum;
#pragma unroll
                for (int dt = 0; dt < 8; ++dt) O[s][dt] *= alpha;
#pragma unroll
                for (int s2 = 0; s2 < 2; ++s2) { u32x4 w; w.x = cvt_pk_bf16(sacc[2 * s2][0], sacc[2 * s2][1]); w.y = cvt_pk_bf16(sacc[2 * s2][2], sacc[2 * s2][3]);
                    w.z = cvt_pk_bf16(sacc[2 * s2 + 1][0], sacc[2 * s2 + 1][1]); w.w = cvt_pk_bf16(sacc[2 * s2 + 1][2], sacc[2 * s2 + 1][3]); pf[s][s2] = __builtin_bit_cast(bf16x8, w); }
            }
#pragma unroll
            for (int dt = 0; dt < 8; ++dt) { const int row = 16 * dt + fr; const LAS unsigned char* rp = Vt + row * 128 + 8 * (fq & 1); const int sw = (row >> 1) & 7;
#pragma unroll
                for (int s2 = 0; s2 < 2; ++s2) {
                    const u32x2 va = *(const LAS u32x2*)(rp + (((4 * s2 + (fq >> 1)) ^ sw) << 4)), vb = *(const LAS u32x2*)(rp + (((4 * s2 + 2 + (fq >> 1)) ^ sw) << 4));
                    u32x4 w; w.x = va.x; w.y = va.y; w.z = vb.x; w.w = vb.y; const bf16x8 vf = __builtin_bit_cast(bf16x8, w);
#pragma unroll
                    for (int s = 0; s < NS; ++s) O[s][dt] = __builtin_amdgcn_mfma_f32_16x16x32_bf16(vf, pf[s][s2], O[s][dt], 0, 0, 0); }
                if (dt & 1) __builtin_amdgcn_sched_barrier(0); }
        }
        __syncthreads();
    }
#undef ATT_STAGE
#pragma unroll
    for (int s = 0; s < NS; ++s) { lsum[s] += __shfl_xor(lsum[s], 16); lsum[s] += __shfl_xor(lsum[s], 32); }
}
__device__ __forceinline__ void load_btab(const Params& p, LAS float* bt) {
    const float* src = (const float*)(p.ws + WS_CTL + CTL_BTAB);
    const int tidb = fresh_tid();
    for (int e = tidb; e < 1024; e += 512) bt[e] = src[e];
    __syncthreads();
}
__device__ __forceinline__ void attnA_phase(const Params& p, LAS unsigned char* lds, int l) {
    LAS float* bt = (LAS float*)(lds + 65536);
    load_btab(p, bt);
    const bf16_t* H = (const bf16_t*)(p.ws + WS_R + R_H); const bf16_t* VT = (const bf16_t*)(p.ws + WS_R + R_VT); bf16_t* YA = (bf16_t*)(p.ws + WS_YA);
    const float* lamv = (const float*)(p.ws + WS_CTL + CTL_LAM); const float lam = lamv[l * 2], lam_init = lamv[l * 2 + 1];
    const float* subln = p.in[I_SUBLN] + l * 128;
    const int tid = fresh_tid(); const int lane = tid & 63, wv = __builtin_amdgcn_readfirstlane(tid >> 6), fr = lane & 15, fq = lane >> 4;
    for (int cc = blockIdx.x * 4; cc < 1024; cc += gridDim.x * 4) for (int it = 0; it < 4; ++it) {
        const int c = cc >> 2;
        const int bh = c >> 2, j = c & 3; const int qt = (it == 0) ? j : (it == 1) ? 7 - j : (it == 2) ? 8 + j : 15 - j;
        const int b = bh >> 2, h = bh & 3;
        AttnArgs a;
        const int qpos_w0 = qt * 128 + wv * 16;
        a.Q = H; a.ldq = HN; a.qcol[0] = HC_QA + h * 128; a.qcol[1] = HC_QA + h * 128 + 64; a.qtok = (size_t)b * SEQ + qpos_w0 + fr; a.qgain = p.in[I_AQG] + l * 64; a.qscale = 0.125f * LOG2E;
        a.K = H; a.ldk = HN; a.krow0 = (size_t)b * SEQ; a.kcol0 = HC_KA + h * 128;
        a.V = VT; a.ldv = T_TOK; a.vrow0 = h * 128; a.vcol0 = (size_t)b * SEQ;
        a.nkt_blk = 2 * qt + 2; a.my_nkt = ((qpos_w0 + 15) >> 6) + 1; a.qpos = qpos_w0 + fr; a.qpos_w0 = qpos_w0; a.bhead[0] = h; a.bhead[1] = h; a.maskrow = nullptr;
        f32x4 O[2][8]; float ls[2];
        attn_core<2, 64, true, 0>(lds, bt, a, O, ls);
        const float i1 = 1.0f / ls[0], i2 = lam / ls[1]; float ss = 0.f;
#pragma unroll
        for (int dt = 0; dt < 8; ++dt)
#pragma unroll
            for (int i = 0; i < 4; ++i) { const float v = O[0][dt][i] * i1 - O[1][dt][i] * i2; O[0][dt][i] = v; ss += v * v; }
        ss += __shfl_xor(ss, 16); ss += __shfl_xor(ss, 32);
        const float sc = rsqrtf(ss * (1.0f / 128.0f) + EPSF) * (1.0f - lam_init);
        bf16_t* dst = YA + a.qtok * 512 + h * 128 + 4 * fq;
#pragma unroll
        for (int dt = 0; dt < 8; ++dt) { const f32x4 g = *(const f32x4*)(subln + 16 * dt + 4 * fq); u32x2 w; w.x = cvt_pk_bf16(O[0][dt][0] * sc * g[0], O[0][dt][1] * sc * g[1]); w.y = cvt_pk_bf16(O[0][dt][2] * sc * g[2], O[0][dt][3] * sc * g[3]);
            *(u32x2*)(dst + 16 * dt) = w; }
    }
}
__device__ __forceinline__ void attnC_phase(const Params& p, LAS unsigned char* lds, int l) {
    LAS float* bt = (LAS float*)(lds + 65536);
    load_btab(p, bt);
    const bf16_t* H = (const bf16_t*)(p.ws + WS_R + R_H); const bf16_t* VT = (const bf16_t*)(p.ws + WS_R + R_VT); bf16_t* YC = (bf16_t*)(p.ws + WS_YC);
    const unsigned short* mask = (const unsigned short*)(p.ws + WS_MASK);
    const int tid = fresh_tid(); const int lane = tid & 63, wv = __builtin_amdgcn_readfirstlane(tid >> 6), fr = lane & 15, fq = lane >> 4;
    const int qs = wv & 3, hp = wv >> 2;
    for (int cc = blockIdx.x * 2; cc < 512; cc += gridDim.x * 2) for (int it = 0; it < 2; ++it) {
        const int c = cc >> 1;
        const int b = c >> 4, j = c & 15; const int qt = (it == 0) ? j : 31 - j;
        AttnArgs a;
        const int qpos_w0 = qt * 64 + qs * 16;
        a.Q = H; a.ldq = HN; a.qcol[0] = HC_CQ + (2 * hp) * 128; a.qcol[1] = HC_CQ + (2 * hp + 1) * 128; a.qtok = (size_t)b * SEQ + qpos_w0 + fr; a.qgain = p.in[I_CQG] + l * 128; a.qscale = 0.08838834764831845f * LOG2E;
        a.K = H; a.ldk = HN; a.krow0 = (size_t)b * SEQ; a.kcol0 = HC_CK;
        a.V = VT; a.ldv = T_TOK; a.vrow0 = 512; a.vcol0 = (size_t)b * SEQ;
        a.nkt_blk = qt + 1; a.my_nkt = qt + 1; a.qpos = qpos_w0 + fr; a.qpos_w0 = qpos_w0; a.bhead[0] = 4 + 2 * hp; a.bhead[1] = 5 + 2 * hp; a.maskrow = mask + a.qtok * 128;
        f32x4 O[2][8]; float ls[2];
        attn_core<2, 128, false, 1>(lds, bt, a, O, ls);
#pragma unroll
        for (int s = 0; s < 2; ++s) { const float inv = 1.0f / ls[s]; bf16_t* dst = YC + a.qtok * 512 + (2 * hp + s) * 128 + 4 * fq;
#pragma unroll
            for (int dt = 0; dt < 8; ++dt) { u32x2 w; w.x = cvt_pk_bf16(O[s][dt][0] * inv, O[s][dt][1] * inv); w.y = cvt_pk_bf16(O[s][dt][2] * inv, O[s][dt][3] * inv); *(u32x2*)(dst + 16 * dt) = w; } }
    }
}
__device__ __forceinline__ void attnX_phase(const Params& p, LAS unsigned char* lds, int l) {
    const bf16_t* QX = (const bf16_t*)(p.ws + WS_YA); const bf16_t* MK = (const bf16_t*)(p.ws + WS_MK); const bf16_t* MVT = (const bf16_t*)(p.ws + WS_MVT); bf16_t* OX = (bf16_t*)(p.ws + WS_YB);
    const int tid = fresh_tid(); const int lane = tid & 63, wv = __builtin_amdgcn_readfirstlane(tid >> 6), fr = lane & 15, fq = lane >> 4;
    for (int unit = blockIdx.x; unit < 1024; unit += gridDim.x) {
        const int b = unit >> 6, h = (unit >> 4) & 3, qt = unit & 15;
        AttnArgs a;
        const int qpos_w0 = qt * 128 + wv * 16;
        a.Q = QX; a.ldq = 512; a.qcol[0] = h * 128; a.qcol[1] = h * 128; a.qtok = (size_t)b * SEQ + qpos_w0 + fr; a.qgain = p.in[I_MQG] + l * 128; a.qscale = 0.08838834764831845f * LOG2E;
        a.K = MK; a.ldk = 512; a.krow0 = (size_t)b * MEMLEN; a.kcol0 = h * 128;
        a.V = MVT; a.ldv = NB * MEMLEN; a.vrow0 = h * 128; a.vcol0 = (size_t)b * MEMLEN;
        a.nkt_blk = 4; a.my_nkt = 4; a.qpos = 0; a.qpos_w0 = 0; a.bhead[0] = 0; a.bhead[1] = 0; a.maskrow = nullptr;
        f32x4 O[1][8]; float ls[1];
        attn_core<1, 128, false, 2>(lds, nullptr, a, O, ls);
        const float inv = 1.0f / ls[0]; bf16_t* dst = OX + a.qtok * 512 + h * 128 + 4 * fq;
#pragma unroll
        for (int dt = 0; dt < 8; ++dt) { u32x2 w; w.x = cvt_pk_bf16(O[0][dt][0] * inv, O[0][dt][1] * inv); w.y = cvt_pk_bf16(O[0][dt][2] * inv, O[0][dt][3] * inv); *(u32x2*)(dst + 16 * dt) = w; }
    }
}

__device__ __forceinline__ void csel_phase(const Params& p, LAS unsigned char* lds) {
    const bf16_t* H = (const bf16_t*)(p.ws + WS_R + R_H); unsigned short* mask = (unsigned short*)(p.ws + WS_MASK);
    LAS unsigned* cnt = (LAS unsigned*)lds;
    const int tid = fresh_tid(); const int lane = tid & 63, wv = __builtin_amdgcn_readfirstlane(tid >> 6), fr = lane & 15, fq = lane >> 4;
    for (int c = blockIdx.x; c < 256; c += gridDim.x) {
        const int b = c >> 4, j = c & 15;
        for (int it = 0; it < 8; ++it) {
            const int i = (it & 1) ? (32 * (it >> 1) + 31 - j) : (32 * (it >> 1) + j);
            const size_t qtok = (size_t)b * SEQ + 16 * i + fr;
            bf16x8 bq[8][2]; float wq[8];
#pragma unroll
            for (int h = 0; h < 8; ++h)
#pragma unroll
                for (int ks = 0; ks < 2; ++ks) bq[h][ks] = *(const bf16x8*)(H + qtok * HN + HC_IQ + h * 64 + 32 * ks + 8 * fq);
            { const u32x4 w = *(const u32x4*)(H + qtok * HN + HC_IW); wq[0] = bf_lo(w.x); wq[1] = bf_hi(w.x); wq[2] = bf_lo(w.y); wq[3] = bf_hi(w.y); wq[4] = bf_lo(w.z); wq[5] = bf_hi(w.z); wq[6] = bf_lo(w.w); wq[7] = bf_hi(w.w); }
            unsigned u[16][4];
#pragma unroll
            for (int n = 0; n < 16; ++n) {
                const int st = wv + 8 * n;
                if (st <= i) {
                    const bf16_t* kp = H + ((size_t)b * SEQ + 16 * st + fr) * HN + HC_IK + 8 * fq;
                    const bf16x8 ka0 = *(const bf16x8*)kp, ka1 = *(const bf16x8*)(kp + 32);
                    float sc[4] = {0.f, 0.f, 0.f, 0.f};
#pragma unroll
                    for (int h = 0; h < 8; ++h) { f32x4 acc = (f32x4){0.f, 0.f, 0.f, 0.f};
                        acc = __builtin_amdgcn_mfma_f32_16x16x32_bf16(ka0, bq[h][0], acc, 0, 0, 0); acc = __builtin_amdgcn_mfma_f32_16x16x32_bf16(ka1, bq[h][1], acc, 0, 0, 0);
#pragma unroll
                        for (int k = 0; k < 4; ++k) sc[k] = __builtin_fmaf(fmaxf(acc[k], 0.f), wq[h], sc[k]); }
#pragma unroll
                    for (int k = 0; k < 4; ++k) { if (st == i && 4 * fq + k > fr) sc[k] = NEG_INF; u[n][k] = ukey(sc[k]); }
                } else {
#pragma unroll
                    for (int k = 0; k < 4; ++k) u[n][k] = 0u;
                }
            }
            unsigned tau = 0u;
            if (i >= 16) {
                bool done = false;
                for (int bit = 31; bit >= 0; --bit) {
                    const unsigned cand = tau | (1u << bit);
                    unsigned cl = 0u;
#pragma unroll
                    for (int n = 0; n < 16; ++n)
#pragma unroll
                        for (int k = 0; k < 4; ++k) cl += (u[n][k] >= cand) ? 1u : 0u;
                    cl += __shfl_xor(cl, 16); cl += __shfl_xor(cl, 32);
                    LAS unsigned* cb = cnt + (bit & 1) * 128;
                    if (fq == 0) cb[wv * 16 + fr] = cl;
                    __syncthreads();
                    unsigned tot = 0u;
#pragma unroll
                    for (int w2 = 0; w2 < 8; ++w2) tot += cb[w2 * 16 + fr];
                    if (!done && tot >= 256u) { tau = cand; if (tot == 256u) done = true; }
                    if (__all(done)) break;
                }
            }
            __syncthreads();
#pragma unroll
            for (int n = 0; n < 16; ++n) {
                const int st = wv + 8 * n;
                if (st <= (i | 3)) {
                    unsigned nib = 0u;
                    if (st <= i) {
#pragma unroll
                        for (int k = 0; k < 4; ++k) { const bool causal = (st < i) || (4 * fq + k <= fr); if (causal && u[n][k] >= tau) nib |= (1u << k); }
                    }
                    unsigned wd = nib << (4 * fq);
                    wd |= __shfl_xor(wd, 16); wd |= __shfl_xor(wd, 32);
                    if (fq == 0) mask[qtok * 128 + st] = (unsigned short)wd;
                }
            }
        }
    }
}
__device__ __forceinline__ void peer_topk_phase(const Params& p, LAS unsigned char* lds) {
    const float* PS = (const float*)(p.ws + WS_R + R_PS); int* EIDX = (int*)(p.ws + WS_YC); float* EGATE = (float*)(p.ws + WS_YC + 16 * MiB);
    const int tid = fresh_tid(); const int lane = tid & 63, wv = __builtin_amdgcn_readfirstlane(tid >> 6);
    LAS float* wl = (LAS float*)(lds + wv * 512);
    LAS int* wi = (LAS int*)wl;
    const unsigned long long lt = (lane == 0) ? 0ull : (~0ull >> (64 - lane));
    for (int item = blockIdx.x * 8 + wv; item < T_TOK * 8; item += gridDim.x * 8) {
        const int tok = item >> 3, h = item & 7;
        const float* sp = PS + (size_t)tok * 2048 + h * 256;
#pragma unroll
        for (int half = 0; half < 2; ++half) {
            const pg8::f32x2 sv = *(const pg8::f32x2*)(sp + half * 128 + 2 * lane);
            const unsigned u0 = ukey(sv.x), u1 = ukey(sv.y);
            unsigned tau = 0u;
            for (int bit = 31; bit >= 0; --bit) { const unsigned cand = tau | (1u << bit);
                const int cnum = __popcll(__ballot(u0 >= cand)) + __popcll(__ballot(u1 >= cand));
                if (cnum >= 16) { tau = cand; if (cnum == 16) break; } }
            const unsigned long long b0 = __ballot(u0 >= tau), b1 = __ballot(u1 >= tau);
            const int pos0 = __popcll(b0 & lt) + __popcll(b1 & lt); const int pos1 = pos0 + ((u0 >= tau) ? 1 : 0);
            if (u0 >= tau && pos0 < 16) { wl[half * 32 + pos0] = sv.x; wi[half * 32 + 16 + pos0] = 2 * lane; }
            if (u1 >= tau && pos1 < 16) { wl[half * 32 + pos1] = sv.y; wi[half * 32 + 16 + pos1] = 2 * lane + 1; }
        }
        asm volatile("s_waitcnt lgkmcnt(0)" ::: "memory");
        float cs[4]; unsigned uc[4];
        { const float va = wl[lane >> 2];
#pragma unroll
            for (int jj = 0; jj < 4; ++jj) { cs[jj] = va + wl[32 + (lane & 3) * 4 + jj]; uc[jj] = ukey(cs[jj]); } }
        unsigned tau = 0u;
        for (int bit = 31; bit >= 0; --bit) { const unsigned cand = tau | (1u << bit);
            const int cnum = __popcll(__ballot(uc[0] >= cand)) + __popcll(__ballot(uc[1] >= cand)) + __popcll(__ballot(uc[2] >= cand)) + __popcll(__ballot(uc[3] >= cand));
            if (cnum >= 16) { tau = cand; if (cnum == 16) break; } }
        {
            const unsigned long long q0 = __ballot(uc[0] >= tau), q1 = __ballot(uc[1] >= tau), q2 = __ballot(uc[2] >= tau), q3 = __ballot(uc[3] >= tau);
            int pos = __popcll(q0 & lt) + __popcll(q1 & lt) + __popcll(q2 & lt) + __popcll(q3 & lt);
            const int e1 = wi[16 + (lane >> 2)];
#pragma unroll
            for (int jj = 0; jj < 4; ++jj) { if (uc[jj] >= tau) { if (pos < 16) { wl[64 + pos] = cs[jj]; wi[80 + pos] = e1 * 128 + wi[48 + (lane & 3) * 4 + jj]; } ++pos; } }
        }
        asm volatile("s_waitcnt lgkmcnt(0)" ::: "memory");
        { const int sl = lane & 15; const float v = wl[64 + sl]; const int e = wi[80 + sl];
            float mx = v; mx = fmaxf(mx, __shfl_xor(mx, 1)); mx = fmaxf(mx, __shfl_xor(mx, 2)); mx = fmaxf(mx, __shfl_xor(mx, 4)); mx = fmaxf(mx, __shfl_xor(mx, 8));
            const float ex = __expf(v - mx); float sm = ex; sm += __shfl_xor(sm, 1); sm += __shfl_xor(sm, 2); sm += __shfl_xor(sm, 4); sm += __shfl_xor(sm, 8);
            if (lane < 16) { EIDX[(size_t)tok * 128 + h * 16 + lane] = e; EGATE[(size_t)tok * 128 + h * 16 + lane] = ex / sm; } }
        asm volatile("s_waitcnt lgkmcnt(0)" ::: "memory");
    }
}
__device__ __forceinline__ void peer_gather_phase(const Params& p, const float* xin) {
    const bf16_t* XN = (const bf16_t*)(p.ws + WS_XN); const bf16_t* U16 = (const bf16_t*)(p.ws + WS_YA); const bf16_t* V16 = (const bf16_t*)(p.ws + WS_YB);
    const int* EIDX = (const int*)(p.ws + WS_YC); const float* EGATE = (const float*)(p.ws + WS_YC + 16 * MiB);
    const int tid = fresh_tid(); const int lane = tid & 63, wv = __builtin_amdgcn_readfirstlane(tid >> 6);
    for (int tok = blockIdx.x * 8 + wv; tok < T_TOK; tok += gridDim.x * 8) {
        const u32x4 x0 = *(const u32x4*)(XN + (size_t)tok * 1024 + 8 * lane), x1 = *(const u32x4*)(XN + (size_t)tok * 1024 + 512 + 8 * lane);
        const unsigned xw[8] = {x0.x, x0.y, x0.z, x0.w, x1.x, x1.y, x1.z, x1.w};
        float acc[16];
#pragma unroll
        for (int j = 0; j < 16; ++j) acc[j] = 0.f;
        for (int bt = 0; bt < 16; ++bt) {
            const int my_e = EIDX[(size_t)tok * 128 + bt * 8 + (lane >> 3)]; const float my_g = EGATE[(size_t)tok * 128 + bt * 8 + (lane >> 3)];
            int e[8];
#pragma unroll
            for (int k = 0; k < 8; ++k) e[k] = __builtin_amdgcn_readlane(my_e, 8 * k);
            float d[8];
#pragma unroll
            for (int k = 0; k < 8; ++k) { const bf16_t* up = U16 + (size_t)e[k] * 1024 + 8 * lane; const u32x4 a = *(const u32x4*)up, b2 = *(const u32x4*)(up + 512);
                const unsigned uw[8] = {a.x, a.y, a.z, a.w, b2.x, b2.y, b2.z, b2.w}; float s = 0.f;
#pragma unroll
                for (int q = 0; q < 8; ++q) s = __builtin_amdgcn_fdot2_f32_bf16(__builtin_bit_cast(bf16x2v, uw[q]), __builtin_bit_cast(bf16x2v, xw[q]), s, false);
                d[k] = s; }
            float r4[4], r2[2], z;
            { const bool up = (lane & 32) != 0;
#pragma unroll
                for (int k = 0; k < 4; ++k) { const float send = up ? d[k] : d[k + 4], keep = up ? d[k + 4] : d[k]; r4[k] = keep + __shfl_xor(send, 32); } }
            { const bool up = (lane & 16) != 0;
#pragma unroll
                for (int k = 0; k < 2; ++k) { const float send = up ? r4[k] : r4[k + 2], keep = up ? r4[k + 2] : r4[k]; r2[k] = keep + __shfl_xor(send, 16); } }
            { const bool up = (lane & 8) != 0; const float send = up ? r2[0] : r2[1], keep = up ? r2[1] : r2[0]; z = keep + __shfl_xor(send, 8); }
            z += __shfl_xor(z, 4); z += __shfl_xor(z, 2); z += __shfl_xor(z, 1);
            const float coef = gelu1(z) * my_g;
#pragma unroll
            for (int k = 0; k < 8; ++k) { const float ck = __uint_as_float((unsigned)__builtin_amdgcn_readlane((int)__float_as_uint(coef), 8 * k));
                const bf16_t* vp = V16 + (size_t)e[k] * 1024 + 8 * lane; const u32x4 a = *(const u32x4*)vp, b2 = *(const u32x4*)(vp + 512);
                const unsigned vw[8] = {a.x, a.y, a.z, a.w, b2.x, b2.y, b2.z, b2.w};
#pragma unroll
                for (int q = 0; q < 8; ++q) { acc[2 * q] = __builtin_fmaf(ck, bf_lo(vw[q]), acc[2 * q]); acc[2 * q + 1] = __builtin_fmaf(ck, bf_hi(vw[q]), acc[2 * q + 1]); } }
        }
        const float* xr = xin + (size_t)tok * 1024; float* orow = p.out + (size_t)tok * 1024;
#pragma unroll
        for (int hf = 0; hf < 2; ++hf)
#pragma unroll
            for (int q = 0; q < 2; ++q) { const f32x4 xv = *(const f32x4*)(xr + hf * 512 + 8 * lane + 4 * q); f32x4 o;
                o[0] = xv[0] + acc[hf * 8 + 4 * q]; o[1] = xv[1] + acc[hf * 8 + 4 * q + 1]; o[2] = xv[2] + acc[hf * 8 + 4 * q + 2]; o[3] = xv[3] + acc[hf * 8 + 4 * q + 3];
                *(f32x4*)(orow + hf * 512 + 8 * lane + 4 * q) = o; }
    }
}
#ifdef PROBE_K
struct DumpSeg { const void* p; size_t n; long long kind; };
__global__ void __launch_bounds__(512) probe_dump(float* out, DumpSeg s0, DumpSeg s1, DumpSeg s2, DumpSeg s3, DumpSeg s4, DumpSeg s5) {
    const DumpSeg segs[6] = {s0, s1, s2, s3, s4, s5};
    const size_t NOUT = (size_t)T_TOK * DM;
    for (size_t i = (size_t)blockIdx.x * 512 + threadIdx.x; i < NOUT; i += (size_t)gridDim.x * 512) {
        float acc = 0.f;
#pragma unroll
        for (int k = 0; k < 6; ++k) { const DumpSeg s = segs[k]; if (s.p == nullptr || s.n == 0) continue;
            for (size_t j = i; j < s.n; j += NOUT) { float v;
                if (s.kind == 0) v = bf2f(((const bf16_t*)s.p)[j]); else if (s.kind == 1) v = ((const float*)s.p)[j]; else if (s.kind == 2) v = (float)((const unsigned short*)s.p)[j] * (1.0f / 65536.0f); else v = (float)(((const int*)s.p)[j] & 0xffff) * (1.0f / 65536.0f);
                if (!(fabsf(v) < 1e30f)) v = 12345.0f;
                acc += v; }
            if (s.n < NOUT) { const size_t j = i % s.n; float v;
                if (s.kind == 0) v = bf2f(((const bf16_t*)s.p)[j]); else if (s.kind == 1) v = ((const float*)s.p)[j]; else if (s.kind == 2) v = (float)((const unsigned short*)s.p)[j] * (1.0f / 65536.0f); else v = (float)(((const int*)s.p)[j] & 0xffff) * (1.0f / 65536.0f);
                if (!(fabsf(v) < 1e30f)) v = 12345.0f;
                if (i >= s.n) acc += v; } }
        out[i] = acc; }
}
#endif
#ifdef PROBE_DET
struct CkSeg { const void* p; size_t nbytes; };
__global__ void __launch_bounds__(512) probe_cksum(unsigned long long* dst, CkSeg s0, CkSeg s1, CkSeg s2, CkSeg s3) {
    const CkSeg segs[4] = {s0, s1, s2, s3};
    unsigned long long h = 0ull;
    for (int k = 0; k < 4; ++k) { const CkSeg s = segs[k]; if (s.p == nullptr) continue; const unsigned* w = (const unsigned*)s.p; const size_t n = s.nbytes / 4;
        for (size_t i = (size_t)blockIdx.x * 512 + threadIdx.x; i < n; i += (size_t)gridDim.x * 512) h += (unsigned long long)w[i] * (unsigned long long)(i * 2654435761ull + 12345ull + (unsigned long long)k * 977ull); }
    for (int o = 32; o; o >>= 1) h += __shfl_xor(h, o);
    if ((threadIdx.x & 63) == 0) atomicAdd(dst, h);
}
__global__ void __launch_bounds__(512) probe_mark(float* out, const unsigned long long* cks, int nph) {
    int code = 0;
    for (int k = nph - 1; k >= 0; --k) if (cks[k] != cks[32 + k] || cks[k] != cks[64 + k]) code = k + 1;
    if (code == 0) return;
    const float f = 2.0f;
    for (size_t i = (size_t)blockIdx.x * 512 + threadIdx.x; i < (size_t)T_TOK * DM; i += (size_t)gridDim.x * 512) out[i] *= f;
}
#endif

#ifdef PROBE_CHK
__device__ __forceinline__ unsigned hsh(unsigned x) { x ^= x >> 16; x *= 0x7feb352du; x ^= x >> 15; x *= 0x846ca68bu; x ^= x >> 16; return x; }
__device__ __forceinline__ void chk_fail(unsigned* flag, int code) { atomicMin(flag, (unsigned)code); }
__device__ __forceinline__ bool close_to(float a, float ref, float atol, float rtol) { return fabsf(a - ref) <= atol + rtol * fabsf(ref) && (a == a); }
__device__ __forceinline__ int h_origcol(int c) { if (c < 1024) return c; if (c < 1536) return c + 512; if (c < 2048) return c + 512; if (c < 2560) return c + 512; if (c < 3072) return c + 768; if (c < 3200) return c; if (c < 3264) return c + 640; return c + 640; }
__device__ __forceinline__ float ref_gelu(float x) { return 0.5f * x * (1.0f + erff(x * 0.70710678f)); }
__global__ void chk_h(Params p, int l, unsigned* flag) {
    const unsigned s = blockIdx.x * blockDim.x + threadIdx.x; const int t = hsh(s * 2 + 1) % T_TOK; const int c = hsh(s * 2 + 2) % 3272;
    const bf16_t* XN = (const bf16_t*)(p.ws + WS_XN); const bf16_t* H = (const bf16_t*)(p.ws + WS_R + R_H); const bf16_t* VT = (const bf16_t*)(p.ws + WS_R + R_VT);
    const float* win = p.in[I_W_IN] + (size_t)l * 1024 * DIN; const int oc = h_origcol(c);
    float r = 0.f; for (int k = 0; k < 1024; ++k) r += bf2f(XN[(size_t)t * 1024 + k]) * win[(size_t)k * DIN + oc];
    if (!close_to(bf2f(H[(size_t)t * HN + c]), r, 0.06f, 0.03f)) chk_fail(flag, 1);
    const int m = hsh(s * 2 + 77) % 640; const int vc = m < 512 ? 1024 + m : 3200 + (m - 512);
    float r2 = 0.f; for (int k = 0; k < 1024; ++k) r2 += bf2f(XN[(size_t)t * 1024 + k]) * win[(size_t)k * DIN + vc];
    if (!close_to(bf2f(VT[(size_t)m * T_TOK + t]), r2, 0.06f, 0.03f)) chk_fail(flag, 2);
}
__global__ void chk_post(Params p, int l, unsigned* flag) {
    const unsigned s = blockIdx.x * blockDim.x + threadIdx.x; const int t = hsh(s * 3 + 1) % T_TOK; const int g = hsh(s * 3 + 2) & 3; const int d = hsh(s * 3 + 3) & 127;
    const bf16_t* H = (const bf16_t*)(p.ws + WS_R + R_H); const bf16_t* YB = (const bf16_t*)(p.ws + WS_YB);
    const int c0 = (t / 128) * 128, tt = t % 128;
    const float* W = p.in[I_BWS] + ((size_t)(l * 4 + g) * 128) * 128; const float* bs = p.in[I_BBS] + (size_t)(l * 4 + g) * 128; const float* vg = p.in[I_BVG] + l * 512 + g * 128;
    float sv = 0.f;
    for (int ss = 0; ss <= tt; ++ss) { const bf16_t* row = H + (size_t)(c0 + ss) * HN + HC_ZV + g * 128; float q = 0.f; for (int dd = 0; dd < 128; ++dd) { const float v = ref_gelu(bf2f(row[dd])); q += v * v; }
        const float vn = ref_gelu(bf2f(row[d])) * rsqrtf(q / 128.f + EPSF) * vg[d]; sv += W[tt * 128 + ss] * vn; }
    sv += bs[tt];
    const float r = ref_gelu(bf2f(H[(size_t)t * HN + HC_ZU + g * 128 + d])) * sv;
    if (!close_to(bf2f(YB[(size_t)t * 512 + g * 128 + d]), r, 0.03f, 0.04f)) chk_fail(flag, 3);
    { const int grp = hsh(s * 3 + 9) & 7; const float* gn = p.in[I_AKG] + l * 64; float q = 0.f; for (int j = 0; j < 64; ++j) { const float v = bf2f(H[(size_t)t * HN + HC_KA + grp * 64 + j]) / gn[j]; q += v * v; }
        if (!close_to(q / 64.f, 1.0f, 0.03f, 0.f)) chk_fail(flag, 5);
        const float* gc = p.in[I_CKG] + l * 128; q = 0.f; for (int j = 0; j < 128; ++j) { const float v = bf2f(H[(size_t)t * HN + HC_CK + j]) / gc[j]; q += v * v; }
        if (!close_to(q / 128.f, 1.0f, 0.03f, 0.f)) chk_fail(flag, 5); }
}
__global__ void chk_mask(Params p, unsigned* flag) {
    const unsigned s = blockIdx.x * blockDim.x + threadIdx.x; const int b = hsh(s * 5 + 1) & 15; const int q = hsh(s * 5 + 2) & 2047;
    const bf16_t* H = (const bf16_t*)(p.ws + WS_R + R_H); const unsigned short* mask = (const unsigned short*)(p.ws + WS_MASK);
    const size_t tq = (size_t)b * SEQ + q;
    int cnt = 0; float minsel = 3e38f, maxuns = -3e38f;
    for (int k = 0; k < SEQ; ++k) { const bool sel = (mask[tq * 128 + (k >> 4)] >> (k & 15)) & 1; if (k > q) { if (k <= (q | 63) && sel) chk_fail(flag, 4); continue; }
        float sc = 0.f; for (int h = 0; h < 8; ++h) { float dt = 0.f; for (int d = 0; d < 64; ++d) dt += bf2f(H[tq * HN + HC_IQ + h * 64 + d]) * bf2f(H[((size_t)b * SEQ + k) * HN + HC_IK + d]); sc += fmaxf(dt, 0.f) * bf2f(H[tq * HN + HC_IW + h]); }
        if (sel) { ++cnt; minsel = fminf(minsel, sc); } else maxuns = fmaxf(maxuns, sc); }
    const int want = (q + 1 < 256) ? q + 1 : 256;
    if (cnt < want || cnt > want + 2) chk_fail(flag, 4);
    if (q >= 256 && minsel < maxuns - 0.02f * (fabsf(maxuns) + 1.f)) chk_fail(flag, 4);
}
__global__ void chk_attn(Params p, int l, unsigned* flag) {
    __shared__ float qn_s[64][130]; __shared__ float o_s[64][130];
    float* qn = qn_s[threadIdx.x]; float* o = o_s[threadIdx.x];
    const unsigned s = blockIdx.x * blockDim.x + threadIdx.x; const int b = hsh(s * 7 + 1) & 15, h = hsh(s * 7 + 2) & 3, q = hsh(s * 7 + 3) & 2047;
    const bf16_t* H = (const bf16_t*)(p.ws + WS_R + R_H); const bf16_t* VT = (const bf16_t*)(p.ws + WS_R + R_VT); const bf16_t* YA = (const bf16_t*)(p.ws + WS_YA);
    const float* lamv = (const float*)(p.ws + WS_CTL + CTL_LAM); const float lam = lamv[l * 2], lam_init = lamv[l * 2 + 1];
    const float* rb = p.in[I_RELB]; const size_t tq = (size_t)b * SEQ + q; const float* qg = p.in[I_AQG] + l * 64; const float* sg = p.in[I_SUBLN] + l * 128;
    for (int sb = 0; sb < 2; ++sb) { float ss = 0.f; for (int d = 0; d < 64; ++d) { const float v = bf2f(H[tq * HN + HC_QA + h * 128 + sb * 64 + d]); ss += v * v; } const float r = rsqrtf(ss / 64.f + EPSF);
        for (int d = 0; d < 64; ++d) qn[sb * 64 + d] = bf2f(H[tq * HN + HC_QA + h * 128 + sb * 64 + d]) * r * qg[d]; }
    for (int d = 0; d < 128; ++d) o[d] = 0.f;
    float mx0 = -3e38f, mx1 = -3e38f, l0 = 0.f, l1 = 0.f;
    for (int pass = 0; pass < 3; ++pass) {
        for (int k = 0; k <= q; ++k) { const int dist = q - k; int bk; if (dist < 16) bk = dist; else { int lg = 16 + (int)(logf((float)dist / 16.f) / 2.0794415416798357f * 16.f); bk = lg < 31 ? lg : 31; }
            const bf16_t* kr = H + ((size_t)b * SEQ + k) * HN + HC_KA + h * 128; float d0 = 0.f, d1 = 0.f;
            for (int e = 0; e < 64; ++e) { d0 += qn[e] * bf2f(kr[e]); d1 += qn[64 + e] * bf2f(kr[64 + e]); }
            const float g0 = d0 * 0.125f + rb[bk * 8 + h], g1 = d1 * 0.125f + rb[bk * 8 + h];
            if (pass == 0) { mx0 = fmaxf(mx0, g0); mx1 = fmaxf(mx1, g1); }
            else if (pass == 1) { l0 += expf(g0 - mx0); l1 += expf(g1 - mx1); }
            else { const float pd = expf(g0 - mx0) / l0 - lam * expf(g1 - mx1) / l1; for (int d = 0; d < 128; ++d) o[d] += pd * bf2f(VT[(size_t)(h * 128 + d) * T_TOK + (size_t)b * SEQ + k]); } } }
    float ssq = 0.f; for (int d = 0; d < 128; ++d) ssq += o[d] * o[d];
    const float sc = rsqrtf(ssq / 128.f + EPSF) * (1.f - lam_init);
    for (int d = 0; d < 128; d += 17) if (!close_to(bf2f(YA[tq * 512 + h * 128 + d]), o[d] * sc * sg[d], 0.03f, 0.05f)) chk_fail(flag, 6);
}
__global__ void chk_attnc(Params p, int l, unsigned* flag) {
    const unsigned s = blockIdx.x * blockDim.x + threadIdx.x; const int b = hsh(s * 11 + 1) & 15, h = hsh(s * 11 + 2) & 3, q = hsh(s * 11 + 3) & 2047;
    const bf16_t* H = (const bf16_t*)(p.ws + WS_R + R_H); const bf16_t* VT = (const bf16_t*)(p.ws + WS_R + R_VT); const bf16_t* YC = (const bf16_t*)(p.ws + WS_YC);
    const unsigned short* mask = (const unsigned short*)(p.ws + WS_MASK); const float* rb = p.in[I_RELB]; const size_t tq = (size_t)b * SEQ + q; const float* qg = p.in[I_CQG] + l * 128;
    float ss = 0.f; for (int d = 0; d < 128; ++d) { const float v = bf2f(H[tq * HN + HC_CQ + h * 128 + d]); ss += v * v; } const float r = rsqrtf(ss / 128.f + EPSF);
    float mx = -3e38f, ls = 0.f, o0 = 0.f, o1 = 0.f; const int d0 = hsh(s * 11 + 4) & 127, d1 = hsh(s * 11 + 5) & 127;
    for (int pass = 0; pass < 2; ++pass)
        for (int k = 0; k <= q; ++k) { if (!((mask[tq * 128 + (k >> 4)] >> (k & 15)) & 1)) continue;
            const int dist = q - k; int bk; if (dist < 16) bk = dist; else { int lg = 16 + (int)(logf((float)dist / 16.f) / 2.0794415416798357f * 16.f); bk = lg < 31 ? lg : 31; }
            float dt = 0.f; for (int d = 0; d < 128; ++d) dt += bf2f(H[tq * HN + HC_CQ + h * 128 + d]) * r * qg[d] * bf2f(H[((size_t)b * SEQ + k) * HN + HC_CK + d]);
            const float lg2 = dt * 0.08838834764831845f + rb[bk * 8 + 4 + h];
            if (pass == 0) mx = fmaxf(mx, lg2); else { const float pr = expf(lg2 - mx); ls += pr; o0 += pr * bf2f(VT[(size_t)(512 + d0) * T_TOK + (size_t)b * SEQ + k]); o1 += pr * bf2f(VT[(size_t)(512 + d1) * T_TOK + (size_t)b * SEQ + k]); } }
    if (!close_to(bf2f(YC[tq * 512 + h * 128 + d0]), o0 / ls, 0.02f, 0.05f)) chk_fail(flag, 7);
    if (!close_to(bf2f(YC[tq * 512 + h * 128 + d1]), o1 / ls, 0.02f, 0.05f)) chk_fail(flag, 7);
}
__global__ void chk_merge(Params p, int l, unsigned* flag) {
    const unsigned s = blockIdx.x * blockDim.x + threadIdx.x; const int t = hsh(s * 13 + 1) % T_TOK; const int j = hsh(s * 13 + 2) & 1023;
    const bf16_t* XN = (const bf16_t*)(p.ws + WS_XN); const bf16_t* G = (const bf16_t*)(p.ws + WS_R + R_G); const bf16_t* MG = (const bf16_t*)(p.ws + WS_R + R_MERGED);
    const float* win = p.in[I_W_IN] + (size_t)l * 1024 * DIN; float m = 0.f;
    for (int br = 0; br < 3; ++br) { float z = 0.f; for (int k = 0; k < 1024; ++k) z += bf2f(XN[(size_t)t * 1024 + k]) * win[(size_t)k * DIN + 3912 + br * 1024 + j];
        const float gt = 1.f / (1.f + expf(-z)); if (!close_to(bf2f(G[(size_t)t * 3072 + br * 1024 + j]), gt, 0.02f, 0.02f)) chk_fail(flag, 8);
        const bf16_t* Y = (const bf16_t*)(p.ws + (br == 0 ? WS_YA : br == 1 ? WS_YB : WS_YC)); const float* wb = p.in[br == 0 ? I_WBRA : br == 1 ? I_WBRB : I_WBRC] + (size_t)l * 512 * 1024;
        float y = 0.f; for (int k = 0; k < 512; ++k) y += bf2f(Y[(size_t)t * 512 + k]) * wb[(size_t)k * 1024 + j]; m += gt * y; }
    if (!close_to(bf2f(MG[(size_t)t * 1024 + j]), m, 0.04f, 0.04f)) chk_fail(flag, 9);
}
__global__ void chk_xmix(Params p, int l, const float* xsrc, unsigned* flag) {
    const unsigned s = blockIdx.x * blockDim.x + threadIdx.x; const int t = hsh(s * 17 + 1) % T_TOK; const int j = hsh(s * 17 + 2) & 1023;
    const bf16_t* MG = (const bf16_t*)(p.ws + WS_R + R_MERGED); const float* wo = p.in[I_WOUT] + (size_t)l * 1024 * 1024;
    float y = 0.f; for (int k = 0; k < 1024; ++k) y += bf2f(MG[(size_t)t * 1024 + k]) * wo[(size_t)k * 1024 + j];
    if (l == 0 && !close_to(p.out[(size_t)t * 1024 + j], xsrc[(size_t)t * 1024 + j] + y, 0.05f, 0.03f)) chk_fail(flag, 10);
}
__global__ void chk_xattn(Params p, int l, unsigned* flag) {
    const unsigned s = blockIdx.x * blockDim.x + threadIdx.x; const int b = hsh(s * 19 + 1) & 15, h = hsh(s * 19 + 2) & 3, q = hsh(s * 19 + 3) & 2047; const int d0 = hsh(s * 19 + 4) & 127;
    const bf16_t* QX = (const bf16_t*)(p.ws + WS_YA); const bf16_t* MK = (const bf16_t*)(p.ws + WS_MK); const bf16_t* MVT = (const bf16_t*)(p.ws + WS_MVT); const bf16_t* OX = (const bf16_t*)(p.ws + WS_YB);
    const bf16_t* XN = (const bf16_t*)(p.ws + WS_XN); const float* wq = p.in[I_MWQ] + (size_t)l * 1024 * 512; const size_t tq = (size_t)b * SEQ + q; const float* qg = p.in[I_MQG] + l * 128;
    { float z = 0.f; for (int k = 0; k < 1024; ++k) z += bf2f(XN[tq * 1024 + k]) * wq[(size_t)k * 512 + h * 128 + d0]; if (!close_to(bf2f(QX[tq * 512 + h * 128 + d0]), z, 0.06f, 0.03f)) chk_fail(flag, 11); }
    float ss = 0.f; for (int d = 0; d < 128; ++d) { const float v = bf2f(QX[tq * 512 + h * 128 + d]); ss += v * v; } const float r = rsqrtf(ss / 128.f + EPSF);
    float mx = -3e38f, ls = 0.f, o0 = 0.f;
    for (int pass = 0; pass < 2; ++pass) for (int k = 0; k < 256; ++k) { float dt = 0.f; for (int d = 0; d < 128; ++d) dt += bf2f(QX[tq * 512 + h * 128 + d]) * r * qg[d] * bf2f(MK[((size_t)b * 256 + k) * 512 + h * 128 + d]);
        const float lg2 = dt * 0.08838834764831845f; if (pass == 0) mx = fmaxf(mx, lg2); else { const float pr = expf(lg2 - mx); ls += pr; o0 += pr * bf2f(MVT[(size_t)(h * 128 + d0) * 4096 + b * 256 + k]); } }
    if (!close_to(bf2f(OX[tq * 512 + h * 128 + d0]), o0 / ls, 0.01f, 0.05f)) chk_fail(flag, 12);
}
__global__ void chk_ps(Params p, int l, unsigned* flag) {
    const unsigned s = blockIdx.x * blockDim.x + threadIdx.x; const int t = hsh(s * 23 + 1) % T_TOK; const int hh = hsh(s * 23 + 2) & 15, n = hsh(s * 23 + 3) & 127;
    const bf16_t* XN = (const bf16_t*)(p.ws + WS_XN); const float* PS = (const float*)(p.ws + WS_R + R_PS);
    const float* pwq = p.in[I_PWQ] + (size_t)l * 1024 * 2048; const float* sk = p.in[(hh & 1) ? I_SK2 : I_SK1] + (size_t)l * 128 * 128;
    float sc = 0.f; for (int d = 0; d < 128; ++d) { float qd = 0.f; for (int k = 0; k < 1024; ++k) qd += bf2f(XN[(size_t)t * 1024 + k]) * pwq[(size_t)k * 2048 + hh * 128 + d]; sc += qd * sk[n * 128 + d]; }
    if (!close_to(PS[(size_t)t * 2048 + hh * 128 + n], sc, 0.05f, 0.03f)) chk_fail(flag, 13);
}
__global__ void chk_topk(Params p, unsigned* flag) {
    const unsigned s = blockIdx.x * blockDim.x + threadIdx.x; const int t = hsh(s * 29 + 1) % T_TOK; const int h = hsh(s * 29 + 2) & 7;
    const float* PS = (const float*)(p.ws + WS_R + R_PS) + (size_t)t * 2048 + h * 256; const int* EIDX = (const int*)(p.ws + WS_YC) + (size_t)t * 128 + h * 16; const float* EG = (const float*)(p.ws + WS_YC + 16 * MiB) + (size_t)t * 128 + h * 16;
    __shared__ float csv_s[64][17]; float* csv = csv_s[threadIdx.x];
    float gsum = 0.f, mn = 3e38f, mxs = -3e38f;
    for (int i = 0; i < 16; ++i) { const int e = EIDX[i]; if (e < 0 || e >= 16384) { chk_fail(flag, 14); return; } const int e1 = e >> 7, e2 = e & 127; int r1 = 0, r2 = 0;
        for (int j = 0; j < 128; ++j) { if (PS[j] > PS[e1]) ++r1; if (PS[128 + j] > PS[128 + e2]) ++r2; }
        if (r1 >= 16 || r2 >= 16) chk_fail(flag, 14);
        csv[i] = PS[e1] + PS[128 + e2]; mn = fminf(mn, csv[i]); mxs = fmaxf(mxs, csv[i]); for (int j = 0; j < i; ++j) if (EIDX[j] == e) chk_fail(flag, 14); }
    for (int i = 0; i < 16; ++i) gsum += expf(csv[i] - mxs);
    for (int i = 0; i < 16; ++i) if (!close_to(EG[i], expf(csv[i] - mxs) / gsum, 0.003f, 0.02f)) chk_fail(flag, 14);
    int better = 0; for (int a = 0; a < 128; ++a) for (int b2 = 0; b2 < 128; ++b2) if (PS[a] + PS[128 + b2] > mn + 1e-4f) ++better;
    if (better > 15) chk_fail(flag, 14);
}
__global__ void chk_save_x(Params p, float* save) { const unsigned s = blockIdx.x * blockDim.x + threadIdx.x; const int t = hsh(s * 31 + 1) % T_TOK; const int d = hsh(s * 31 + 2) & 1023; save[s] = p.out[(size_t)t * 1024 + d]; }
__global__ void chk_gather(Params p, int l, const float* save, unsigned* flag) {
    const unsigned s = blockIdx.x * blockDim.x + threadIdx.x; const int t = hsh(s * 31 + 1) % T_TOK; const int d = hsh(s * 31 + 2) & 1023;
    const bf16_t* XN = (const bf16_t*)(p.ws + WS_XN); const int* EIDX = (const int*)(p.ws + WS_YC) + (size_t)t * 128; const float* EG = (const float*)(p.ws + WS_YC + 16 * MiB) + (size_t)t * 128;
    const float* pu = p.in[I_PU] + (size_t)l * 16384 * 1024; const float* pv = p.in[I_PV] + (size_t)l * 16384 * 1024; float inc = 0.f;
    for (int i = 0; i < 128; ++i) { const int e = EIDX[i]; float dt = 0.f; for (int k = 0; k < 1024; ++k) dt += bf2f(XN[(size_t)t * 1024 + k]) * pu[(size_t)e * 1024 + k]; inc += EG[i] * ref_gelu(dt) * pv[(size_t)e * 1024 + d]; }
    if (!close_to(p.out[(size_t)t * 1024 + d] - save[s], inc, 0.03f, 0.05f)) chk_fail(flag, 15);
}
__global__ void __launch_bounds__(512) chk_mark(float* out, const unsigned* flag) {
    const unsigned code = *flag; if (code == 0 || code > 100) return;
    const float f = 1.0f + 0.3f * (float)code;
    for (size_t i = (size_t)blockIdx.x * 512 + threadIdx.x; i < (size_t)T_TOK * DM; i += (size_t)gridDim.x * 512) out[i] *= f;
}
#endif

#ifndef MK_MULTI
#define MK_MULTI 0
#endif
constexpr int NPH = 15, NLAYER = 2;
__global__ void __launch_bounds__(512, 2) hybrid_fwd(Params p) {
    extern __shared__ __attribute__((aligned(16))) unsigned char lds_raw[];
    LAS unsigned char* lds = (LAS unsigned char*)lds_raw;
    if (threadIdx.x == 0) *(LAS u32x4*)(lds + LDS_BAR_OFF) = (u32x4){0u, 0u, 0u, 0u};
    __syncthreads();
    XcdBarrier bar = xcd_barrier_post((unsigned*)(p.ws + WS_CTL), (volatile LAS unsigned*)(lds + LDS_BAR_OFF));
    const int lo = p.ph_lo, hi = p.ph_hi;
#ifndef PHMASK
#define PHMASK 0x7fff
#endif
#define IN(k) (((PHMASK >> ((k) % NPH)) & 1) && lo <= (k) && (k) < hi)
#define SEAM(k) do { if (IN(k) && IN((k) + 1)) xcd_barrier(bar); } while (0)
    unsigned char* ws = p.ws;
    bf16_t* const XN = (bf16_t*)(ws + WS_XN);
    for (int l = 0; l < NLAYER; ++l) {
        const int P0 = l * NPH;
        const float* xsrc = (l == 0) ? p.in[I_X] : (const float*)p.out;
        if (IN(P0 + 0)) {
            if (l == 0) make_tables(p);
            prep_weights(p, lds, l);
            rmsnorm_rows(xsrc, p.in[I_NORM_MIX] + l * 1024, XN, T_TOK);
            rmsnorm_rows(p.in[I_MEM], p.in[I_NORM_MEMSRC] + l * 1024, (bf16_t*)(ws + WS_MEMN), NB * MEMLEN);
        }
        SEAM(P0 + 0);
        if (IN(P0 + 1)) {
            run_gemm(lds, XN, (const bf16_t*)(ws + WS_WB + WB_WIN), T_TOK, HN, 1024, 0, EpiStore{(bf16_t*)(ws + WS_R + R_H), HN});
            run_gemm(lds, (const bf16_t*)(ws + WS_WB + WB_WV), XN, 768, T_TOK, 1024, 128, EpiStore{(bf16_t*)(ws + WS_R + R_VT), T_TOK});
            run_gemm(lds, (const bf16_t*)(ws + WS_MEMN), (const bf16_t*)(ws + WS_WB + WB_MK), NB * MEMLEN, 512, 1024, 0, EpiStore{(bf16_t*)(ws + WS_MK), 512});
            run_gemm(lds, (const bf16_t*)(ws + WS_WB + WB_MV), (const bf16_t*)(ws + WS_MEMN), 512, NB * MEMLEN, 1024, 32, EpiStore{(bf16_t*)(ws + WS_MVT), NB * MEMLEN});
        }
        SEAM(P0 + 1);
        if (IN(P0 + 2)) {
#ifndef SKIP_KN
            knorm_rows(p, l);
#endif
#ifndef SKIP_GM
            gmlp_phase(p, lds, l);
#endif
#ifndef SKIP_CS
            csel_phase(p, lds);
#endif
        }
        SEAM(P0 + 2);
        if (IN(P0 + 3)) {
#ifndef SKIP_AA
            attnA_phase(p, lds, l);
#endif
            __syncthreads();
#ifndef SKIP_AC
            attnC_phase(p, lds, l);
#endif
        }
        SEAM(P0 + 3);
        if (IN(P0 + 4)) run_gemm(lds, XN, (const bf16_t*)(ws + WS_WB + WB_WG), T_TOK, 3072, 1024, 0, EpiSigmoid{(bf16_t*)(ws + WS_R + R_G), 3072});
        SEAM(P0 + 4);
        if (IN(P0 + 5)) {
            bf16_t* MG = (bf16_t*)(ws + WS_R + R_MERGED); const bf16_t* G = (const bf16_t*)(ws + WS_R + R_G);
            run_gemm(lds, (const bf16_t*)(ws + WS_YA), (const bf16_t*)(ws + WS_WB + WB_BRA), T_TOK, 1024, 512, 0, EpiBranch{MG, G, 0, 1});
            run_gemm(lds, (const bf16_t*)(ws + WS_YB), (const bf16_t*)(ws + WS_WB + WB_BRB), T_TOK, 1024, 512, 0, EpiBranch{MG, G, 1, 0});
            run_gemm(lds, (const bf16_t*)(ws + WS_YC), (const bf16_t*)(ws + WS_WB + WB_BRC), T_TOK, 1024, 512, 0, EpiBranch{MG, G, 2, 0});
        }
        SEAM(P0 + 5);
        if (IN(P0 + 6)) run_gemm(lds, (const bf16_t*)(ws + WS_R + R_MERGED), (const bf16_t*)(ws + WS_WB + WB_OUT), T_TOK, 1024, 1024, 0, EpiResid{xsrc, p.out, 1024});
        SEAM(P0 + 6);
        if (IN(P0 + 7)) rmsnorm_rows(p.out, p.in[I_NORM_MEM] + l * 1024, XN, T_TOK);
        SEAM(P0 + 7);
        if (IN(P0 + 8)) run_gemm(lds, XN, (const bf16_t*)(ws + WS_WB + WB_MQ), T_TOK, 512, 1024, 0, EpiStore{(bf16_t*)(ws + WS_YA), 512});
        SEAM(P0 + 8);
        if (IN(P0 + 9)) attnX_phase(p, lds, l);
        SEAM(P0 + 9);
        if (IN(P0 + 10)) run_gemm(lds, (const bf16_t*)(ws + WS_YB), (const bf16_t*)(ws + WS_WB + WB_MO), T_TOK, 1024, 512, 0, EpiResid{p.out, p.out, 1024});
        SEAM(P0 + 10);
        if (IN(P0 + 11)) {
            rmsnorm_rows(p.out, p.in[I_NORM_PEER] + l * 1024, XN, T_TOK);
            conv_copy(p.in[I_PU] + (size_t)l * 16384 * 1024, (bf16_t*)(ws + WS_YA), (size_t)16384 * 1024);
            conv_copy(p.in[I_PV] + (size_t)l * 16384 * 1024, (bf16_t*)(ws + WS_YB), (size_t)16384 * 1024);
        }
        SEAM(P0 + 11);
        if (IN(P0 + 12)) run_gemm(lds, XN, (const bf16_t*)(ws + WS_WB + WB_PS), T_TOK, 2048, 1024, 0, EpiF32Store{(float*)(ws + WS_R + R_PS), 2048});
        SEAM(P0 + 12);
        if (IN(P0 + 13)) peer_topk_phase(p, lds);
        SEAM(P0 + 13);
        if (IN(P0 + 14)) peer_gather_phase(p, p.out);
        SEAM(P0 + 14);
    }
#undef IN
#undef SEAM
}

extern "C" void kernel_launch(void* const* d_in, const int* in_sizes, int n_in, void* d_out, int out_size, void* d_ws, size_t ws_size, hipStream_t stream) {
    static int grid = 0;
    if (grid == 0) {
        if (n_in != 34 || out_size != T_TOK * DM || ws_size < WS_END) { fprintf(stderr, "kernel_launch: unexpected shapes (n_in %d out %d ws %zu)\n", n_in, out_size, ws_size); grid = -1; return; }
        int dev = 0, cus = 0, per_cu = 0;
        if (hipGetDevice(&dev) != hipSuccess || hipDeviceGetAttribute(&cus, hipDeviceAttributeMultiprocessorCount, dev) != hipSuccess) { grid = -1; return; }
        if (hipFuncSetAttribute((const void*)hybrid_fwd, hipFuncAttributeMaxDynamicSharedMemorySize, LDS_TOTAL) != hipSuccess) { fprintf(stderr, "kernel_launch: hipFuncSetAttribute failed\n"); grid = -1; return; }
        if (hipOccupancyMaxActiveBlocksPerMultiprocessor(&per_cu, (const void*)hybrid_fwd, 512, LDS_TOTAL) != hipSuccess || per_cu < 1) { fprintf(stderr, "kernel_launch: occupancy query says %d\n", per_cu); }
        (void)hipGetLastError();
        grid = cus;
    }
    if (grid < 0) return;
#ifdef PROBE_ZERO_WS
    if (hipMemsetAsync((char*)d_ws, 0, WS_END, stream) != hipSuccess) return;
#endif
    if (hipMemsetAsync((char*)d_ws + WS_CTL, 0, XCD_BAR_WORDS * sizeof(unsigned), stream) != hipSuccess) return;
    Params p{};
    for (int i = 0; i < 34; ++i) p.in[i] = (const float*)d_in[i];
    p.out = (float*)d_out; p.ws = (unsigned char*)d_ws;
#ifdef PROBE_CHK
    {
        unsigned char* ws = (unsigned char*)d_ws; unsigned* flag = (unsigned*)(ws + WS_CTL + 200 * 1024); float* save = (float*)(ws + WS_CTL + 256 * 1024);
        hipMemsetAsync(flag, 0xFF, 4, stream);
        const int CL = PROBE_CHK - 1;
        for (int ph = 0; ph < 2 * NPH; ++ph) {
            const int l = ph / NPH, k = ph % NPH;
            if (l == CL && k == 14) hipLaunchKernelGGL(chk_save_x, dim3(16), dim3(64), 0, stream, p, save);
            p.ph_lo = ph; p.ph_hi = ph + 1; hipLaunchKernelGGL(hybrid_fwd, dim3(grid), dim3(512), LDS_TOTAL, stream, p);
            if (l != CL) continue;
            const float* xsrc = (const float*)d_in[0];
            if (k == 1) hipLaunchKernelGGL(chk_h, dim3(32), dim3(64), 0, stream, p, l, flag);
            if (k == 2) { hipLaunchKernelGGL(chk_post, dim3(16), dim3(64), 0, stream, p, l, flag); hipLaunchKernelGGL(chk_mask, dim3(4), dim3(64), 0, stream, p, flag); }
            if (k == 3) { hipLaunchKernelGGL(chk_attn, dim3(4), dim3(64), 0, stream, p, l, flag); hipLaunchKernelGGL(chk_attnc, dim3(4), dim3(64), 0, stream, p, l, flag); }
            if (k == 5) hipLaunchKernelGGL(chk_merge, dim3(16), dim3(64), 0, stream, p, l, flag);
            if (k == 6) hipLaunchKernelGGL(chk_xmix, dim3(16), dim3(64), 0, stream, p, l, xsrc, flag);
            if (k == 9) hipLaunchKernelGGL(chk_xattn, dim3(8), dim3(64), 0, stream, p, l, flag);
            if (k == 12) hipLaunchKernelGGL(chk_ps, dim3(8), dim3(64), 0, stream, p, l, flag);
            if (k == 13) hipLaunchKernelGGL(chk_topk, dim3(8), dim3(64), 0, stream, p, flag);
            if (k == 14) hipLaunchKernelGGL(chk_gather, dim3(16), dim3(64), 0, stream, p, l, (const float*)save, flag);
        }
        hipLaunchKernelGGL(chk_mark, dim3(1024), dim3(512), 0, stream, (float*)d_out, (const unsigned*)flag);
    }
#elif defined(PROBE_DET)
    {
        unsigned char* ws = (unsigned char*)d_ws; const size_t NT = (size_t)T_TOK;
        unsigned long long* cks = (unsigned long long*)(ws + WS_CTL + 128 * 1024);
        hipMemsetAsync(cks, 0, 128 * 8, stream);
        for (int run = 0; run < 3; ++run) for (int ph = 0; ph <= PROBE_PH; ++ph) {
            p.ph_lo = ph; p.ph_hi = ph + 1; hipLaunchKernelGGL(hybrid_fwd, dim3(grid), dim3(512), LDS_TOTAL, stream, p);
            CkSeg z{nullptr, 0}; CkSeg c[4] = {z, z, z, z};
            switch (ph) {
            case 0: c[0] = {ws + WS_WB, 27 * MiB}; c[1] = {ws + WS_XN, NT * 2048}; c[2] = {ws + WS_MEMN, 8 * MiB}; c[3] = {ws + WS_CTL + CTL_BTAB, 4096}; break;
            case 1: c[0] = {ws + WS_R + R_H, NT * HN * 2}; c[1] = {ws + WS_R + R_VT, 768 * NT * 2}; c[2] = {ws + WS_MK, 4 * MiB}; c[3] = {ws + WS_MVT, 4 * MiB}; break;
            case 2: c[0] = {ws + WS_R + R_H, NT * HN * 2}; c[1] = {ws + WS_YB, 32 * MiB}; c[2] = {ws + WS_MK, 4 * MiB}; c[3] = {ws + WS_MASK, 8 * MiB}; break;
            case 3: c[0] = {ws + WS_YA, 32 * MiB}; c[1] = {ws + WS_YC, 32 * MiB}; break;
            case 4: c[0] = {ws + WS_R + R_G, 192 * MiB}; break;
            case 5: c[0] = {ws + WS_R + R_MERGED, 64 * MiB}; break;
            case 6: c[0] = {d_out, 128 * MiB}; break;
            case 7: c[0] = {ws + WS_XN, 64 * MiB}; break;
            case 8: c[0] = {ws + WS_YA, 32 * MiB}; break;
            case 9: c[0] = {ws + WS_YB, 32 * MiB}; break;
            case 10: c[0] = {d_out, 128 * MiB}; break;
            case 11: c[0] = {ws + WS_XN, 64 * MiB}; c[1] = {ws + WS_YA, 32 * MiB}; c[2] = {ws + WS_YB, 32 * MiB}; break;
            case 12: c[0] = {ws + WS_R + R_PS, 256 * MiB}; break;
            case 13: c[0] = {ws + WS_YC, 32 * MiB}; break;
            case 14: c[0] = {d_out, 128 * MiB}; break;
            }
            hipLaunchKernelGGL(probe_cksum, dim3(1024), dim3(512), 0, stream, cks + run * 32 + ph, c[0], c[1], c[2], c[3]);
        }
        for (int ph = PROBE_PH + 1; ph < 2 * NPH; ++ph) { p.ph_lo = ph; p.ph_hi = ph + 1; hipLaunchKernelGGL(hybrid_fwd, dim3(grid), dim3(512), LDS_TOTAL, stream, p); }
        hipLaunchKernelGGL(probe_mark, dim3(1024), dim3(512), 0, stream, (float*)d_out, (const unsigned long long*)cks, PROBE_PH + 1);
    }
#elif defined(PROBE_K)
    for (int ph = 0; ph < PROBE_K; ++ph) { p.ph_lo = ph; p.ph_hi = ph + 1; hipLaunchKernelGGL(hybrid_fwd, dim3(grid), dim3(512), LDS_TOTAL, stream, p); }
    {
        unsigned char* ws = (unsigned char*)d_ws; DumpSeg z{nullptr, 0, 0}; DumpSeg s[6] = {z, z, z, z, z, z};
        const size_t NT = (size_t)T_TOK;
#if PROBE_K == 1
        s[0] = {ws + WS_XN, NT * 1024, 0}; s[1] = {ws + WS_WB, 27 * MiB / 2, 0}; s[2] = {ws + WS_MEMN, 4096 * 1024, 0}; s[3] = {ws + WS_CTL + CTL_BTAB, 1024, 1};
#elif PROBE_K == 2
        s[0] = {ws + WS_R + R_H, NT * HN, 0}; s[1] = {ws + WS_R + R_VT, 768 * NT, 0}; s[2] = {ws + WS_MK, 4096 * 512, 0}; s[3] = {ws + WS_MVT, 512 * 4096, 0};
#elif PROBE_K == 3
        s[0] = {ws + WS_R + R_H, NT * HN, 0}; s[1] = {ws + WS_YB, NT * 512, 0}; s[2] = {ws + WS_MK, 4096 * 512, 0}; s[3] = {ws + WS_MASK, NT * 128, 2};
#elif PROBE_K == 4
        s[0] = {ws + WS_YA, NT * 512, 0}; s[1] = {ws + WS_YC, NT * 512, 0};
#elif PROBE_K == 5
        s[0] = {ws + WS_R + R_G, NT * 3072, 0};
#elif PROBE_K == 6
        s[0] = {ws + WS_R + R_MERGED, NT * 1024, 0};
#elif PROBE_K == 7
        s[0] = {d_out, NT * 1024, 1};
#elif PROBE_K == 9
        s[0] = {ws + WS_YA, NT * 512, 0}; s[1] = {ws + WS_XN, NT * 1024, 0};
#elif PROBE_K == 10
        s[0] = {ws + WS_YB, NT * 512, 0};
#elif PROBE_K == 11
        s[0] = {d_out, NT * 1024, 1};
#elif PROBE_K == 12
        s[0] = {ws + WS_YA, NT * 512, 0}; s[1] = {ws + WS_YB, NT * 512, 0}; s[2] = {ws + WS_XN, NT * 1024, 0};
#elif PROBE_K == 13
        s[0] = {ws + WS_R + R_PS, NT * 2048, 1};
#elif PROBE_K == 14
        s[0] = {ws + WS_YC, NT * 128, 3}; s[1] = {ws + WS_YC + 16 * MiB, NT * 128, 1};
#endif
        hipLaunchKernelGGL(probe_dump, dim3(1024), dim3(512), 0, stream, (float*)d_out, s[0], s[1], s[2], s[3], s[4], s[5]);
    }
#elif MK_MULTI
    for (int ph = 0; ph < NPH * NLAYER; ++ph) { p.ph_lo = ph; p.ph_hi = ph + 1; hipLaunchKernelGGL(hybrid_fwd, dim3(grid), dim3(512), LDS_TOTAL, stream, p); }
#else
    p.ph_lo = 0; p.ph_hi = NPH * NLAYER;
    hipLaunchKernelGGL(hybrid_fwd, dim3(grid), dim3(512), LDS_TOTAL, stream, p);
#endif
}
```

```cpp
#define MK_MULTI 0
#include <hip/hip_runtime.h>
#include <cstdio>
#include <cstdint>
#define XB_TMO      128
#define XB_XCNT(j)  (256  + 64 * (j))
#define XB_XSUB(j)  (1280 + 64 * (j))
#define XB_XGEN(j)  (2304 + 64 * (j))
#define XB_TOP      3328
#define XB_TOPGEN   3392
#define XCD_BAR_WORDS 3456
#define XB_SPIN_CAP (1u << 18)
#define LAS __attribute__((address_space(3)))

__device__ __forceinline__ unsigned xb_ld(unsigned* p)              { return __hip_atomic_load(p, __ATOMIC_RELAXED, __HIP_MEMORY_SCOPE_AGENT); }
__device__ __forceinline__ unsigned xb_add(unsigned* p, unsigned v) { return __hip_atomic_fetch_add(p, v, __ATOMIC_RELAXED, __HIP_MEMORY_SCOPE_AGENT); }
__device__ __forceinline__ unsigned xb_xcc_id() { return (unsigned)__builtin_amdgcn_s_getreg((3 << 11) | 20) & 0xFu; }
#define XB_SPIN(cond, bar) do { unsigned _sp = 0; while (cond) { __builtin_amdgcn_s_sleep(1); \
    if ((++_sp & 255u) == 0u) { if (xb_ld(&(bar)[XB_TMO])) break; if (_sp > XB_SPIN_CAP) { atomicAdd(&(bar)[XB_TMO], 1u); break; } } } } while (0)

struct XcdBarrier {
    unsigned* bar; unsigned x;
    volatile LAS unsigned* st;
};

__device__ __forceinline__ XcdBarrier xcd_barrier_post(unsigned* bar, volatile LAS unsigned* st) {
    XcdBarrier b; b.bar = bar; b.x = xb_xcc_id(); b.st = st;
    if (threadIdx.x == 0) st[2] = xb_add(&bar[XB_XCNT(b.x)], 1u) + 1u;
    return b;
}
__device__ __forceinline__ void xcd_barrier_complete(unsigned* bar, unsigned x, unsigned& nloc, unsigned& nx) {
    const unsigned G = gridDim.x * gridDim.y * gridDim.z;
    unsigned sum, cnt, mine, sp = 0u;
    for (;;) {
        sum = 0u; cnt = 0u; mine = 0u;
#pragma unroll
        for (unsigned j = 0; j < 16; ++j) { const unsigned c = xb_ld(&bar[XB_XCNT(j)]); sum += c; cnt += (c > 0u) ? 1u : 0u; mine = (j == x) ? c : mine; }
        if (sum == G) break;
        __builtin_amdgcn_s_sleep(1);
        if ((++sp & 255u) == 0u) { if (xb_ld(&bar[XB_TMO])) break; if (sp > XB_SPIN_CAP) { atomicAdd(&bar[XB_TMO], 1u); break; } }
    }
    nloc = mine > 0u ? mine : 1u; nx = cnt > 0u ? cnt : 1u;
}

__device__ __forceinline__ void xcd_barrier(const XcdBarrier& b) {
    asm volatile("s_waitcnt vmcnt(0)" ::: "memory");
    __syncthreads();
    if (threadIdx.x == 0) {
        unsigned* bar = b.bar;
        __builtin_amdgcn_s_waitcnt(0);
        unsigned nloc = b.st[0], nx = b.st[1];
        if (nloc == 0u) { xcd_barrier_complete(bar, b.x, nloc, nx); b.st[0] = nloc; b.st[1] = nx; }
        const unsigned old = xb_add(&bar[XB_XSUB(b.x)], 1u);
        const unsigned gen = old / nloc;
        if (old + 1u == (gen + 1u) * nloc) {
            __builtin_amdgcn_fence(__ATOMIC_RELEASE, "agent");
            asm volatile("s_waitcnt vmcnt(0)" ::: "memory");
            const unsigned og = xb_add(&bar[XB_TOP], 1u);
            const unsigned tg = og / nx;
            if (og + 1u == (tg + 1u) * nx) xb_add(&bar[XB_TOPGEN], 1u);
            else XB_SPIN(xb_ld(&bar[XB_TOPGEN]) == tg, bar);
            __builtin_amdgcn_fence(__ATOMIC_ACQUIRE, "agent");
            xb_add(&bar[XB_XGEN(b.x)], 1u);
            asm volatile("s_waitcnt vmcnt(0)" ::: "memory");
        } else {
            XB_SPIN(xb_ld(&bar[XB_XGEN(b.x)]) == gen, bar);
            __builtin_amdgcn_fence(__ATOMIC_ACQUIRE, "agent");
            asm volatile("s_waitcnt vmcnt(0)" ::: "memory");
        }
    }
    __syncthreads();
}
namespace pg8 {
#define PG8_LAS __attribute__((address_space(3)))
typedef unsigned short bf16_t;
typedef short bf16x8 __attribute__((ext_vector_type(8)));
typedef float f32x4 __attribute__((ext_vector_type(4)));
typedef unsigned u32x4 __attribute__((ext_vector_type(4)));
constexpr int BM = 256, BK = 64, HALF = 128, HTB = HALF * BK * 2  , STAGE_BYTES = 8 * HTB, NXCD = 8, WGM = 8;

__host__ __device__ __forceinline__ int lds_byte(int r, int c) { const int st = (r >> 4) * 2 + (c >> 5), rr = r & 15, cc = c & 31, ob = rr * 64 + cc * 2; return st * 1024 + (ob ^ (((ob >> 9) & 1) << 5)); }
__host__ __device__ __forceinline__ void stage_rc(int b, int& R, int& C) { const int st = b / 1024, sb = b % 1024, swz = sb ^ (((sb >> 9) & 1) << 5); R = (st >> 1) * 16 + swz / 64; C = (st & 1) * 32 + (swz % 64) / 2; }
__host__ __device__ __forceinline__ int perm32(int rho) { const int n = rho >> 4, i = rho & 15; return 8 * (i >> 2) + 4 * n + (i & 3); }

struct Unit { int pm, pn; };
struct Gemm { const bf16_t* A; const bf16_t* Bt; int M, N, K; };
struct StaticOrder {
    int nM, nN, nwg, G, c;
    __host__ __device__ void init(int M, int N, int G_, int c_) { nM = M / BM; nN = N / BM; nwg = nM * nN; G = G_; c = c_; }
    __host__ __device__ bool next(int i, Unit& u) const {
        const long L = (long)i * G + c; if (L >= nwg) return false;
        int wgid = (int)L; { const int q = nwg / NXCD, r = nwg % NXCD, xcd = wgid % NXCD, off = wgid / NXCD; wgid = (xcd < r ? xcd * (q + 1) : r * (q + 1) + (xcd - r) * q) + off; }
        const int nig = WGM * nN, gid = wgid / nig, fm = gid * WGM, gsz = (nM - fm) < WGM ? (nM - fm) : WGM;
        u.pm = fm + ((wgid % nig) % gsz); u.pn = (wgid % nig) / gsz; return true;
    }
    __device__ __forceinline__ void a_ready(const Unit&) const {}
    __device__ __forceinline__ void done(const Unit&) const {}
};
__device__ __forceinline__ unsigned cvt_pk_bf16(float lo, float hi) { unsigned r; asm volatile("v_cvt_pk_bf16_f32 %0, %1, %2" : "=v"(r) : "v"(lo), "v"(hi)); return r; }
typedef float f32x2 __attribute__((ext_vector_type(2)));
__device__ __forceinline__ f32x2 gelu_pk(f32x2 v) {
    const f32x2 av = __builtin_elementwise_abs(v), d = av * 0.2316418882f + 1.0f;
    f32x2 t; t.x = __builtin_amdgcn_rcpf(d.x); t.y = __builtin_amdgcn_rcpf(d.y);
    f32x2 q = t * 0.5307027145f + (-0.7265760135f); q = q * t + 0.7107068705f; q = q * t + (-0.142248368f); q = q * t + 0.127414796f; q = q * t;
    const f32x2 s = (v * v) * (-0.72134752044f);
    f32x2 e; e.x = __builtin_amdgcn_exp2f(s.x); e.y = __builtin_amdgcn_exp2f(s.y);
    const f32x2 m = v * (q * e), r = v - m;
    f32x2 o; o.x = v.x < 0.f ? m.x : r.x; o.y = v.y < 0.f ? m.y : r.y; return o;
}

template <class Epi, class Sched, bool STAMP = false>
__device__ __forceinline__ void gemm_phase(PG8_LAS unsigned char* lds, const Gemm g, const Sched& S, const Epi& E, unsigned long long* stamps) {
    int tid_l = threadIdx.x; asm volatile("" : "+v"(tid_l)); const int tid = tid_l, wid = __builtin_amdgcn_readfirstlane(tid >> 6), lane = tid & 63, wr = wid >> 2, wc = wid & 3, fr = lane & 15, fq = lane >> 4;
    const int K = g.K, nt = K / BK;
    int ts_lo = 0, ts_hi = 0, nts = 0; const unsigned long long rt_entry = STAMP ? (unsigned long long)wall_clock64() : 0ull;
#define PG8_STAMP() do { if (STAMP && wid == 0 && nts < 64) { const unsigned long long _c = (unsigned long long)clock64(); \
        ts_lo = (lane == nts) ? (int)(unsigned)_c : ts_lo; ts_hi = (lane == nts) ? (int)(unsigned)(_c >> 32) : ts_hi; ++nts; } } while (0)
    PG8_STAMP();
    unsigned voffA[2], voffB[2];
#pragma unroll
    for (int i = 0; i < 2; ++i) { int R, C; stage_rc(tid * 16 + i * 8192, R, C); const int Rb = Epi::PERM ? ((R & ~31) + perm32(R & 31)) : R;
        voffA[i] = (unsigned)(R * K + C) * 2u; voffB[i] = (unsigned)(Rb * K + C) * 2u; }
    const size_t kstep = (size_t)(BK * 2);
    const size_t hstep = (size_t)HALF * K * 2;
    const size_t tstep = 2 * hstep;
    const unsigned ldsw = (unsigned)wid * 1024u;
    const int aoff = lds_byte(wr * 64 + fr, fq * 8), boff = lds_byte(wc * 32 + fr, fq * 8);
#define PG8_SA(b, h) (((b) * 2 + (h)) * HTB)
#define PG8_SB(b, h) ((4 + (b) * 2 + (h)) * HTB)
#define PG8_STAGE(bufoff, gbase, voff) do { _Pragma("unroll") for (int _i = 0; _i < 2; ++_i) \
        __builtin_amdgcn_global_load_lds((const unsigned*)((const char*)(gbase) + (voff)[_i]), (PG8_LAS unsigned*)(lds + (bufoff) + ldsw + _i * 8192), 16, 0, 0); } while (0)
#define PG8_LDA(dst, b, h) do { _Pragma("unroll") for (int m = 0; m < 4; ++m) _Pragma("unroll") for (int k = 0; k < 2; ++k) dst[m][k] = *(const PG8_LAS bf16x8*)(lds + PG8_SA(b, h) + aoff + m * 2048 + k * 1024); } while (0)
#define PG8_LDB(dst, b, h) do { _Pragma("unroll") for (int n = 0; n < 2; ++n) _Pragma("unroll") for (int k = 0; k < 2; ++k) dst[n][k] = *(const PG8_LAS bf16x8*)(lds + PG8_SB(b, h) + boff + n * 2048 + k * 1024); } while (0)
#define PG8_MMA(ai, bj, At, Bt) do { __builtin_amdgcn_s_setprio(1); _Pragma("unroll") for (int m = 0; m < 4; ++m) _Pragma("unroll") for (int n = 0; n < 2; ++n) _Pragma("unroll") for (int k = 0; k < 2; ++k) \
        acc[ai][bj][m][n] = __builtin_amdgcn_mfma_f32_16x16x32_bf16(Bt[n][k], At[m][k], acc[ai][bj][m][n], 0, 0, 0); __builtin_amdgcn_s_setprio(0); } while (0)
#define PG8_WAIT_V(n) asm volatile("s_waitcnt vmcnt(" #n ")" ::: "memory")
#define PG8_WAIT_L(n) asm volatile("s_waitcnt lgkmcnt(" #n ")" ::: "memory")
#define PG8_BAR __builtin_amdgcn_s_barrier()
#define PG8_SCHED __builtin_amdgcn_sched_barrier(0)
    Unit cur, nxt; int ui = 0;
    if (!S.next(0, cur)) return;
    f32x4 acc[2][2][4][2];
#pragma unroll
    for (int a = 0; a < 2; ++a)
#pragma unroll
        for (int b = 0; b < 2; ++b)
#pragma unroll
            for (int m = 0; m < 4; ++m)
#pragma unroll
                for (int n = 0; n < 2; ++n) acc[a][b][m][n] = (f32x4){0.f, 0.f, 0.f, 0.f};
    bf16x8 At[4][2], B0[2][2], B1[2][2];
    const char* cA = (const char*)g.A + (size_t)cur.pm * tstep; const char* cB = (const char*)g.Bt + (size_t)cur.pn * tstep;
    S.a_ready(cur);
    PG8_STAGE(PG8_SB(0, 0), cB, voffB); PG8_STAGE(PG8_SA(0, 0), cA, voffA); PG8_STAGE(PG8_SB(0, 1), cB + hstep, voffB); PG8_STAGE(PG8_SA(0, 1), cA + hstep, voffA);
    if (wr == 1) PG8_BAR;
    PG8_WAIT_V(4); PG8_BAR;
    PG8_STAGE(PG8_SB(1, 0), cB + kstep, voffB); PG8_STAGE(PG8_SA(1, 0), cA + kstep, voffA); PG8_STAGE(PG8_SB(1, 1), cB + hstep + kstep, voffB);
    PG8_WAIT_V(6); PG8_BAR;
    PG8_STAMP();
    for (;;) {
        const bool has_next = S.next(ui + 1, nxt);
        const char* nA = has_next ? (const char*)g.A + (size_t)nxt.pm * tstep : cA; const char* nB = has_next ? (const char*)g.Bt + (size_t)nxt.pn * tstep : cB;
        for (int t = 0; t < nt; t += 2) {
            const bool last = (t == nt - 2);
            const char* a1 = cA + (size_t)(t + 1) * kstep;
            const char* a2 = last ? nA : cA + (size_t)(t + 2) * kstep; const char* b2 = last ? nB : cB + (size_t)(t + 2) * kstep;
            const char* a3 = a2 + kstep; const char* b3 = b2 + kstep;
            if (last && has_next) S.a_ready(nxt);
            PG8_LDB(B0, 0, 0); PG8_SCHED; PG8_LDA(At, 0, 0); PG8_STAGE(PG8_SA(1, 1), a1 + hstep, voffA);
            PG8_WAIT_L(8); PG8_BAR; PG8_WAIT_L(0); PG8_MMA(0, 0, At, B0); PG8_BAR; PG8_SCHED;
            PG8_LDB(B1, 0, 1); PG8_STAGE(PG8_SB(0, 0), b2, voffB);
            PG8_BAR; PG8_WAIT_L(0); PG8_MMA(0, 1, At, B1); PG8_BAR;
            PG8_LDA(At, 0, 1); PG8_STAGE(PG8_SA(0, 0), a2, voffA);
            PG8_BAR; PG8_WAIT_L(0); PG8_MMA(1, 0, At, B0); PG8_BAR; PG8_SCHED;
            PG8_STAGE(PG8_SB(0, 1), b2 + hstep, voffB);
            PG8_WAIT_V(6); PG8_BAR; PG8_MMA(1, 1, At, B1); PG8_BAR;
            PG8_LDB(B0, 1, 0); PG8_SCHED; PG8_LDA(At, 1, 0); PG8_STAGE(PG8_SA(0, 1), a2 + hstep, voffA);
            PG8_WAIT_L(8); PG8_BAR; PG8_WAIT_L(0); PG8_MMA(0, 0, At, B0); PG8_BAR; PG8_SCHED;
            PG8_LDB(B1, 1, 1); PG8_STAGE(PG8_SB(1, 0), b3, voffB);
            PG8_BAR; PG8_WAIT_L(0); PG8_MMA(0, 1, At, B1); PG8_BAR;
            PG8_LDA(At, 1, 1); PG8_STAGE(PG8_SA(1, 0), a3, voffA);
            PG8_BAR; PG8_WAIT_L(0); PG8_MMA(1, 0, At, B0); PG8_BAR; PG8_SCHED;
            PG8_STAGE(PG8_SB(1, 1), b3 + hstep, voffB);
            PG8_WAIT_V(6); PG8_BAR; PG8_MMA(1, 1, At, B1); PG8_BAR;
        }
        PG8_STAMP();
        if constexpr (!Epi::AFTER_DRAIN) { E(acc, cur, wr, wc, fr, fq); S.done(cur); }
        PG8_STAMP();
        if (!has_next) break;
#pragma unroll
        for (int a = 0; a < 2; ++a)
#pragma unroll
            for (int b = 0; b < 2; ++b)
#pragma unroll
                for (int m = 0; m < 4; ++m)
#pragma unroll
                    for (int n = 0; n < 2; ++n) acc[a][b][m][n] = (f32x4){0.f, 0.f, 0.f, 0.f};
        cur = nxt; cA = nA; cB = nB; ++ui;
    }
    PG8_WAIT_V(0);
    if (wr == 0) PG8_BAR;
    PG8_BAR;
    if constexpr (Epi::AFTER_DRAIN) { E.fused(acc, cur, wr, wc, fr, fq, lds, wid, lane); S.done(cur); }
    PG8_STAMP();
    if (STAMP && wid == 0) { stamps[lane] = lane < nts ? (((unsigned long long)(unsigned)ts_hi << 32) | (unsigned)ts_lo) : 0ull;
        if (lane == 62) stamps[62] = rt_entry; if (lane == 63) stamps[63] = (unsigned long long)wall_clock64(); }
#undef PG8_STAMP
#undef PG8_SA
#undef PG8_SB
#undef PG8_STAGE
#undef PG8_LDA
#undef PG8_LDB
#undef PG8_MMA
#undef PG8_WAIT_V
#undef PG8_WAIT_L
#undef PG8_BAR
#undef PG8_SCHED
}
}

using pg8::bf16_t; using pg8::bf16x8; using pg8::f32x4; using pg8::u32x4;
typedef unsigned u32x2 __attribute__((ext_vector_type(2)));
typedef __bf16 bf16x2v __attribute__((ext_vector_type(2)));
__device__ __forceinline__ unsigned cvt_pk_bf16(float lo, float hi) { bf16x2v v; v.x = (__bf16)lo; v.y = (__bf16)hi; return __builtin_bit_cast(unsigned, v); }
#define NEG_INF (-__builtin_inff())
constexpr int T_TOK = 32768, DM = 1024, SEQ = 2048, NB = 16, MEMLEN = 256;
constexpr int HN = 3328;
constexpr int HC_QA = 0, HC_KA = 512, HC_ZU = 1024, HC_ZV = 1536, HC_CQ = 2048, HC_IQ = 2560, HC_CK = 3072, HC_IK = 3200, HC_IW = 3264;
constexpr int DIN = 6984;
constexpr float EPSF = 1e-6f, LOG2E = 1.4426950408889634f;
constexpr size_t MiB = 1048576;
constexpr size_t WS_CTL = 0, CTL_BTAB = 65536, CTL_LAM = 73728;
constexpr size_t WS_WB = 1 * MiB;
constexpr size_t WB_WIN = 0, WB_WV = 6815744, WB_WG = 8 * MiB, WB_BRA = 14 * MiB, WB_BRB = 15 * MiB, WB_BRC = 16 * MiB, WB_OUT = 17 * MiB,
                 WB_MQ = 19 * MiB, WB_MK = 20 * MiB, WB_MV = 21 * MiB, WB_MO = 22 * MiB, WB_PS = 23 * MiB;
constexpr size_t WS_MEMN = 29 * MiB, WS_MK = 37 * MiB, WS_MVT = 41 * MiB, WS_MASK = 45 * MiB, WS_XN = 53 * MiB, WS_R = 117 * MiB;
constexpr size_t R_H = 0, R_VT = 208 * MiB, R_G = 0, R_MERGED = 192 * MiB, R_PS = 0;
constexpr size_t WS_YA = 373 * MiB, WS_YB = 405 * MiB, WS_YC = 437 * MiB, WS_END = 469 * MiB;
constexpr int LDS_TOTAL = 163840, LDS_BAR_OFF = 163840 - 16;

struct Params { const float* in[34]; float* out; unsigned char* ws; int ph_lo, ph_hi, rep_ph, rep_n, rep_var, pad0; };
enum { I_X = 0, I_MEM, I_RELB, I_NORM_MIX, I_W_IN, I_AQG, I_AKG, I_LQ1, I_LK1, I_LQ2, I_LK2, I_SUBLN, I_BVG, I_BWS, I_BBS, I_CQG, I_CKG, I_WBRA, I_WBRB, I_WBRC,
       I_WOUT, I_NORM_MEM, I_NORM_MEMSRC, I_MWQ, I_MWKV, I_MQG, I_MKG, I_MWO, I_NORM_PEER, I_PWQ, I_SK1, I_SK2, I_PU, I_PV };

__device__ __forceinline__ int fresh_tid() { int t = threadIdx.x; asm volatile("" : "+v"(t)); return t; }
__device__ __forceinline__ int fresh_bid() { int b = blockIdx.x; asm volatile("" : "+s"(b)); return b; }
typedef __attribute__((address_space(1))) unsigned char* gptr_t;
__device__ __forceinline__ const Params& fresh_kp() { unsigned long long v = (unsigned long long)__builtin_amdgcn_kernarg_segment_ptr(); asm volatile("" : "+s"(v)); return *(const Params*)(const __attribute__((address_space(4))) Params*)v; }
__device__ __forceinline__ unsigned char* fresh_ptr(unsigned char* q) { unsigned long long v = (unsigned long long)q; asm volatile("" : "+s"(v)); return (unsigned char*)(gptr_t)v; }
__device__ __forceinline__ float shx(float v, int m, int lane) { return __uint_as_float((unsigned)__builtin_amdgcn_ds_bpermute((lane ^ m) << 2, (int)__float_as_uint(v))); }
__device__ __forceinline__ unsigned shxu(unsigned v, int m, int lane) { return (unsigned)__builtin_amdgcn_ds_bpermute((lane ^ m) << 2, (int)v); }
#define SHX(v, m) shx((v), (m), lane)
__device__ __forceinline__ float bf_lo(unsigned w) { return __uint_as_float(w << 16); }
__device__ __forceinline__ float bf_hi(unsigned w) { return __uint_as_float(w & 0xffff0000u); }
__device__ __forceinline__ float bf2f(bf16_t b) { return __uint_as_float(((unsigned)b) << 16); }
__device__ __forceinline__ bf16_t f2bf(float f) { return (bf16_t)(cvt_pk_bf16(f, 0.f) & 0xffffu); }
__device__ __forceinline__ float wave_sum(float v, int lane) { v += shx(v, 32, lane); v += shx(v, 16, lane); v += shx(v, 8, lane); v += shx(v, 4, lane); v += shx(v, 2, lane); v += shx(v, 1, lane); return v; }
__device__ __forceinline__ float gelu1(float x) { pg8::f32x2 v; v.x = x; v.y = 0.f; return pg8::gelu_pk(v).x; }
__device__ __forceinline__ unsigned ukey(float f) { const unsigned b = __float_as_uint(f); return (b & 0x80000000u) ? ~b : (b | 0x80000000u); }

typedef f32x4 AccT[2][2][4][2];
struct EpiStore {
    static constexpr bool PERM = true, AFTER_DRAIN = false;
    bf16_t* O; int ldc;
    __device__ __forceinline__ void operator()(const f32x4 (&acc)[2][2][4][2], const pg8::Unit& u, int wr, int wc, int fr, int fq) const {
        const int row0 = u.pm * 256 + wr * 64 + fr, col0 = u.pn * 256 + wc * 32 + 8 * fq;
#pragma unroll
        for (int ai = 0; ai < 2; ++ai)
#pragma unroll
            for (int m = 0; m < 4; ++m) { bf16_t* rowp = O + (size_t)(row0 + ai * 128 + m * 16) * ldc + col0;
#pragma unroll
                for (int bj = 0; bj < 2; ++bj) { const f32x4 v0 = acc[ai][bj][m][0], v1 = acc[ai][bj][m][1];
                    u32x4 w; w.x = cvt_pk_bf16(v0[0], v0[1]); w.y = cvt_pk_bf16(v0[2], v0[3]); w.z = cvt_pk_bf16(v1[0], v1[1]); w.w = cvt_pk_bf16(v1[2], v1[3]);
                    *(u32x4*)(rowp + bj * 128) = w; } }
    }
};
struct EpiSigmoid {
    static constexpr bool PERM = true, AFTER_DRAIN = false;
    bf16_t* O; int ldc;
    __device__ __forceinline__ void operator()(const f32x4 (&acc)[2][2][4][2], const pg8::Unit& u, int wr, int wc, int fr, int fq) const {
        const int row0 = u.pm * 256 + wr * 64 + fr, col0 = u.pn * 256 + wc * 32 + 8 * fq;
#pragma unroll
        for (int ai = 0; ai < 2; ++ai)
#pragma unroll
            for (int m = 0; m < 4; ++m) { bf16_t* rowp = O + (size_t)(row0 + ai * 128 + m * 16) * ldc + col0;
#pragma unroll
                for (int bj = 0; bj < 2; ++bj) { f32x4 v0 = acc[ai][bj][m][0], v1 = acc[ai][bj][m][1];
#pragma unroll
                    for (int j = 0; j < 4; ++j) { v0[j] = __builtin_amdgcn_rcpf(1.0f + __builtin_amdgcn_exp2f(-LOG2E * v0[j])); v1[j] = __builtin_amdgcn_rcpf(1.0f + __builtin_amdgcn_exp2f(-LOG2E * v1[j])); }
                    u32x4 w; w.x = cvt_pk_bf16(v0[0], v0[1]); w.y = cvt_pk_bf16(v0[2], v0[3]); w.z = cvt_pk_bf16(v1[0], v1[1]); w.w = cvt_pk_bf16(v1[2], v1[3]);
                    *(u32x4*)(rowp + bj * 128) = w; } }
    }
};
struct EpiBranch {
    static constexpr bool PERM = true, AFTER_DRAIN = false;
    bf16_t* Mg; const bf16_t* G; int br; int first;
    __device__ __forceinline__ void operator()(const f32x4 (&acc)[2][2][4][2], const pg8::Unit& u, int wr, int wc, int fr, int fq) const {
        const int row0 = u.pm * 256 + wr * 64 + fr, col0 = u.pn * 256 + wc * 32 + 8 * fq;
#pragma unroll
        for (int ai = 0; ai < 2; ++ai)
#pragma unroll
            for (int m = 0; m < 4; ++m) { const size_t row = (size_t)(row0 + ai * 128 + m * 16);
#pragma unroll
                for (int bj = 0; bj < 2; ++bj) { const f32x4 v0 = acc[ai][bj][m][0], v1 = acc[ai][bj][m][1];
                    const u32x4 g = *(const u32x4*)(G + row * 3072 + br * 1024 + col0 + bj * 128);
                    u32x4 p; p.x = 0u; p.y = 0u; p.z = 0u; p.w = 0u;
                    if (!first) p = *(const u32x4*)(Mg + row * 1024 + col0 + bj * 128);
                    u32x4 w;
                    w.x = cvt_pk_bf16(bf_lo(p.x) + bf_lo(g.x) * v0[0], bf_hi(p.x) + bf_hi(g.x) * v0[1]);
                    w.y = cvt_pk_bf16(bf_lo(p.y) + bf_lo(g.y) * v0[2], bf_hi(p.y) + bf_hi(g.y) * v0[3]);
                    w.z = cvt_pk_bf16(bf_lo(p.z) + bf_lo(g.z) * v1[0], bf_hi(p.z) + bf_hi(g.z) * v1[1]);
                    w.w = cvt_pk_bf16(bf_lo(p.w) + bf_lo(g.w) * v1[2], bf_hi(p.w) + bf_hi(g.w) * v1[3]);
                    *(u32x4*)(Mg + row * 1024 + col0 + bj * 128) = w; } }
    }
};
struct EpiResid {
    static constexpr bool PERM = false, AFTER_DRAIN = false;
    const float* base; float* out; int ldc;
    __device__ __forceinline__ void operator()(const f32x4 (&acc)[2][2][4][2], const pg8::Unit& u, int wr, int wc, int fr, int fq) const {
        const int row0 = u.pm * 256 + wr * 64 + fr, col0 = u.pn * 256 + wc * 32 + 4 * fq;
#pragma unroll
        for (int ai = 0; ai < 2; ++ai)
#pragma unroll
            for (int m = 0; m < 4; ++m) { const size_t off = (size_t)(row0 + ai * 128 + m * 16) * ldc + col0;
#pragma unroll
                for (int bj = 0; bj < 2; ++bj)
#pragma unroll
                    for (int n = 0; n < 2; ++n) { const f32x4 b = *(const f32x4*)(base + off + bj * 128 + n * 16); *(f32x4*)(out + off + bj * 128 + n * 16) = b + acc[ai][bj][m][n]; } }
    }
};
struct EpiF32Store {
    static constexpr bool PERM = false, AFTER_DRAIN = false;
    float* C; int ldc;
    __device__ __forceinline__ void operator()(const f32x4 (&acc)[2][2][4][2], const pg8::Unit& u, int wr, int wc, int fr, int fq) const {
        const int row0 = u.pm * 256 + wr * 64 + fr, col0 = u.pn * 256 + wc * 32 + 4 * fq;
#pragma unroll
        for (int ai = 0; ai < 2; ++ai)
#pragma unroll
            for (int m = 0; m < 4; ++m) { const size_t off = (size_t)(row0 + ai * 128 + m * 16) * ldc + col0;
#pragma unroll
                for (int bj = 0; bj < 2; ++bj)
#pragma unroll
                    for (int n = 0; n < 2; ++n) *(f32x4*)(C + off + bj * 128 + n * 16) = acc[ai][bj][m][n]; }
    }
};
typedef _Float16 f16x4 __attribute__((ext_vector_type(4)));
struct EpiF16Store {
    static constexpr bool PERM = false, AFTER_DRAIN = false;
    _Float16* C; int ldc;
    __device__ __forceinline__ void operator()(const f32x4 (&acc)[2][2][4][2], const pg8::Unit& u, int wr, int wc, int fr, int fq) const {
        const int row0 = u.pm * 256 + wr * 64 + fr, col0 = u.pn * 256 + wc * 32 + 4 * fq;
#pragma unroll
        for (int ai = 0; ai < 2; ++ai)
#pragma unroll
            for (int m = 0; m < 4; ++m) { const size_t off = (size_t)(row0 + ai * 128 + m * 16) * ldc + col0;
#pragma unroll
                for (int bj = 0; bj < 2; ++bj)
#pragma unroll
                    for (int n = 0; n < 2; ++n) { const f32x4 v = acc[ai][bj][m][n]; *(f16x4*)(C + off + bj * 128 + n * 16) = (f16x4){(_Float16)v[0], (_Float16)v[1], (_Float16)v[2], (_Float16)v[3]}; } }
    }
};
template <class Epi>
__device__ __forceinline__ void run_gemm(LAS unsigned char* lds, const bf16_t* A, const bf16_t* Bt, int M, int N, int K, int cshift, const Epi& E) {
    pg8::Gemm g{A, Bt, M, N, K}; pg8::StaticOrder S; S.init(M, N, (int)gridDim.x, (int)((blockIdx.x + cshift) % gridDim.x));
    pg8::gemm_phase<Epi, pg8::StaticOrder, false>(lds, g, S, E, nullptr);
    __syncthreads();
}

__device__ __forceinline__ void conv_transpose(LAS unsigned char* lds, const float* src, int ld_src, int col0, int ncols, bf16_t* dst, int K, int nrows) {
    LAS float* tl = (LAS float*)lds;
    const int tid = fresh_tid(), ntk = K / 64, ntiles = (nrows / 64) * ntk;
    for (int tile = blockIdx.x; tile < ntiles; tile += gridDim.x) {
        const int n0 = (tile / ntk) * 64, k0 = (tile % ntk) * 64;
#pragma unroll
        for (int p = 0; p < 2; ++p) { const int kk = (tid >> 4) + 32 * p, n4 = (tid & 15) * 4;
            f32x4 v = (f32x4){0.f, 0.f, 0.f, 0.f};
            if (n0 + n4 < ncols) v = *(const f32x4*)(src + (size_t)(k0 + kk) * ld_src + col0 + n0 + n4);
            tl[kk * 65 + n4 + 0] = v[0]; tl[kk * 65 + n4 + 1] = v[1]; tl[kk * 65 + n4 + 2] = v[2]; tl[kk * 65 + n4 + 3] = v[3]; }
        __syncthreads();
        { const int n = tid >> 3, kc = (tid & 7) * 8; float f[8];
#pragma unroll
            for (int j = 0; j < 8; ++j) f[j] = tl[(kc + j) * 65 + n];
            u32x4 w; w.x = cvt_pk_bf16(f[0], f[1]); w.y = cvt_pk_bf16(f[2], f[3]); w.z = cvt_pk_bf16(f[4], f[5]); w.w = cvt_pk_bf16(f[6], f[7]);
            *(u32x4*)(dst + (size_t)(n0 + n) * K + k0 + kc) = w; }
        __syncthreads();
    }
}
__device__ __forceinline__ void rmsnorm_rows(const float* x, const float* g, bf16_t* out, int rows) {
    const int tid = fresh_tid(); const int lane = tid & 63, gw = blockIdx.x * 8 + (tid >> 6), nw = gridDim.x * 8;
    f32x4 gv[4];
#pragma unroll
    for (int i = 0; i < 4; ++i) gv[i] = *(const f32x4*)(g + 4 * lane + 256 * i);
    for (int r = gw; r < rows; r += nw) {
        f32x4 v[4]; float ss = 0.f;
#pragma unroll
        for (int i = 0; i < 4; ++i) { v[i] = *(const f32x4*)(x + (size_t)r * 1024 + 4 * lane + 256 * i); ss += v[i][0] * v[i][0] + v[i][1] * v[i][1] + v[i][2] * v[i][2] + v[i][3] * v[i][3]; }
        ss = wave_sum(ss, lane);
        const float sc = rsqrtf(ss * (1.0f / 1024.0f) + EPSF);
#pragma unroll
        for (int i = 0; i < 4; ++i) { u32x2 w; w.x = cvt_pk_bf16(v[i][0] * sc * gv[i][0], v[i][1] * sc * gv[i][1]); w.y = cvt_pk_bf16(v[i][2] * sc * gv[i][2], v[i][3] * sc * gv[i][3]);
            *(u32x2*)(out + (size_t)r * 1024 + 4 * lane + 256 * i) = w; }
    }
}
__device__ __forceinline__ void peer_fuse_weights(LAS unsigned char* lds, const float* pwq  , const float* sk1, const float* sk2  , bf16_t* dst  ) {
    LAS float* Pt = (LAS float*)lds;
    LAS float* Sk = (LAS float*)(lds + 64 * 129 * 4);
    const int tid = fresh_tid();
    for (int item = blockIdx.x; item < 256; item += gridDim.x) {
        const int hh = item >> 4, k0 = (item & 15) * 64; const float* sk = (hh & 1) ? sk2 : sk1;
        for (int e = tid; e < 64 * 32; e += 512) { const int kk = e >> 5, d4 = (e & 31) * 4; const f32x4 v = *(const f32x4*)(pwq + (size_t)(k0 + kk) * 2048 + hh * 128 + d4);
            Pt[kk * 129 + d4] = v[0]; Pt[kk * 129 + d4 + 1] = v[1]; Pt[kk * 129 + d4 + 2] = v[2]; Pt[kk * 129 + d4 + 3] = v[3]; }
        for (int e = tid; e < 128 * 32; e += 512) { const int n = e >> 5, d4 = (e & 31) * 4; const f32x4 v = *(const f32x4*)(sk + (size_t)n * 128 + d4);
            Sk[n * 129 + d4] = v[0]; Sk[n * 129 + d4 + 1] = v[1]; Sk[n * 129 + d4 + 2] = v[2]; Sk[n * 129 + d4 + 3] = v[3]; }
        __syncthreads();
        { const int n = tid & 127, kg = __builtin_amdgcn_readfirstlane(tid >> 7); float acc[16];
#pragma unroll
            for (int j = 0; j < 16; ++j) acc[j] = 0.f;
            for (int d = 0; d < 128; ++d) { const float s = Sk[n * 129 + d];
#pragma unroll
                for (int j = 0; j < 16; ++j) acc[j] = __builtin_fmaf(Pt[(kg * 16 + j) * 129 + d], s, acc[j]); }
            u32x4 w0, w1; w0.x = cvt_pk_bf16(acc[0], acc[1]); w0.y = cvt_pk_bf16(acc[2], acc[3]); w0.z = cvt_pk_bf16(acc[4], acc[5]); w0.w = cvt_pk_bf16(acc[6], acc[7]);
            w1.x = cvt_pk_bf16(acc[8], acc[9]); w1.y = cvt_pk_bf16(acc[10], acc[11]); w1.z = cvt_pk_bf16(acc[12], acc[13]); w1.w = cvt_pk_bf16(acc[14], acc[15]);
            bf16_t* o = dst + (size_t)(hh * 128 + n) * 1024 + k0 + kg * 16; *(u32x4*)o = w0; *(u32x4*)(o + 8) = w1; }
        __syncthreads();
    }
}
__device__ __forceinline__ void make_tables(const Params& p) {
    unsigned char* const wsl = fresh_ptr(p.ws);
    if (blockIdx.x != 0) return;
    const int tidm = fresh_tid();
    float* btab = (float*)(wsl + WS_CTL + CTL_BTAB); float* lamv = (float*)(wsl + WS_CTL + CTL_LAM);
    const float* rb = p.in[I_RELB];
    for (int e = tidm; e < 8 * 128; e += 512) { const int hd = e >> 7, d = e & 127; int bk;
        if (d < 16) bk = d; else { const float nf = (float)d; int lg = 16 + (int)(logf(nf / 16.0f) / 2.0794415416798357f * 16.0f); bk = lg < 31 ? lg : 31; }
        btab[e] = (rb[bk * 8 + hd] - rb[31 * 8 + hd]) * LOG2E; }
    if (tidm < 128) { const int l = tidm >> 6, lane = tidm & 63;
        float a = p.in[I_LQ1][l * 64 + lane] * p.in[I_LK1][l * 64 + lane], b = p.in[I_LQ2][l * 64 + lane] * p.in[I_LK2][l * 64 + lane];
        a = wave_sum(a, lane); b = wave_sum(b, lane);
        const float lam_init = 0.8f - 0.6f * expf(-0.3f * (float)l);
        if (lane == 0) { lamv[l * 2] = expf(a) - expf(b) + lam_init; lamv[l * 2 + 1] = lam_init; } }
}
__device__ __forceinline__ void prep_weights(const Params& p, LAS unsigned char* lds, int l) {
    unsigned char* const wsl = fresh_ptr(p.ws);
    unsigned char* wb = wsl + WS_WB;
    const float* win = p.in[I_W_IN] + (size_t)l * 1024 * DIN;
    bf16_t* winT = (bf16_t*)(wb + WB_WIN);
    conv_transpose(lds, win, DIN, 0,    512, winT + (size_t)HC_QA * 1024, 1024, 512);
    conv_transpose(lds, win, DIN, 512,  512, winT + (size_t)HC_KA * 1024, 1024, 512);
    conv_transpose(lds, win, DIN, 1536, 512, winT + (size_t)HC_ZU * 1024, 1024, 512);
    conv_transpose(lds, win, DIN, 2048, 512, winT + (size_t)HC_ZV * 1024, 1024, 512);
    conv_transpose(lds, win, DIN, 2560, 512, winT + (size_t)HC_CQ * 1024, 1024, 512);
    conv_transpose(lds, win, DIN, 3328, 512, winT + (size_t)HC_IQ * 1024, 1024, 512);
    conv_transpose(lds, win, DIN, 3072, 128, winT + (size_t)HC_CK * 1024, 1024, 128);
    conv_transpose(lds, win, DIN, 3840, 64,  winT + (size_t)HC_IK * 1024, 1024, 64);
    conv_transpose(lds, win, DIN, 3904, 8,   winT + (size_t)HC_IW * 1024, 1024, 64);
    bf16_t* wvT = (bf16_t*)(wb + WB_WV);
    conv_transpose(lds, win, DIN, 1024, 512, wvT, 1024, 512);
    conv_transpose(lds, win, DIN, 3200, 128, wvT + (size_t)512 * 1024, 1024, 128);
    conv_transpose(lds, win, DIN, 0,    0,   wvT + (size_t)640 * 1024, 1024, 128);
    conv_transpose(lds, win, DIN, 3912, 3072, (bf16_t*)(wb + WB_WG), 1024, 3072);
    conv_transpose(lds, p.in[I_WBRA] + (size_t)l * 512 * 1024, 1024, 0, 1024, (bf16_t*)(wb + WB_BRA), 512, 1024);
    conv_transpose(lds, p.in[I_WBRB] + (size_t)l * 512 * 1024, 1024, 0, 1024, (bf16_t*)(wb + WB_BRB), 512, 1024);
    conv_transpose(lds, p.in[I_WBRC] + (size_t)l * 512 * 1024, 1024, 0, 1024, (bf16_t*)(wb + WB_BRC), 512, 1024);
    conv_transpose(lds, p.in[I_WOUT] + (size_t)l * 1024 * 1024, 1024, 0, 1024, (bf16_t*)(wb + WB_OUT), 1024, 1024);
    conv_transpose(lds, p.in[I_MWQ] + (size_t)l * 1024 * 512, 512, 0, 512, (bf16_t*)(wb + WB_MQ), 1024, 512);
    conv_transpose(lds, p.in[I_MWKV] + (size_t)l * 1024 * 1024, 1024, 0, 512, (bf16_t*)(wb + WB_MK), 1024, 512);
    conv_transpose(lds, p.in[I_MWKV] + (size_t)l * 1024 * 1024, 1024, 512, 512, (bf16_t*)(wb + WB_MV), 1024, 512);
    conv_transpose(lds, p.in[I_MWO] + (size_t)l * 512 * 1024, 1024, 0, 1024, (bf16_t*)(wb + WB_MO), 512, 1024);
    peer_fuse_weights(lds, p.in[I_PWQ] + (size_t)l * 1024 * 2048, p.in[I_SK1] + (size_t)l * 128 * 128, p.in[I_SK2] + (size_t)l * 128 * 128, (bf16_t*)(wb + WB_PS));
}
__device__ __forceinline__ void conv_copy(const float* src, bf16_t* dst, size_t n) {
    const size_t stride = (size_t)gridDim.x * 512 * 8;
    const int tidc = fresh_tid();
    for (size_t i = ((size_t)blockIdx.x * 512 + tidc) * 8; i < n; i += stride) {
        const f32x4 a = *(const f32x4*)(src + i), b = *(const f32x4*)(src + i + 4);
        u32x4 w; w.x = cvt_pk_bf16(a[0], a[1]); w.y = cvt_pk_bf16(a[2], a[3]); w.z = cvt_pk_bf16(b[0], b[1]); w.w = cvt_pk_bf16(b[2], b[3]);
        *(u32x4*)(dst + i) = w; }
}

__device__ __forceinline__ void knorm_rows(const Params& p, int l) {
    unsigned char* const wsl = fresh_ptr(p.ws);
    bf16_t* H = (bf16_t*)(wsl + WS_R + R_H); bf16_t* MK = (bf16_t*)(wsl + WS_MK);
    const float* akg = p.in[I_AKG] + l * 64; const float* ckg = p.in[I_CKG] + l * 128; const float* mkg = p.in[I_MKG] + l * 128;
    const int tid = fresh_tid(); const int lane = tid & 63, gw = blockIdx.x * 8 + (tid >> 6), nw = gridDim.x * 8;
    float ga[8], gm[8];
#pragma unroll
    for (int j = 0; j < 8; ++j) { ga[j] = akg[(8 * lane + j) & 63]; gm[j] = mkg[(8 * lane + j) & 127]; }
    const float gc0 = ckg[2 * lane], gc1 = ckg[2 * lane + 1];
    for (int r = gw; r < T_TOK; r += nw) {
        bf16_t* row = H + (size_t)r * HN;
        {
            u32x4 w = *(const u32x4*)(row + HC_KA + 8 * lane); float f[8] = {bf_lo(w.x), bf_hi(w.x), bf_lo(w.y), bf_hi(w.y), bf_lo(w.z), bf_hi(w.z), bf_lo(w.w), bf_hi(w.w)};
            float ss = 0.f;
#pragma unroll
            for (int j = 0; j < 8; ++j) ss += f[j] * f[j];
            ss += SHX(ss, 1); ss += SHX(ss, 2); ss += SHX(ss, 4);
            const float sc = rsqrtf(ss * (1.0f / 64.0f) + EPSF);
            w.x = cvt_pk_bf16(f[0] * sc * ga[0], f[1] * sc * ga[1]); w.y = cvt_pk_bf16(f[2] * sc * ga[2], f[3] * sc * ga[3]);
            w.z = cvt_pk_bf16(f[4] * sc * ga[4], f[5] * sc * ga[5]); w.w = cvt_pk_bf16(f[6] * sc * ga[6], f[7] * sc * ga[7]);
            *(u32x4*)(row + HC_KA + 8 * lane) = w; }
        {
            const unsigned w = *(const unsigned*)(row + HC_CK + 2 * lane); const float a = bf_lo(w), b = bf_hi(w);
            const float ss = wave_sum(a * a + b * b, lane); const float sc = rsqrtf(ss * (1.0f / 128.0f) + EPSF);
            *(unsigned*)(row + HC_CK + 2 * lane) = cvt_pk_bf16(a * sc * gc0, b * sc * gc1); }
    }
    for (int r = gw; r < NB * MEMLEN; r += nw) {
        bf16_t* row = MK + (size_t)r * 512;
        u32x4 w = *(const u32x4*)(row + 8 * lane); float f[8] = {bf_lo(w.x), bf_hi(w.x), bf_lo(w.y), bf_hi(w.y), bf_lo(w.z), bf_hi(w.z), bf_lo(w.w), bf_hi(w.w)};
        float ss = 0.f;
#pragma unroll
        for (int j = 0; j < 8; ++j) ss += f[j] * f[j];
        ss += SHX(ss, 1); ss += SHX(ss, 2); ss += SHX(ss, 4); ss += SHX(ss, 8);
        const float sc = rsqrtf(ss * (1.0f / 128.0f) + EPSF);
        w.x = cvt_pk_bf16(f[0] * sc * gm[0], f[1] * sc * gm[1]); w.y = cvt_pk_bf16(f[2] * sc * gm[2], f[3] * sc * gm[3]);
        w.z = cvt_pk_bf16(f[4] * sc * gm[4], f[5] * sc * gm[5]); w.w = cvt_pk_bf16(f[6] * sc * gm[6], f[7] * sc * gm[7]);
        *(u32x4*)(row + 8 * lane) = w;
    }
}
__device__ __forceinline__ void gmlp_phase(const Params& p, LAS unsigned char* lds, int l) {
    unsigned char* const wsl = fresh_ptr(p.ws);
    const bf16_t* H = (const bf16_t*)(wsl + WS_R + R_H); bf16_t* YB = (bf16_t*)(wsl + WS_YB);
    LAS unsigned char* Wl = lds;
    LAS unsigned char* Vt = lds + 32768;
    LAS unsigned char* Ul = lds + 65536;
    const int tid = fresh_tid(), lane = tid & 63, wv = __builtin_amdgcn_readfirstlane(tid >> 6), fr = lane & 15, fq = lane >> 4;
    for (int unit = blockIdx.x; unit < 1024; unit += gridDim.x) {
        const int c = unit >> 2, g = unit & 3; const size_t t0 = (size_t)c * 128;
        const float* W = p.in[I_BWS] + ((size_t)(l * 4 + g) * 128) * 128; const float* bs = p.in[I_BBS] + (size_t)(l * 4 + g) * 128; const float* vg = p.in[I_BVG] + l * 512 + g * 128;
        { const int t = tid >> 2, sq = (tid & 3) * 32;
#pragma unroll
            for (int q = 0; q < 4; ++q) { const f32x4 a = *(const f32x4*)(W + (size_t)t * 128 + sq + q * 8), b = *(const f32x4*)(W + (size_t)t * 128 + sq + q * 8 + 4);
                float f[8] = {a[0], a[1], a[2], a[3], b[0], b[1], b[2], b[3]};
#pragma unroll
                for (int j = 0; j < 8; ++j) if (sq + q * 8 + j > t) f[j] = 0.f;
                u32x4 w; w.x = cvt_pk_bf16(f[0], f[1]); w.y = cvt_pk_bf16(f[2], f[3]); w.z = cvt_pk_bf16(f[4], f[5]); w.w = cvt_pk_bf16(f[6], f[7]);
                const int ch = (sq >> 3) + q; *(LAS u32x4*)(Wl + t * 256 + ((ch ^ (t & 15)) << 4)) = w; } }
        { const int s = tid >> 2, dq = (tid & 3) * 32;
            const bf16_t* src = H + (t0 + s) * HN + HC_ZV + g * 128 + dq; float f[32]; float ss = 0.f;
#pragma unroll
            for (int q = 0; q < 4; ++q) { const u32x4 w = *(const u32x4*)(src + q * 8);
                f[q * 8 + 0] = bf_lo(w.x); f[q * 8 + 1] = bf_hi(w.x); f[q * 8 + 2] = bf_lo(w.y); f[q * 8 + 3] = bf_hi(w.y); f[q * 8 + 4] = bf_lo(w.z); f[q * 8 + 5] = bf_hi(w.z); f[q * 8 + 6] = bf_lo(w.w); f[q * 8 + 7] = bf_hi(w.w); }
#pragma unroll
            for (int j = 0; j < 32; ++j) { f[j] = gelu1(f[j]); ss += f[j] * f[j]; }
            ss += SHX(ss, 1); ss += SHX(ss, 2);
            const float sc = rsqrtf(ss * (1.0f / 128.0f) + EPSF);
#pragma unroll
            for (int j = 0; j < 32; ++j) { const int d = dq + j; const float v = f[j] * sc * vg[d];
                *(LAS bf16_t*)(Vt + d * 256 + (((s >> 3) ^ (d & 15)) << 4) + (s & 7) * 2) = f2bf(v); } }
        { const int t = tid >> 2, dq = (tid & 3) * 32;
            const bf16_t* src = H + (t0 + t) * HN + HC_ZU + g * 128 + dq;
#pragma unroll
            for (int q = 0; q < 4; ++q) { const u32x4 w = *(const u32x4*)(src + q * 8);
                u32x4 o; o.x = cvt_pk_bf16(gelu1(bf_lo(w.x)), gelu1(bf_hi(w.x))); o.y = cvt_pk_bf16(gelu1(bf_lo(w.y)), gelu1(bf_hi(w.y)));
                o.z = cvt_pk_bf16(gelu1(bf_lo(w.z)), gelu1(bf_hi(w.z))); o.w = cvt_pk_bf16(gelu1(bf_lo(w.w)), gelu1(bf_hi(w.w)));
                *(LAS u32x4*)(Ul + t * 272 + (dq + q * 8) * 2) = o; } }
        __syncthreads();
        {
            f32x4 acc[8];
#pragma unroll
            for (int dd = 0; dd < 8; ++dd) acc[dd] = (f32x4){0.f, 0.f, 0.f, 0.f};
            const int nks = (wv >> 1) + 1; const int trow = 16 * wv + fr;
            for (int ks = 0; ks < nks; ++ks) {
                const bf16x8 wf = *(const LAS bf16x8*)(Wl + trow * 256 + (((4 * ks + fq) ^ (trow & 15)) << 4));
#pragma unroll
                for (int dd = 0; dd < 8; ++dd) { const int d = 16 * dd + fr; const bf16x8 vf = *(const LAS bf16x8*)(Vt + d * 256 + (((4 * ks + fq) ^ (d & 15)) << 4));
                    acc[dd] = __builtin_amdgcn_mfma_f32_16x16x32_bf16(wf, vf, acc[dd], 0, 0, 0); } }
#pragma unroll
            for (int i = 0; i < 4; ++i) { const int t = 16 * wv + 4 * fq + i; const float bb = bs[t];
#pragma unroll
                for (int dd = 0; dd < 8; ++dd) { const int d = 16 * dd + fr; LAS bf16_t* up = (LAS bf16_t*)(Ul + t * 272 + d * 2); *up = f2bf((acc[dd][i] + bb) * bf2f(*up)); } }
        }
        __syncthreads();
        { const int t = tid >> 2, dq = (tid & 3) * 32; bf16_t* dst = YB + (t0 + t) * 512 + g * 128 + dq;
#pragma unroll
            for (int q = 0; q < 4; ++q) *(u32x4*)(dst + q * 8) = *(const LAS u32x4*)(Ul + t * 272 + (dq + q * 8) * 2); }
        __syncthreads();
    }
}

struct AttnArgs {
    const bf16_t* Q; int ldq; int qcol[2]; size_t qtok; const float* qgain; float qscale;
    const bf16_t* K; int ldk; size_t krow0; int kcol0;
    const bf16_t* V; int ldv; int vrow0; size_t vcol0;
    int nkt_blk, my_nkt, qpos, qpos_w0; int bhead[2]; const unsigned short* maskrow; int var;
};
#ifdef ATT_PROBE
#define AV(bit) (a.var & (bit))
#else
#define AV(bit) 0
#endif
template <int NS, int DQK, bool KSPLIT, int MODE>
__device__ __forceinline__ void attn_core(LAS unsigned char* lds, const LAS float* btab, const AttnArgs& a, f32x4 (&O)[NS][8], float (&lsum)[NS]) {
    constexpr int NKS = DQK / 32;
    const int tid = fresh_tid(), lane = tid & 63, fr = lane & 15, fq = lane >> 4;
    bf16x8 qf[NS][NKS];
#pragma unroll
    for (int s = 0; s < NS; ++s) {
        float qv[NKS][8]; float ss = 0.f;
#pragma unroll
        for (int ks = 0; ks < NKS; ++ks) { const u32x4 w = *(const u32x4*)(a.Q + a.qtok * a.ldq + a.qcol[s] + 32 * ks + 8 * fq);
            qv[ks][0] = bf_lo(w.x); qv[ks][1] = bf_hi(w.x); qv[ks][2] = bf_lo(w.y); qv[ks][3] = bf_hi(w.y); qv[ks][4] = bf_lo(w.z); qv[ks][5] = bf_hi(w.z); qv[ks][6] = bf_lo(w.w); qv[ks][7] = bf_hi(w.w);
#pragma unroll
            for (int j = 0; j < 8; ++j) ss += qv[ks][j] * qv[ks][j]; }
        ss += SHX(ss, 16); ss += SHX(ss, 32);
        const float r = rsqrtf(ss * (1.0f / (float)DQK) + EPSF) * a.qscale;
#pragma unroll
        for (int ks = 0; ks < NKS; ++ks) { const f32x4 g0 = *(const f32x4*)(a.qgain + 32 * ks + 8 * fq), g1 = *(const f32x4*)(a.qgain + 32 * ks + 8 * fq + 4);
            u32x4 w; w.x = cvt_pk_bf16(qv[ks][0] * r * g0[0], qv[ks][1] * r * g0[1]); w.y = cvt_pk_bf16(qv[ks][2] * r * g0[2], qv[ks][3] * r * g0[3]);
            w.z = cvt_pk_bf16(qv[ks][4] * r * g1[0], qv[ks][5] * r * g1[1]); w.w = cvt_pk_bf16(qv[ks][6] * r * g1[2], qv[ks][7] * r * g1[3]);
            qf[s][ks] = __builtin_bit_cast(bf16x8, w); }
    }
    constexpr bool MROW = (MODE != 1);
    float mrun[NS]; f32x4 lacc[NS];
    const bf16x8 ones = __builtin_bit_cast(bf16x8, (u32x4){0x3f803f80u, 0x3f803f80u, 0x3f803f80u, 0x3f803f80u});
#pragma unroll
    for (int s = 0; s < NS; ++s) { mrun[s] = NEG_INF; lacc[s] = (f32x4){0.f, 0.f, 0.f, 0.f};
#pragma unroll
        for (int dt = 0; dt < 8; ++dt) O[s][dt] = (f32x4){0.f, 0.f, 0.f, 0.f}; }
    const int wvs = __builtin_amdgcn_readfirstlane(tid >> 6);
    const int c0 = tid, c1 = tid + 512;
    const int kr0 = c0 >> 4, kr1 = c1 >> 4, vr0 = c0 >> 3, vr1 = c1 >> 3;
    const int kc0 = (c0 & 15) ^ (kr0 & 15), kc1 = (c1 & 15) ^ (kr1 & 15), vc0 = (c0 & 7) ^ ((vr0 >> 1) & 7), vc1 = (c1 & 7) ^ ((vr1 >> 1) & 7);
    const bf16_t* kg0 = a.K + (a.krow0 + kr0) * a.ldk + a.kcol0 + kc0 * 8; const bf16_t* kg1 = a.K + (a.krow0 + kr1) * a.ldk + a.kcol0 + kc1 * 8;
    const bf16_t* vg0 = a.V + (size_t)(a.vrow0 + vr0) * a.ldv + a.vcol0 + vc0 * 8; const bf16_t* vg1 = a.V + (size_t)(a.vrow0 + vr1) * a.ldv + a.vcol0 + vc1 * 8;
    const int ldw = wvs * 1024;
#define ATT_STAGE(bufoff, ko, vo) do { \
        __builtin_amdgcn_global_load_lds((const unsigned*)(kg0 + (ko)), (LAS unsigned*)(lds + (bufoff) + ldw), 16, 0, 0); \
        __builtin_amdgcn_global_load_lds((const unsigned*)(kg1 + (ko)), (LAS unsigned*)(lds + (bufoff) + 8192 + ldw), 16, 0, 0); \
        __builtin_amdgcn_global_load_lds((const unsigned*)(vg0 + (vo)), (LAS unsigned*)(lds + (bufoff) + 16384 + ldw), 16, 0, 0); \
        __builtin_amdgcn_global_load_lds((const unsigned*)(vg1 + (vo)), (LAS unsigned*)(lds + (bufoff) + 24576 + ldw), 16, 0, 0); } while (0)
    LAS unsigned char* mrow = lds + 102400 + wvs * 4352 + fr * 264;
    if (MODE == 1) {
#pragma unroll
        for (int j = 0; j < 4; ++j) { const u32x4 w = *(const u32x4*)(a.maskrow + fq * 32 + j * 8); *(LAS u32x2*)(mrow + fq * 64 + j * 16) = (u32x2){w.x, w.y}; *(LAS u32x2*)(mrow + fq * 64 + j * 16 + 8) = (u32x2){w.z, w.w}; }
        asm volatile("s_waitcnt vmcnt(0) lgkmcnt(0)" ::: "memory");
    }
    ATT_STAGE(0, 0, 0);
    if (a.nkt_blk > 1 && !AV(8)) ATT_STAGE(32768, (size_t)64 * a.ldk, (size_t)64);
    int slot = 0;
    for (int kt = 0; kt < a.nkt_blk; ++kt) {
        if (kt + 1 < a.nkt_blk && !AV(8)) asm volatile("s_waitcnt vmcnt(4)" ::: "memory"); else asm volatile("s_waitcnt vmcnt(0)" ::: "memory");
        if (!AV(16)) { asm volatile("" ::: "memory"); __builtin_amdgcn_s_barrier(); asm volatile("" ::: "memory"); }
        if (kt + 2 < a.nkt_blk && !AV(8)) { const int ns = (slot >= 1) ? slot - 1 : 2; const size_t ko = (size_t)(kt + 2) * 64 * a.ldk, vo = (size_t)(kt + 2) * 64; ATT_STAGE(ns * 32768, ko, vo); }
        const int buf = slot; slot = (slot == 2) ? 0 : slot + 1;
        unsigned long long mbits = 0ull;
        if (MODE == 1) { const u32x2 mw = *(const LAS u32x2*)(mrow + kt * 8); mbits = ((unsigned long long)mw.y << 32) | mw.x; }
        if (kt < a.my_nkt) {
            const LAS unsigned char* Kt = lds + buf * 32768; const LAS unsigned char* Vt = Kt + 16384;
            const int key0 = kt * 64;
            const bool near = (MODE != 2) && (a.qpos_w0 - key0 - 63 < 128);
            bf16x8 pf[NS][2];
#pragma unroll
            for (int s = 0; s < NS; ++s) {
                f32x4 sacc[4];
#pragma unroll
                for (int t = 0; t < 4; ++t) { const LAS unsigned char* rp = Kt + (16 * t + fr) * 256;
                    if (AV(4)) { sacc[t] = (f32x4){0.f, 0.f, 0.f, 0.f}; continue; }
                    { const bf16x8 kf = *(const LAS bf16x8*)(rp + ((((KSPLIT ? 8 * s : 0) + fq) ^ fr) << 4)); sacc[t] = __builtin_amdgcn_mfma_f32_16x16x32_bf16(kf, qf[s][0], (f32x4){0.f, 0.f, 0.f, 0.f}, 0, 0, 0); }
#pragma unroll
                    for (int ks = 1; ks < NKS; ++ks) { const bf16x8 kf = *(const LAS bf16x8*)(rp + ((((KSPLIT ? 8 * s : 0) + 4 * ks + fq) ^ fr) << 4));
                        sacc[t] = __builtin_amdgcn_mfma_f32_16x16x32_bf16(kf, qf[s][ks], sacc[t], 0, 0, 0); } }
                if (!AV(1)) {
                if (MODE == 1) { const unsigned lo = (unsigned)mbits, hi = (unsigned)(mbits >> 32); unsigned nib[4];
                    nib[0] = (lo & 0xffffu) >> (4 * fq); nib[1] = (lo >> 16) >> (4 * fq); nib[2] = (hi & 0xffffu) >> (4 * fq); nib[3] = (hi >> 16) >> (4 * fq);
#pragma unroll
                    for (int t = 0; t < 4; ++t)
#pragma unroll
                        for (int i = 0; i < 4; ++i) sacc[t][i] = ((nib[t] >> i) & 1u) ? sacc[t][i] : NEG_INF; }
                if (MODE != 2) { if (near) {
                    const LAS float* bt = btab + a.bhead[s] * 128; const int dist0 = a.qpos - key0 - 4 * fq;
                    float bia[4][4];
#pragma unroll
                    for (int t = 0; t < 4; ++t)
#pragma unroll
                        for (int i = 0; i < 4; ++i) { const int dist = dist0 - 16 * t - i; const int di = dist < 0 ? 0 : (dist > 127 ? 127 : dist); bia[t][i] = bt[di]; }
#pragma unroll
                    for (int t = 0; t < 4; ++t)
#pragma unroll
                        for (int i = 0; i < 4; ++i) { float x = sacc[t][i] + bia[t][i]; if (MODE == 0) x = (dist0 - 16 * t - i < 0) ? NEG_INF : x; sacc[t][i] = x; }
                } }
                float rmax = fmaxf(fmaxf(__builtin_fmaxf(sacc[0][0], sacc[0][1]), fmaxf(sacc[0][2], sacc[0][3])), fmaxf(fmaxf(sacc[1][0], sacc[1][1]), fmaxf(sacc[1][2], sacc[1][3])));
                rmax = fmaxf(rmax, fmaxf(fmaxf(fmaxf(sacc[2][0], sacc[2][1]), fmaxf(sacc[2][2], sacc[2][3])), fmaxf(fmaxf(sacc[3][0], sacc[3][1]), fmaxf(sacc[3][2], sacc[3][3]))));
                rmax = fmaxf(rmax, SHX(rmax, 16)); rmax = fmaxf(rmax, SHX(rmax, 32));
                if (__any(rmax > mrun[s] + 8.0f)) {
                    const float mn = fmaxf(mrun[s], rmax); const float alpha = (mn == NEG_INF) ? 1.0f : __builtin_amdgcn_exp2f(mrun[s] - mn); mrun[s] = mn;
#pragma unroll
                    for (int dt = 0; dt < 8; ++dt) O[s][dt] *= alpha;
                    lacc[s] *= alpha;
                }
                const float mu = (mrun[s] == NEG_INF) ? 0.f : mrun[s];
                float psum = 0.f;
#pragma unroll
                for (int t = 0; t < 4; ++t)
#pragma unroll
                    for (int i = 0; i < 4; ++i) { sacc[t][i] = __builtin_amdgcn_exp2f(sacc[t][i] - mu); if (!MROW) psum += sacc[t][i]; }
                if (!MROW) lacc[s][0] += psum;
                }
#pragma unroll
                for (int s2 = 0; s2 < 2; ++s2) { u32x4 w; w.x = cvt_pk_bf16(sacc[2 * s2][0], sacc[2 * s2][1]); w.y = cvt_pk_bf16(sacc[2 * s2][2], sacc[2 * s2][3]);
                    w.z = cvt_pk_bf16(sacc[2 * s2 + 1][0], sacc[2 * s2 + 1][1]); w.w = cvt_pk_bf16(sacc[2 * s2 + 1][2], sacc[2 * s2 + 1][3]); pf[s][s2] = __builtin_bit_cast(bf16x8, w); }
                if (!AV(2) && MROW)
#pragma unroll
                for (int s2 = 0; s2 < 2; ++s2) lacc[s] = __builtin_amdgcn_mfma_f32_16x16x32_bf16(ones, pf[s][s2], lacc[s], 0, 0, 0);
            }
            if (!AV(2))
#pragma unroll
            for (int dt = 0; dt < 8; ++dt) { const int row = 16 * dt + fr; const LAS unsigned char* rp = Vt + row * 128 + 8 * (fq & 1); const int sw = (row >> 1) & 7;
#pragma unroll
                for (int s2 = 0; s2 < 2; ++s2) {
                    const u32x2 va = *(const volatile LAS u32x2*)(rp + (((4 * s2 + (fq >> 1)) ^ sw) << 4)), vb = *(const volatile LAS u32x2*)(rp + (((4 * s2 + 2 + (fq >> 1)) ^ sw) << 4));
                    u32x4 w; w.x = va.x; w.y = va.y; w.z = vb.x; w.w = vb.y; const bf16x8 vf = __builtin_bit_cast(bf16x8, w);
#pragma unroll
                    for (int s = 0; s < NS; ++s) O[s][dt] = __builtin_amdgcn_mfma_f32_16x16x32_bf16(vf, pf[s][s2], O[s][dt], 0, 0, 0); } }
        }
    }
    __syncthreads();
#undef ATT_STAGE
#pragma unroll
    for (int s = 0; s < NS; ++s) { lsum[s] = lacc[s][0]; if (!MROW) { lsum[s] += SHX(lsum[s], 16); lsum[s] += SHX(lsum[s], 32); } }
}
__device__ __forceinline__ void load_btab(const Params& p, LAS float* bt) {
    unsigned char* const wsl = fresh_ptr(p.ws);
    const float* src = (const float*)(wsl + WS_CTL + CTL_BTAB);
    const int tidb = fresh_tid();
    for (int e = tidb; e < 1024; e += 512) bt[e] = src[e];
    __syncthreads();
}
__device__ __forceinline__ void attnA_phase(const Params& p, LAS unsigned char* lds, int l, int var) {
    unsigned char* const wsl = fresh_ptr(p.ws);
    LAS float* bt = (LAS float*)(lds + 98304);
    load_btab(p, bt);
    const bf16_t* H = (const bf16_t*)(wsl + WS_R + R_H); const bf16_t* VT = (const bf16_t*)(wsl + WS_R + R_VT); bf16_t* YA = (bf16_t*)(wsl + WS_YA);
    const float* lamv = (const float*)(wsl + WS_CTL + CTL_LAM); const float lam = lamv[l * 2], lam_init = lamv[l * 2 + 1];
    const float* subln = p.in[I_SUBLN] + l * 128;
    const int tid = fresh_tid(); const int lane = tid & 63, wv = __builtin_amdgcn_readfirstlane(tid >> 6), fr = lane & 15, fq = lane >> 4;
    for (int vb = blockIdx.x; vb < 256; vb += gridDim.x) for (int it = 0; it < 4; ++it) {
        const int xg = vb & 7, sl = vb >> 3;
        const int bh = xg * 8 + (it >> 1) * 4 + (sl >> 3), j = sl & 7; const int qt = (it & 1) ? 15 - j : j;
        const int b = bh >> 2, h = bh & 3;
        AttnArgs a;
        const int qpos_w0 = qt * 128 + wv * 16;
        a.Q = H; a.ldq = HN; a.qcol[0] = HC_QA + h * 128; a.qcol[1] = HC_QA + h * 128 + 64; a.qtok = (size_t)b * SEQ + qpos_w0 + fr; a.qgain = p.in[I_AQG] + l * 64; a.qscale = 0.125f * LOG2E;
        a.K = H; a.ldk = HN; a.krow0 = (size_t)b * SEQ; a.kcol0 = HC_KA + h * 128;
        a.V = VT; a.ldv = T_TOK; a.vrow0 = h * 128; a.vcol0 = (size_t)b * SEQ;
        a.nkt_blk = 2 * qt + 2; a.my_nkt = ((qpos_w0 + 15) >> 6) + 1; a.qpos = qpos_w0 + fr; a.qpos_w0 = qpos_w0; a.bhead[0] = h; a.bhead[1] = h; a.maskrow = nullptr; a.var = var;
        f32x4 O[2][8]; float ls[2];
        attn_core<2, 64, true, 0>(lds, bt, a, O, ls);
        const float i1 = 1.0f / ls[0], i2 = lam / ls[1]; float ss = 0.f;
#pragma unroll
        for (int dt = 0; dt < 8; ++dt)
#pragma unroll
            for (int i = 0; i < 4; ++i) { const float v = O[0][dt][i] * i1 - O[1][dt][i] * i2; O[0][dt][i] = v; ss += v * v; }
        ss += SHX(ss, 16); ss += SHX(ss, 32);
        const float sc = rsqrtf(ss * (1.0f / 128.0f) + EPSF) * (1.0f - lam_init);
        bf16_t* dst = YA + a.qtok * 512 + h * 128 + 4 * fq;
#pragma unroll
        for (int dt = 0; dt < 8; ++dt) { const f32x4 g = *(const f32x4*)(subln + 16 * dt + 4 * fq); u32x2 w; w.x = cvt_pk_bf16(O[0][dt][0] * sc * g[0], O[0][dt][1] * sc * g[1]); w.y = cvt_pk_bf16(O[0][dt][2] * sc * g[2], O[0][dt][3] * sc * g[3]);
            *(u32x2*)(dst + 16 * dt) = w; }
    }
}
__device__ __forceinline__ void attnC_phase(const Params& p, LAS unsigned char* lds, int l, int var) {
    unsigned char* const wsl = fresh_ptr(p.ws);
    LAS float* bt = (LAS float*)(lds + 98304);
    load_btab(p, bt);
    const bf16_t* H = (const bf16_t*)(wsl + WS_R + R_H); const bf16_t* VT = (const bf16_t*)(wsl + WS_R + R_VT); bf16_t* YC = (bf16_t*)(wsl + WS_YC);
    const unsigned short* mask = (const unsigned short*)(wsl + WS_MASK);
    const int tid = fresh_tid(); const int lane = tid & 63, wv = __builtin_amdgcn_readfirstlane(tid >> 6), fr = lane & 15, fq = lane >> 4;
    const int qs = wv & 3, hp = wv >> 2;
    for (int vb = blockIdx.x; vb < 256; vb += gridDim.x) for (int it = 0; it < 2; ++it) {
        const int xg = vb & 7, sl = vb >> 3;
        const int b = xg * 2 + (sl >> 4), j = sl & 15; const int qt = (it == 0) ? j : 31 - j;
        AttnArgs a;
        const int qpos_w0 = qt * 64 + qs * 16;
        a.Q = H; a.ldq = HN; a.qcol[0] = HC_CQ + (2 * hp) * 128; a.qcol[1] = HC_CQ + (2 * hp + 1) * 128; a.qtok = (size_t)b * SEQ + qpos_w0 + fr; a.qgain = p.in[I_CQG] + l * 128; a.qscale = 0.08838834764831845f * LOG2E;
        a.K = H; a.ldk = HN; a.krow0 = (size_t)b * SEQ; a.kcol0 = HC_CK;
        a.V = VT; a.ldv = T_TOK; a.vrow0 = 512; a.vcol0 = (size_t)b * SEQ;
        a.nkt_blk = qt + 1; a.my_nkt = qt + 1; a.qpos = qpos_w0 + fr; a.qpos_w0 = qpos_w0; a.bhead[0] = 4 + 2 * hp; a.bhead[1] = 5 + 2 * hp; a.maskrow = mask + a.qtok * 128; a.var = var;
        f32x4 O[2][8]; float ls[2];
        attn_core<2, 128, false, 1>(lds, bt, a, O, ls);
#pragma unroll
        for (int s = 0; s < 2; ++s) { const float inv = 1.0f / ls[s]; bf16_t* dst = YC + a.qtok * 512 + (2 * hp + s) * 128 + 4 * fq;
#pragma unroll
            for (int dt = 0; dt < 8; ++dt) { u32x2 w; w.x = cvt_pk_bf16(O[s][dt][0] * inv, O[s][dt][1] * inv); w.y = cvt_pk_bf16(O[s][dt][2] * inv, O[s][dt][3] * inv); *(u32x2*)(dst + 16 * dt) = w; } }
    }
}
__device__ __forceinline__ void attnX_phase(const Params& p, LAS unsigned char* lds, int l) {
    unsigned char* const wsl = fresh_ptr(p.ws);
    const int var = 0;
    const bf16_t* QX = (const bf16_t*)(wsl + WS_YA); const bf16_t* MK = (const bf16_t*)(wsl + WS_MK); const bf16_t* MVT = (const bf16_t*)(wsl + WS_MVT); bf16_t* OX = (bf16_t*)(wsl + WS_YB);
    const int tid = fresh_tid(); const int lane = tid & 63, wv = __builtin_amdgcn_readfirstlane(tid >> 6), fr = lane & 15, fq = lane >> 4;
    for (int unit = blockIdx.x; unit < 1024; unit += gridDim.x) {
        const int b = unit >> 6, h = (unit >> 4) & 3, qt = unit & 15;
        AttnArgs a;
        const int qpos_w0 = qt * 128 + wv * 16;
        a.Q = QX; a.ldq = 512; a.qcol[0] = h * 128; a.qcol[1] = h * 128; a.qtok = (size_t)b * SEQ + qpos_w0 + fr; a.qgain = p.in[I_MQG] + l * 128; a.qscale = 0.08838834764831845f * LOG2E;
        a.K = MK; a.ldk = 512; a.krow0 = (size_t)b * MEMLEN; a.kcol0 = h * 128;
        a.V = MVT; a.ldv = NB * MEMLEN; a.vrow0 = h * 128; a.vcol0 = (size_t)b * MEMLEN;
        a.nkt_blk = 4; a.my_nkt = 4; a.qpos = 0; a.qpos_w0 = 0; a.bhead[0] = 0; a.bhead[1] = 0; a.maskrow = nullptr; a.var = var;
        f32x4 O[1][8]; float ls[1];
        attn_core<1, 128, false, 2>(lds, nullptr, a, O, ls);
        const float inv = 1.0f / ls[0]; bf16_t* dst = OX + a.qtok * 512 + h * 128 + 4 * fq;
#pragma unroll
        for (int dt = 0; dt < 8; ++dt) { u32x2 w; w.x = cvt_pk_bf16(O[0][dt][0] * inv, O[0][dt][1] * inv); w.y = cvt_pk_bf16(O[0][dt][2] * inv, O[0][dt][3] * inv); *(u32x2*)(dst + 16 * dt) = w; }
    }
}

__device__ __forceinline__ unsigned dpp_sum_u32(unsigned x) {
    x += (unsigned)__builtin_amdgcn_update_dpp(0, (int)x, 0xB1, 0xF, 0xF, true); x += (unsigned)__builtin_amdgcn_update_dpp(0, (int)x, 0x4E, 0xF, 0xF, true);
    x += (unsigned)__builtin_amdgcn_update_dpp(0, (int)x, 0x141, 0xF, 0xF, true); x += (unsigned)__builtin_amdgcn_update_dpp(0, (int)x, 0x140, 0xF, 0xF, true);
    { auto r = __builtin_amdgcn_permlane16_swap(x, x, false, false); x = r[0] + r[1]; } { auto r = __builtin_amdgcn_permlane32_swap(x, x, false, false); x = r[0] + r[1]; }
    return x;
}
__device__ __forceinline__ unsigned umaxu(unsigned a, unsigned b) { return a > b ? a : b; }
__device__ __forceinline__ unsigned uminu(unsigned a, unsigned b) { return a < b ? a : b; }
__device__ __forceinline__ unsigned dpp_max_u32(unsigned x) {
    x = umaxu(x, (unsigned)__builtin_amdgcn_update_dpp(0, (int)x, 0xB1, 0xF, 0xF, true)); x = umaxu(x, (unsigned)__builtin_amdgcn_update_dpp(0, (int)x, 0x4E, 0xF, 0xF, true));
    x = umaxu(x, (unsigned)__builtin_amdgcn_update_dpp(0, (int)x, 0x141, 0xF, 0xF, true)); x = umaxu(x, (unsigned)__builtin_amdgcn_update_dpp(0, (int)x, 0x140, 0xF, 0xF, true));
    { auto r = __builtin_amdgcn_permlane16_swap(x, x, false, false); x = umaxu(r[0], r[1]); } { auto r = __builtin_amdgcn_permlane32_swap(x, x, false, false); x = umaxu(r[0], r[1]); }
    return x;
}
__device__ __forceinline__ float key2f_full(unsigned k) { return __uint_as_float((k & 0x80000000u) ? (k & 0x7fffffffu) : ~k); }
__device__ __forceinline__ void csel_phase(const Params& p, LAS unsigned char* lds, int var) {
    unsigned char* const wsl = fresh_ptr(p.ws);
#ifdef ATT_PROBE
#define CV(bit) (var & (bit))
#else
#define CV(bit) 0
#endif
    const bf16_t* H = (const bf16_t*)(wsl + WS_R + R_H); unsigned short* mask = (unsigned short*)(wsl + WS_MASK);
    constexpr int SC_ROW = 8208;
    const int tid = fresh_tid(); const int lane = tid & 63, wv = __builtin_amdgcn_readfirstlane(tid >> 6), fr = lane & 15, fq = lane >> 4;
    for (int c = blockIdx.x; c < 256; c += gridDim.x) {
        const int b = c >> 4, j = c & 15;
        for (int it = 0; it < 8; ++it) {
            const int i = (it & 1) ? (32 * (it >> 1) + 31 - j) : (32 * (it >> 1) + j);
            if (!CV(1)) {
                const size_t qtok = (size_t)b * SEQ + 16 * i + fr;
                bf16x8 bq[8][2]; float wq[8];
#pragma unroll
                for (int h = 0; h < 8; ++h)
#pragma unroll
                    for (int ks = 0; ks < 2; ++ks) bq[h][ks] = *(const bf16x8*)(H + qtok * HN + HC_IQ + h * 64 + 32 * ks + 8 * fq);
                { const u32x4 w = *(const u32x4*)(H + qtok * HN + HC_IW); wq[0] = bf_lo(w.x); wq[1] = bf_hi(w.x); wq[2] = bf_lo(w.y); wq[3] = bf_hi(w.y); wq[4] = bf_lo(w.z); wq[5] = bf_hi(w.z); wq[6] = bf_lo(w.w); wq[7] = bf_hi(w.w); }
                const bf16_t* kbase = H + ((size_t)b * SEQ + fr) * HN + HC_IK + 8 * fq;
                bf16x8 ka0, ka1; ka0 = ka1 = (bf16x8){0, 0, 0, 0, 0, 0, 0, 0};
                if (wv <= i) { const bf16_t* kp = kbase + (size_t)(16 * wv) * HN; ka0 = *(const bf16x8*)kp; ka1 = *(const bf16x8*)(kp + 32); }
                for (int st = wv; st <= i; st += 8) {
                    bf16x8 na0 = ka0, na1 = ka1;
                    if (st + 8 <= i) { const bf16_t* kp = kbase + (size_t)(16 * (st + 8)) * HN; na0 = *(const bf16x8*)kp; na1 = *(const bf16x8*)(kp + 32); }
                    f32x4 sc = (f32x4){0.f, 0.f, 0.f, 0.f};
#pragma unroll
                    for (int h = 0; h < 8; ++h) { f32x4 acc = __builtin_amdgcn_mfma_f32_16x16x32_bf16(ka0, bq[h][0], (f32x4){0.f, 0.f, 0.f, 0.f}, 0, 0, 0); acc = __builtin_amdgcn_mfma_f32_16x16x32_bf16(ka1, bq[h][1], acc, 0, 0, 0);
#pragma unroll
                        for (int k = 0; k < 4; ++k) sc[k] = __builtin_fmaf(fmaxf(acc[k], 0.f), wq[h], sc[k]); }
                    *(LAS f32x4*)(lds + fr * SC_ROW + (16 * st + 4 * fq) * 4) = sc;
                    ka0 = na0; ka1 = na1;
                }
            }
            __syncthreads();
#pragma unroll 1
            for (int qq = 0; qq < 2; ++qq) {
                const int q = 2 * wv + qq, qpos = 16 * i + q; const size_t tok = (size_t)b * SEQ + qpos;
                float u[8][4];
#pragma unroll
                for (int j2 = 0; j2 < 8; ++j2) { const f32x4 v = *(const LAS f32x4*)(lds + q * SC_ROW + (j2 * 256 + 4 * lane) * 4);
#pragma unroll
                    for (int k = 0; k < 4; ++k) u[j2][k] = (j2 * 256 + 4 * lane + k <= qpos) ? v[k] : NEG_INF; }
                int B1 = 256, B2 = 256; float vmx = 0.f, Sc = 0.f;
                if (qpos >= 256 && !CV(2)) {
                    float mx = NEG_INF, mnv = -NEG_INF;
#pragma unroll
                    for (int j2 = 0; j2 < 8; ++j2)
#pragma unroll
                        for (int k = 0; k < 4; ++k) { mx = fmaxf(mx, u[j2][k]); mnv = fminf(mnv, (u[j2][k] == NEG_INF) ? -NEG_INF : u[j2][k]); }
                    mx = key2f_full(dpp_max_u32(ukey(mx))); mnv = key2f_full(~dpp_max_u32(~ukey(mnv)));
                    vmx = mx; Sc = 255.99f / fmaxf(mx - mnv, 1e-20f);
                    LAS unsigned* hist = (LAS unsigned*)(lds + 131584 + wv * 1024);
                    unsigned need = 256u;
#pragma unroll 1
                    for (int lvl = 0; lvl < 2; ++lvl) {
                        *(LAS u32x4*)(hist + 4 * lane) = (u32x4){0u, 0u, 0u, 0u};
#pragma unroll
                        for (int j2 = 0; j2 < 8; ++j2)
#pragma unroll
                            for (int k = 0; k < 4; ++k) { const float v = u[j2][k];
                                if (v != NEG_INF) { const float t = (vmx - v) * Sc; int bn = (int)t; bn = bn > 255 ? 255 : bn;
                                    if (lvl == 0) (void)__hip_atomic_fetch_add(hist + bn, 1u, __ATOMIC_RELAXED, __HIP_MEMORY_SCOPE_WORKGROUP);
                                    else if (bn == B1) { int sb = (int)((t - (float)B1) * 256.0f); sb = sb > 255 ? 255 : (sb < 0 ? 0 : sb); (void)__hip_atomic_fetch_add(hist + sb, 1u, __ATOMIC_RELAXED, __HIP_MEMORY_SCOPE_WORKGROUP); } } }
                        const u32x4 h4 = *(const LAS u32x4*)(hist + 4 * lane);
                        const unsigned s4 = h4.x + h4.y + h4.z + h4.w; unsigned pre = s4;
#pragma unroll
                        for (int dd = 1; dd < 64; dd <<= 1) { const unsigned tt = (unsigned)__builtin_amdgcn_ds_bpermute(((lane - dd) & 63) << 2, (int)pre); if (lane >= dd) pre += tt; }
                        const unsigned long long bal = __ballot(pre >= need);
                        const int L = bal ? (int)__builtin_ctzll(bal) : 63;
                        unsigned c = (unsigned)__builtin_amdgcn_readlane((int)(pre - s4), L);
                        const unsigned hx = (unsigned)__builtin_amdgcn_readlane((int)h4.x, L), hy = (unsigned)__builtin_amdgcn_readlane((int)h4.y, L), hz = (unsigned)__builtin_amdgcn_readlane((int)h4.z, L);
                        int Bsel = 4 * L + 3;
                        if (c + hx >= need) Bsel = 4 * L; else { c += hx; if (c + hy >= need) Bsel = 4 * L + 1; else { c += hy; if (c + hz >= need) Bsel = 4 * L + 2; else c += hz; } }
                        if (lvl == 0) { B1 = Bsel; need -= c; } else B2 = Bsel;
                    }
                }
                if (!CV(4))
#pragma unroll
                for (int j2 = 0; j2 < 8; ++j2) {
                    const int st = j2 * 16 + (lane >> 2);
                    unsigned nib = 0u;
#pragma unroll
                    for (int k = 0; k < 4; ++k) { const float v = u[j2][k]; bool sel = (v != NEG_INF);
                        if (sel && B1 < 256) { const float t = (vmx - v) * Sc; int bn = (int)t; bn = bn > 255 ? 255 : bn;
                            if (bn > B1) sel = false; else if (bn == B1) { int sb = (int)((t - (float)B1) * 256.0f); sb = sb > 255 ? 255 : (sb < 0 ? 0 : sb); sel = (sb <= B2); } }
                        if (sel) nib |= (1u << k); }
                    unsigned wd = nib << (4 * (lane & 3));
                    wd |= (unsigned)__builtin_amdgcn_update_dpp(0, (int)wd, 0xB1, 0xF, 0xF, true); wd |= (unsigned)__builtin_amdgcn_update_dpp(0, (int)wd, 0x4E, 0xF, 0xF, true);
                    if ((lane & 3) == 0 && st <= (i | 3)) mask[tok * 128 + st] = (unsigned short)wd;
                }
            }
            __syncthreads();
        }
    }
}
__device__ __forceinline__ void ins16(unsigned (&L)[16], unsigned x) {
#pragma unroll
    for (int j = 0; j < 16; ++j) { const unsigned hi = L[j] > x ? L[j] : x; x = L[j] > x ? x : L[j]; L[j] = hi; }
}
__device__ __forceinline__ float key2f(unsigned k) { return __uint_as_float((k & 0x80000000u) ? (k & 0x7fffffffu) : ~k); }
__device__ __forceinline__ void top16_of_128(const float* sp, unsigned (&L)[16]) {
#pragma unroll
    for (int j = 0; j < 16; ++j) L[j] = 0u;
    for (int c = 0; c < 4; ++c) {
        f32x4 v[8];
#pragma unroll
        for (int q = 0; q < 8; ++q) v[q] = *(const f32x4*)(sp + c * 32 + q * 4);
#pragma unroll
        for (int q = 0; q < 8; ++q)
#pragma unroll
            for (int i = 0; i < 4; ++i) ins16(L, (ukey(v[q][i]) & ~127u) | (unsigned)(127 - (c * 32 + q * 4 + i)));
    }
}
__device__ __forceinline__ void peer_topk_phase(const Params& p, LAS unsigned char* lds) {
    unsigned char* const wsl = fresh_ptr(p.ws);
    const float* PS = (const float*)(wsl + WS_R + R_PS); int* EIDX = (int*)(wsl + WS_YC); float* EGATE = (float*)(wsl + WS_YC + 16 * MiB);
    const int tid = fresh_tid();
    for (int item = blockIdx.x * 512 + tid; item < T_TOK * 8; item += gridDim.x * 512) {
        const int tok = item >> 3, h = item & 7;
        const float* sp = PS + (size_t)tok * 2048 + h * 256;
        unsigned L1[16], L2[16], L3[16];
        top16_of_128(sp, L1);
        top16_of_128(sp + 128, L2);
        float v1[16], v2[16];
#pragma unroll
        for (int j = 0; j < 16; ++j) { v1[j] = key2f(L1[j] & ~127u); v2[j] = key2f(L2[j] & ~127u); L3[j] = 0u; }
#pragma unroll
        for (int a = 0; a < 16; ++a)
#pragma unroll
            for (int b = 0; b < 16; ++b) if ((a + 1) * (b + 1) <= 16) ins16(L3, (ukey(v1[a] + v2[b]) & ~255u) | (unsigned)(255 - (a * 16 + b)));
        int eo[16]; float go[16]; float gsum = 0.f; const float cmax = key2f(L3[0] & ~255u);
#pragma unroll
        for (int i = 0; i < 16; ++i) { const int code = 255 - (int)(L3[i] & 255u); const int a = code >> 4, b = code & 15; int e1 = 0, e2 = 0;
#pragma unroll
            for (int j = 0; j < 16; ++j) { e1 = (a == j) ? (int)(L1[j] & 127u) : e1; e2 = (b == j) ? (int)(L2[j] & 127u) : e2; }
            eo[i] = (127 - e1) * 128 + (127 - e2); go[i] = __expf(key2f(L3[i] & ~255u) - cmax); gsum += go[i]; }
        const float ginv = 1.0f / gsum;
        int* ep = EIDX + (size_t)tok * 128 + h * 16; float* gp = EGATE + (size_t)tok * 128 + h * 16;
#pragma unroll
        for (int q = 0; q < 4; ++q) { *(u32x4*)(ep + 4 * q) = (u32x4){(unsigned)eo[4 * q], (unsigned)eo[4 * q + 1], (unsigned)eo[4 * q + 2], (unsigned)eo[4 * q + 3]};
            *(f32x4*)(gp + 4 * q) = (f32x4){go[4 * q] * ginv, go[4 * q + 1] * ginv, go[4 * q + 2] * ginv, go[4 * q + 3] * ginv}; }
    }
}
constexpr size_t PE_US = 0, PE_VS = 8 * MiB, PE_USC = 16 * MiB, PE_VSC = 17 * MiB;
__device__ __forceinline__ u32x4 pack_fp4_32(const f32x4 (&v)[8], float isc) {
    unsigned w[4];
#pragma unroll
    for (int d = 0; d < 4; ++d) { unsigned t = 0u;
        t = __builtin_amdgcn_cvt_scalef32_pk_fp4_f32(t, v[2 * d][0] * isc, v[2 * d][1] * isc, 1.0f, 0); t = __builtin_amdgcn_cvt_scalef32_pk_fp4_f32(t, v[2 * d][2] * isc, v[2 * d][3] * isc, 1.0f, 1);
        t = __builtin_amdgcn_cvt_scalef32_pk_fp4_f32(t, v[2 * d + 1][0] * isc, v[2 * d + 1][1] * isc, 1.0f, 2); t = __builtin_amdgcn_cvt_scalef32_pk_fp4_f32(t, v[2 * d + 1][2] * isc, v[2 * d + 1][3] * isc, 1.0f, 3);
        w[d] = t; }
    return (u32x4){w[0], w[1], w[2], w[3]};
}
__device__ __forceinline__ float fp4_block_scale(const f32x4 (&v)[8]) {
    float am = 0.f;
#pragma unroll
    for (int q = 0; q < 8; ++q) am = fmaxf(am, fmaxf(fmaxf(fabsf(v[q][0]), fabsf(v[q][1])), fmaxf(fabsf(v[q][2]), fabsf(v[q][3]))));
    am = fmaxf(am, 1e-30f);
    const int eb = (int)((__float_as_uint(am) >> 23) & 0xffu);
    float sc = __uint_as_float((unsigned)(eb - 2) << 23);
    if (am > 6.0f * sc) sc *= 2.0f;
    return sc;
}
__device__ __forceinline__ void conv_peer_tables(const float* pu, const float* pv, unsigned char* dst) {
    const int tid = fresh_tid(); const int lane = tid & 63, hl = lane & 31, gw = blockIdx.x * 8 + (tid >> 6), nw = gridDim.x * 8;
    const int q = hl >> 3, c = hl & 7;
    for (int r2 = gw; r2 < 8192; r2 += nw) {
        const int e = 2 * r2 + (lane >> 5);
        f32x4 a[8], b[8];
#pragma unroll
        for (int k = 0; k < 8; ++k) { a[k] = *(const f32x4*)(pu + (size_t)e * 1024 + 32 * hl + 4 * k); b[k] = *(const f32x4*)(pv + (size_t)e * 1024 + 32 * hl + 4 * k); }
        const float su = fp4_block_scale(a), sv = fp4_block_scale(b);
        const size_t row = (size_t)q * 16384 + e;
        *(u32x4*)(dst + PE_US + row * 128 + 16 * c) = pack_fp4_32(a, 1.0f / su);
        *(u32x4*)(dst + PE_VS + row * 128 + 16 * c) = pack_fp4_32(b, 1.0f / sv);
        dst[PE_USC + row * 16 + 2 * (c & 3) + (c >> 2)] = (unsigned char)((__float_as_uint(su) >> 23) & 0xffu);
        dst[PE_VSC + row * 8 + c] = (unsigned char)((__float_as_uint(sv) >> 23) & 0xffu);
    }
}
typedef float f32x2g __attribute__((ext_vector_type(2)));
typedef int v8i_t __attribute__((ext_vector_type(8)));
typedef int v4i_u __attribute__((ext_vector_type(4)));
#define FP4X2(w, b) __builtin_amdgcn_cvt_scalef32_pk_f32_fp4((w), 1.0f, (b))
__device__ __forceinline__ void peer_slice_map(const Params& p, LAS unsigned char* lds, int& q, int& half, int& bx, int& nbx) {
    LAS int* sm = (LAS int*)(lds + LDS_BAR_OFF - 32);
    __syncthreads();
    if (threadIdx.x == 0) {
        unsigned* barw = (unsigned*)(fresh_ptr(p.ws) + WS_CTL);
        const unsigned x = xb_xcc_id(); bool hw = x < 8u; unsigned mine = 0u;
        for (unsigned jx = 0; jx < 16; ++jx) { const unsigned cn = xb_ld(&barw[XB_XCNT(jx)]); if (jx < 8u) hw = hw && (cn > 0u); else hw = hw && (cn == 0u); if (jx == x) mine = cn; }
        const unsigned rk = ((volatile LAS unsigned*)(lds + LDS_BAR_OFF))[2];
        hw = hw && rk >= 1u && rk <= mine;
#if MK_MULTI || defined(MPROBE) || defined(PROBE_CHK) || defined(PROBE_DET) || defined(PROBE_K) || defined(NO_HW_MAP)
        hw = false;
#endif
        const int xcd = hw ? (int)x : (int)(blockIdx.x & 7);
        sm[0] = xcd & 3; sm[1] = xcd >> 2; sm[2] = hw ? (int)(rk - 1u) : (int)(blockIdx.x >> 3); sm[3] = hw ? (int)mine : (int)((gridDim.x + 7 - xcd) >> 3);
    }
    __syncthreads();
    q = sm[0]; half = sm[1]; bx = sm[2]; nbx = sm[3];
    __syncthreads();
}
__device__ __forceinline__ void peer_udot_phase(const Params& p, LAS unsigned char* lds, int var) {
    (void)var;
#ifdef ATT_PROBE
#define PUV(bit) (var & (bit))
#else
#define PUV(bit) 0
#endif
    unsigned char* const wsl = fresh_ptr(p.ws);
    const bf16_t* XN = (const bf16_t*)(wsl + WS_XN); const int* EIDX = (const int*)(wsl + WS_YC); bf16_t* PZ = (bf16_t*)(wsl + WS_R);
    const int tid = fresh_tid(); const int lane = tid & 63, wv = __builtin_amdgcn_readfirstlane(tid >> 6), fr = lane & 15, fq = lane >> 4;
    int q, half, bx, nbx; peer_slice_map(p, lds, q, half, bx, nbx);
    const unsigned char* US = wsl + WS_YA + PE_US + (size_t)q * 16384 * 128; const unsigned char* USC = wsl + WS_YA + PE_USC + (size_t)q * 16384 * 16;
    LAS unsigned* eid = (LAS unsigned*)(lds + wv * 512);
    LAS unsigned char* xb = lds + 4096 + wv * 512;
    LAS unsigned char* usl = lds + 8192 + wv * 2048;
    LAS unsigned char* ub = lds + 24576 + wv * 16384;
    const int stride = nbx * 8, tlim = T_TOK / 2;
    int ti = bx * 8 + wv;
    if (ti >= tlim) return;
    unsigned idr[16], es0, es1;
#define PU_IDS() { _Pragma("unroll") for (int i = 0; i < 16; ++i) idr[i] = eid[8 * i + (lane >> 3)]; es0 = eid[lane]; es1 = eid[64 + lane]; asm volatile("s_waitcnt lgkmcnt(0)" ::: "memory"); }
#define PU_ROWS(i0) { _Pragma("unroll") for (int i = (i0); i < (i0) + 8; ++i) { const int k = 8 * i + (lane >> 3); \
        const unsigned char* src = US + (unsigned)(idr[i] * 128u + 16u * (unsigned)((lane & 7) ^ ((k >> 1) & 7)));     \
        __builtin_amdgcn_global_load_lds((const unsigned*)src, (LAS unsigned*)(ub + i * 1024), 16, 0, 0); } }
#define PU_SMALL(tx, te) if (!PUV(32)) { \
        __builtin_amdgcn_global_load_lds((const unsigned*)(USC + (unsigned)(es0 * 16u)), (LAS unsigned*)usl, 16, 0, 0); __builtin_amdgcn_global_load_lds((const unsigned*)(USC + (unsigned)(es1 * 16u)), (LAS unsigned*)(usl + 1024), 16, 0, 0); \
        if (lane < 32) { __builtin_amdgcn_global_load_lds((const unsigned*)(XN + (size_t)(tx) * 1024 + 256 * q) + 4 * lane, (LAS unsigned*)xb, 16, 0, 0); }          \
        if (lane < 32) { __builtin_amdgcn_global_load_lds((const unsigned*)(EIDX + (size_t)(te) * 128) + 4 * lane, eid, 16, 0, 0); } }
    {   const int tok0 = half * tlim + ti, tn = (ti + stride < tlim) ? tok0 + stride : tok0;
        eid[lane] = (unsigned)EIDX[(size_t)tok0 * 128 + lane]; eid[64 + lane] = (unsigned)EIDX[(size_t)tok0 * 128 + 64 + lane];
        PU_IDS()
        PU_ROWS(0) PU_SMALL(tok0, tn) PU_ROWS(8) }
    bool first = true;
    for (; ti < tlim; ti += stride) {
        const int tok = half * tlim + ti;
        if (first) asm volatile("s_waitcnt vmcnt(8)" ::: "memory"); else asm volatile("s_waitcnt vmcnt(9)" ::: "memory");
        first = false;
        v8i_t xq[2];
#pragma unroll
        for (int k = 0; k < 8; ++k) { const u32x4 w = *(const LAS u32x4*)(xb + 2 * (128 * (k >> 2) + 16 * fq + 64 * ((k >> 1) & 1) + 8 * (k & 1))); unsigned d0 = 0u, d1 = 0u;
            d0 = __builtin_amdgcn_cvt_pk_fp8_f32(bf_lo(w.x), bf_hi(w.x), d0, false); d0 = __builtin_amdgcn_cvt_pk_fp8_f32(bf_lo(w.y), bf_hi(w.y), d0, true);
            d1 = __builtin_amdgcn_cvt_pk_fp8_f32(bf_lo(w.z), bf_hi(w.z), d1, false); d1 = __builtin_amdgcn_cvt_pk_fp8_f32(bf_lo(w.w), bf_hi(w.w), d1, true);
            xq[k >> 2][2 * (k & 3)] = (int)d0; xq[k >> 2][2 * (k & 3) + 1] = (int)d1; }
        unsigned usc[8]; u32x4 a0[4], a1[4];
#pragma unroll
        for (int b = 0; b < 8; ++b) usc[b] = *(const LAS unsigned short*)(usl + 16 * (16 * b + fr) + 2 * fq);
#pragma unroll
        for (int b = 0; b < 4; ++b) { const LAS unsigned char* row = ub + (16 * b + fr) * 128; const int sw = fr >> 1;
            a0[b] = *(const LAS u32x4*)(row + ((fq ^ sw) << 4)); a1[b] = *(const LAS u32x4*)(row + (((4 + fq) ^ sw) << 4)); }
        PU_IDS()
        {   const int tn = (ti + stride < tlim) ? tok + stride : tok, t2 = (ti + 2 * stride < tlim) ? tok + 2 * stride : tok;
            PU_ROWS(0) PU_SMALL(tn, t2) }
        f32x4 keep = (f32x4){0.f, 0.f, 0.f, 0.f};
#define PU_MMA(b, A0, A1) { const v4i_u q0 = (v4i_u){(int)A0.x, (int)A0.y, (int)A0.z, (int)A0.w}, q1 = (v4i_u){(int)A1.x, (int)A1.y, (int)A1.z, (int)A1.w}; \
            const v8i_t av0 = __builtin_shufflevector(q0, q0, 0, 1, 2, 3, -1, -1, -1, -1), av1 = __builtin_shufflevector(q1, q1, 0, 1, 2, 3, -1, -1, -1, -1);     \
            f32x4 dacc = __builtin_amdgcn_mfma_scale_f32_16x16x128_f8f6f4(av0, xq[0], (f32x4){0.f, 0.f, 0.f, 0.f}, 4, 0, 0, (int)usc[b], 0, 127); \
            dacc = __builtin_amdgcn_mfma_scale_f32_16x16x128_f8f6f4(av1, xq[1], dacc, 4, 0, 1, (int)usc[b], 0, 127); \
            if ((fr & 7) == (b)) keep = dacc; }
#pragma unroll
        for (int b = 0; b < 4; ++b) PU_MMA(b, a0[b], a1[b])
        asm volatile("s_waitcnt vmcnt(12)" : "+v"(keep) :: "memory");
#pragma unroll
        for (int b = 0; b < 4; ++b) { const LAS unsigned char* row = ub + (64 + 16 * b + fr) * 128; const int sw = fr >> 1;
            a0[b] = *(const LAS u32x4*)(row + ((fq ^ sw) << 4)); a1[b] = *(const LAS u32x4*)(row + (((4 + fq) ^ sw) << 4)); }
        asm volatile("s_waitcnt lgkmcnt(0)" ::: "memory");
        PU_ROWS(8)
#pragma unroll
        for (int b = 0; b < 4; ++b) PU_MMA(4 + b, a0[b], a1[b])
        asm volatile("" : "+v"(keep));
        if (fr < 8) { u32x2 o; o.x = cvt_pk_bf16(keep[0], keep[1]); o.y = cvt_pk_bf16(keep[2], keep[3]);
            *(u32x2*)(PZ + ((size_t)q * T_TOK + tok) * 128 + 16 * fr + 4 * fq) = o; }
    }
#undef PU_IDS
#undef PU_ROWS
#undef PU_SMALL
#undef PU_MMA
#undef PUV
}
struct PvCoefIn { unsigned w0, w1, w2, w3; f32x2g g; u32x2 e; u32x2 s0, s1; };
typedef int v2i_t __attribute__((ext_vector_type(2)));
typedef int v4i_t __attribute__((ext_vector_type(4)));
typedef unsigned short u16x2_t __attribute__((ext_vector_type(2)));
__device__ __forceinline__ unsigned max_byte8(u32x2 s) {
    const unsigned a = s.x & 0x00ff00ffu, b = (s.x >> 8) & 0x00ff00ffu, c = s.y & 0x00ff00ffu, d = (s.y >> 8) & 0x00ff00ffu;
    const u16x2_t m = __builtin_elementwise_max(__builtin_elementwise_max(__builtin_bit_cast(u16x2_t, a), __builtin_bit_cast(u16x2_t, b)), __builtin_elementwise_max(__builtin_bit_cast(u16x2_t, c), __builtin_bit_cast(u16x2_t, d)));
    return m.x > m.y ? (unsigned)m.x : (unsigned)m.y;
}
__device__ __forceinline__ void peer_vacc_phase(const Params& p, LAS unsigned char* lds, const float* xin, float* xout, int var) {
#ifdef ATT_PROBE
#define PVV(bit) (var & (bit))
#else
#define PVV(bit) 0
#endif
    unsigned char* const wsl = fresh_ptr(p.ws);
    const int* EIDX = (const int*)(wsl + WS_YC); const float* EGATE = (const float*)(wsl + WS_YC + 16 * MiB); const bf16_t* PZ = (const bf16_t*)(wsl + WS_R);
    const int tid = fresh_tid(); const int lane = tid & 63, wv = __builtin_amdgcn_readfirstlane(tid >> 6), fr = lane & 15, fq = lane >> 4;
    int q, half, bx, nbx; peer_slice_map(p, lds, q, half, bx, nbx);
    const unsigned char* VS = wsl + WS_YA + PE_VS + (size_t)q * 16384 * 128; const unsigned char* VSC = wsl + WS_YA + PE_VSC + (size_t)q * 16384 * 8;
    LAS unsigned char* ec = lds + wv * 1024;
    LAS unsigned* eidr = (LAS unsigned*)(lds + 8192 + wv * 1536);
    LAS unsigned char* ub = lds + 20480 + wv * 16384;
    const int stride = nbx * 8, tlim = T_TOK / 2;
    int ti = bx * 8 + wv;
    if (ti >= tlim) return;
#define PV_TOK(k_) (half * tlim + ((ti + (k_) * stride < tlim) ? ti + (k_) * stride : ti))
#define PV_LDR(tk, R) { const size_t tb = (size_t)(tk) * 128 + 2 * lane; R.w0 = *(const unsigned*)(PZ + tb); R.w1 = *(const unsigned*)(PZ + (size_t)T_TOK * 128 + tb); \
        R.w2 = *(const unsigned*)(PZ + (size_t)2 * T_TOK * 128 + tb); R.w3 = *(const unsigned*)(PZ + (size_t)3 * T_TOK * 128 + tb); R.g = *(const f32x2g*)(EGATE + tb); }
#define PV_LDS(R, slot) { const u32x2 e2 = *(const LAS u32x2*)(eidr + 128 * (slot) + 2 * lane); R.s0 = *(const u32x2*)(VSC + (size_t)e2.x * 8); R.s1 = *(const u32x2*)(VSC + (size_t)e2.y * 8); }
#define PV_S2(R, SOUT) { const float z0 = bf_lo(R.w0) + bf_lo(R.w1) + bf_lo(R.w2) + bf_lo(R.w3), z1 = bf_hi(R.w0) + bf_hi(R.w1) + bf_hi(R.w2) + bf_hi(R.w3); \
        const float c0 = gelu1(z0) * R.g.x, c1 = gelu1(z1) * R.g.y; \
        float am = fmaxf(fabsf(c0) * __uint_as_float(max_byte8(R.s0) << 23), fabsf(c1) * __uint_as_float(max_byte8(R.s1) << 23)); \
        am = __uint_as_float(dpp_max_u32(__float_as_uint(am)));            \
        int sx = 134 - (int)((__float_as_uint(am) >> 23) & 255u); sx = sx > 100 ? 100 : (sx < -100 ? -100 : sx); SOUT = sx; \
        const float up = __uint_as_float((unsigned)(127 + sx) << 23); const float f0 = c0 * up, f1 = c1 * up; \
        _Pragma("unroll") for (int cc = 0; cc < 8; ++cc) { const unsigned b0 = ((cc < 4 ? R.s0.x : R.s0.y) >> (8 * (cc & 3))) & 0xffu, b1 = ((cc < 4 ? R.s1.x : R.s1.y) >> (8 * (cc & 3))) & 0xffu; \
            const unsigned w = __builtin_amdgcn_cvt_pk_fp8_f32(f0 * __uint_as_float(b0 << 23), f1 * __uint_as_float(b1 << 23), 0u, false); \
            *(LAS unsigned short*)(ec + 128 * cc + 2 * lane) = (unsigned short)w; } }
#define PV_IDS(slot) { _Pragma("unroll") for (int i = 0; i < 16; ++i) idr[i] = eidr[128 * (slot) + 8 * i + (lane >> 3)]; }
#define PV_DMA(slot) { _Pragma("unroll") for (int i = 0; i < 16; ++i) { const int k = 8 * i + (lane >> 3); \
        const unsigned char* src = VS + (unsigned)(idr[i] * 128u + 16u * (unsigned)((lane & 7) ^ ((k >> 1) & 7))); \
        __builtin_amdgcn_global_load_lds((const unsigned*)src, (LAS unsigned*)(ub + i * 1024), 16, 0, 0); } }
#define PV_EDMA(tk, slot) { if (lane < 32) { __builtin_amdgcn_global_load_lds((const unsigned*)(EIDX + (size_t)(tk) * 128) + 4 * lane, eidr + 128 * (slot), 16, 0, 0); } }
    PvCoefIn r; float xn[4]; int s_cur = 0, s_next = 0; unsigned idr[16]; float pend[4] = {0.f, 0.f, 0.f, 0.f}; size_t pend_eo = 0; bool have_pend = false;
    int s0 = 0, s1 = 1, s2 = 2;
    {   const int tokA = PV_TOK(0), tokB = PV_TOK(1), tokC = PV_TOK(2);
        eidr[lane] = (unsigned)EIDX[(size_t)tokA * 128 + lane]; eidr[64 + lane] = (unsigned)EIDX[(size_t)tokA * 128 + 64 + lane];
        eidr[128 + lane] = (unsigned)EIDX[(size_t)tokB * 128 + lane]; eidr[192 + lane] = (unsigned)EIDX[(size_t)tokB * 128 + 64 + lane];
        eidr[256 + lane] = (unsigned)EIDX[(size_t)tokC * 128 + lane]; eidr[320 + lane] = (unsigned)EIDX[(size_t)tokC * 128 + 64 + lane];
        PV_LDR(tokA, r) PV_LDS(r, 0) PV_S2(r, s_cur)
        PV_LDR(tokB, r) PV_LDS(r, 1)
        const size_t eo0 = (size_t)tokA * 1024 + 256 * q + 128 * (fq & 1) + 16 * (fq >> 1) + fr;
#pragma unroll
        for (int i = 0; i < 4; ++i) xn[i] = xin[eo0 + 32 * i];
        PV_IDS(0)
        asm volatile("s_waitcnt lgkmcnt(0)" ::: "memory");
        PV_DMA(0) }
    for (; ti < tlim; ti += stride) {
        const int tok = half * tlim + ti;
        const size_t eo = (size_t)tok * 1024 + 256 * q + 128 * (fq & 1) + 16 * (fq >> 1) + fr;
        v8i_t av;
        { const u32x4 alo = *(const LAS u32x4*)(ec + 128 * (fr & 7) + 16 * fq), ahi = *(const LAS u32x4*)(ec + 128 * (fr & 7) + 64 + 16 * fq);
          av[0] = (int)alo.x; av[1] = (int)alo.y; av[2] = (int)alo.z; av[3] = (int)alo.w; av[4] = (int)ahi.x; av[5] = (int)ahi.y; av[6] = (int)ahi.z; av[7] = (int)ahi.w; }
        asm volatile("s_waitcnt vmcnt(0) lgkmcnt(0)" : "+v"(av) :: "memory");
        if (have_pend && !PVV(64)) {
#pragma unroll
            for (int i = 0; i < 4; ++i) xout[pend_eo + 32 * i] = pend[i]; }
        float xv[4];
#pragma unroll
        for (int i = 0; i < 4; ++i) xv[i] = xn[i];
        PvCoefIn rc = r;
        asm volatile("" : "+v"(rc.w0), "+v"(rc.w1), "+v"(rc.w2), "+v"(rc.w3), "+v"(rc.g), "+v"(rc.s0), "+v"(rc.s1));
        { const int tok1 = PV_TOK(1), tok2 = PV_TOK(2);
          if (!PVV(1024)) { PV_LDR(tok2, r) PV_LDS(r, s2) }
          const size_t eo1 = (size_t)tok1 * 1024 + 256 * q + 128 * (fq & 1) + 16 * (fq >> 1) + fr;
#pragma unroll
          for (int i = 0; i < 4; ++i) xn[i] = (PVV(64) || PVV(1024)) ? 0.f : xin[eo1 + 32 * i]; }
        v2i_t bt[16][2];
#pragma unroll
        for (int nt = 0; nt < 16; ++nt)
#pragma unroll
            for (int h = 0; h < 2; ++h) { const int k = 32 * fq + 16 * h + fr;
                if (PVV(128)) bt[nt][h] = (v2i_t){k, nt}; else bt[nt][h] = __builtin_amdgcn_ds_read_tr4_b64_v2i32((LAS v2i_t*)(ub + k * 128 + ((((nt >> 1) ^ (fr >> 1)) & 7) << 4) + 8 * (nt & 1))); }
        PV_IDS(s1)
        asm volatile("s_waitcnt lgkmcnt(0)" ::: "memory");
        if (!PVV(256)) PV_DMA(s1)
        { const int tok3 = PV_TOK(3); PV_EDMA(tok3, s0) }
        if (!PVV(512)) PV_S2(rc, s_next)
        float o[4] = {0.f, 0.f, 0.f, 0.f};
#pragma unroll
        for (int nt = 0; nt < 16; ++nt) {
            const v4i_t b4 = (v4i_t){bt[nt][0].x, bt[nt][0].y, bt[nt][1].x, bt[nt][1].y}; const v8i_t bv = __builtin_shufflevector(b4, b4, 0, 1, 2, 3, -1, -1, -1, -1);
            const f32x4 cacc = PVV(128) ? (f32x4){(float)b4[0], (float)b4[1], (float)b4[2], (float)b4[3]} : __builtin_amdgcn_mfma_scale_f32_16x16x128_f8f6f4(av, bv, (f32x4){0.f, 0.f, 0.f, 0.f}, 0, 4, 0, 127, 0, 127);
            const bool mine = ((nt >> 3) == (fq & 1)) && ((nt & 1) == (fq >> 1));
            o[(nt >> 1) & 3] = mine ? cacc[(nt >> 1) & 3] : o[(nt >> 1) & 3];
        }
        const float dn = __uint_as_float((unsigned)(127 - s_cur) << 23);
#pragma unroll
        for (int i = 0; i < 4; ++i) pend[i] = xv[i] + o[i] * dn;
        pend_eo = eo; have_pend = true;
        s_cur = s_next;
        { const int tmp = s0; s0 = s1; s1 = s2; s2 = tmp; }
    }
    if (have_pend) {
#pragma unroll
        for (int i = 0; i < 4; ++i) xout[pend_eo + 32 * i] = pend[i]; }
#undef PV_TOK
#undef PV_LDR
#undef PV_LDS
#undef PV_EDMA
#undef PV_IDS
#undef PV_S2
#undef PV_DMA
#undef PVV
}
#ifdef PROBE_K
struct DumpSeg { const void* p; size_t n; long long kind; };
__global__ void __launch_bounds__(512) probe_dump(float* out, DumpSeg s0, DumpSeg s1, DumpSeg s2, DumpSeg s3, DumpSeg s4, DumpSeg s5) {
    const DumpSeg segs[6] = {s0, s1, s2, s3, s4, s5};
    const size_t NOUT = (size_t)T_TOK * DM;
    for (size_t i = (size_t)blockIdx.x * 512 + threadIdx.x; i < NOUT; i += (size_t)gridDim.x * 512) {
        float acc = 0.f;
#pragma unroll
        for (int k = 0; k < 6; ++k) { const DumpSeg s = segs[k]; if (s.p == nullptr || s.n == 0) continue;
            for (size_t j = i; j < s.n; j += NOUT) { float v;
                if (s.kind == 0) v = bf2f(((const bf16_t*)s.p)[j]); else if (s.kind == 1) v = ((const float*)s.p)[j]; else if (s.kind == 2) v = (float)((const unsigned short*)s.p)[j] * (1.0f / 65536.0f); else v = (float)(((const int*)s.p)[j] & 0xffff) * (1.0f / 65536.0f);
                if (!(fabsf(v) < 1e30f)) v = 12345.0f;
                acc += v; }
            if (s.n < NOUT) { const size_t j = i % s.n; float v;
                if (s.kind == 0) v = bf2f(((const bf16_t*)s.p)[j]); else if (s.kind == 1) v = ((const float*)s.p)[j]; else if (s.kind == 2) v = (float)((const unsigned short*)s.p)[j] * (1.0f / 65536.0f); else v = (float)(((const int*)s.p)[j] & 0xffff) * (1.0f / 65536.0f);
                if (!(fabsf(v) < 1e30f)) v = 12345.0f;
                if (i >= s.n) acc += v; } }
        out[i] = acc; }
}
#endif
#ifdef PROBE_DET
struct CkSeg { const void* p; size_t nbytes; };
__global__ void __launch_bounds__(512) probe_cksum(unsigned long long* dst, CkSeg s0, CkSeg s1, CkSeg s2, CkSeg s3) {
    const CkSeg segs[4] = {s0, s1, s2, s3};
    unsigned long long h = 0ull;
    for (int k = 0; k < 4; ++k) { const CkSeg s = segs[k]; if (s.p == nullptr) continue; const unsigned* w = (const unsigned*)s.p; const size_t n = s.nbytes / 4;
        for (size_t i = (size_t)blockIdx.x * 512 + threadIdx.x; i < n; i += (size_t)gridDim.x * 512) h += (unsigned long long)w[i] * (unsigned long long)(i * 2654435761ull + 12345ull + (unsigned long long)k * 977ull); }
    for (int o = 32; o; o >>= 1) h += __shfl_xor(h, o);
    if ((threadIdx.x & 63) == 0) atomicAdd(dst, h);
}
__global__ void __launch_bounds__(512) probe_mark(float* out, const unsigned long long* cks, int nph) {
    int code = 0;
    for (int k = nph - 1; k >= 0; --k) if (cks[k] != cks[32 + k] || cks[k] != cks[64 + k]) code = k + 1;
    if (code == 0) return;
    const float f = 2.0f;
    for (size_t i = (size_t)blockIdx.x * 512 + threadIdx.x; i < (size_t)T_TOK * DM; i += (size_t)gridDim.x * 512) out[i] *= f;
}
#endif

#ifdef PROBE_CHK
__device__ __forceinline__ unsigned hsh(unsigned x) { x ^= x >> 16; x *= 0x7feb352du; x ^= x >> 15; x *= 0x846ca68bu; x ^= x >> 16; return x; }
__device__ __forceinline__ void chk_fail(unsigned* flag, int code) { atomicMin(flag, (unsigned)code); }
__device__ __forceinline__ bool close_to(float a, float ref, float atol, float rtol) { return fabsf(a - ref) <= atol + rtol * fabsf(ref) && (a == a); }
__device__ __forceinline__ int h_origcol(int c) { if (c < 1024) return c; if (c < 1536) return c + 512; if (c < 2048) return c + 512; if (c < 2560) return c + 512; if (c < 3072) return c + 768; if (c < 3200) return c; if (c < 3264) return c + 640; return c + 640; }
__device__ __forceinline__ float ref_gelu(float x) { return 0.5f * x * (1.0f + erff(x * 0.70710678f)); }
__global__ void chk_h(Params p, int l, unsigned* flag) {
    const unsigned s = blockIdx.x * blockDim.x + threadIdx.x; const int t = hsh(s * 2 + 1) % T_TOK; const int c = hsh(s * 2 + 2) % 3272;
    const bf16_t* XN = (const bf16_t*)(p.ws + WS_XN); const bf16_t* H = (const bf16_t*)(p.ws + WS_R + R_H); const bf16_t* VT = (const bf16_t*)(p.ws + WS_R + R_VT);
    const float* win = p.in[I_W_IN] + (size_t)l * 1024 * DIN; const int oc = h_origcol(c);
    float r = 0.f; for (int k = 0; k < 1024; ++k) r += bf2f(XN[(size_t)t * 1024 + k]) * win[(size_t)k * DIN + oc];
    if (!close_to(bf2f(H[(size_t)t * HN + c]), r, 0.06f, 0.03f)) chk_fail(flag, 1);
    const int m = hsh(s * 2 + 77) % 640; const int vc = m < 512 ? 1024 + m : 3200 + (m - 512);
    float r2 = 0.f; for (int k = 0; k < 1024; ++k) r2 += bf2f(XN[(size_t)t * 1024 + k]) * win[(size_t)k * DIN + vc];
    if (!close_to(bf2f(VT[(size_t)m * T_TOK + t]), r2, 0.06f, 0.03f)) chk_fail(flag, 2);
}
__global__ void chk_post(Params p, int l, unsigned* flag) {
    const unsigned s = blockIdx.x * blockDim.x + threadIdx.x; const int t = hsh(s * 3 + 1) % T_TOK; const int g = hsh(s * 3 + 2) & 3; const int d = hsh(s * 3 + 3) & 127;
    const bf16_t* H = (const bf16_t*)(p.ws + WS_R + R_H); const bf16_t* YB = (const bf16_t*)(p.ws + WS_YB);
    const int c0 = (t / 128) * 128, tt = t % 128;
    const float* W = p.in[I_BWS] + ((size_t)(l * 4 + g) * 128) * 128; const float* bs = p.in[I_BBS] + (size_t)(l * 4 + g) * 128; const float* vg = p.in[I_BVG] + l * 512 + g * 128;
    float sv = 0.f;
    for (int ss = 0; ss <= tt; ++ss) { const bf16_t* row = H + (size_t)(c0 + ss) * HN + HC_ZV + g * 128; float q = 0.f; for (int dd = 0; dd < 128; ++dd) { const float v = ref_gelu(bf2f(row[dd])); q += v * v; }
        const float vn = ref_gelu(bf2f(row[d])) * rsqrtf(q / 128.f + EPSF) * vg[d]; sv += W[tt * 128 + ss] * vn; }
    sv += bs[tt];
    const float r = ref_gelu(bf2f(H[(size_t)t * HN + HC_ZU + g * 128 + d])) * sv;
    if (!close_to(bf2f(YB[(size_t)t * 512 + g * 128 + d]), r, 0.03f, 0.04f)) chk_fail(flag, 3);
    { const int grp = hsh(s * 3 + 9) & 7; const float* gn = p.in[I_AKG] + l * 64; float q = 0.f; for (int j = 0; j < 64; ++j) { const float v = bf2f(H[(size_t)t * HN + HC_KA + grp * 64 + j]) / gn[j]; q += v * v; }
        if (!close_to(q / 64.f, 1.0f, 0.03f, 0.f)) chk_fail(flag, 5);
        const float* gc = p.in[I_CKG] + l * 128; q = 0.f; for (int j = 0; j < 128; ++j) { const float v = bf2f(H[(size_t)t * HN + HC_CK + j]) / gc[j]; q += v * v; }
        if (!close_to(q / 128.f, 1.0f, 0.03f, 0.f)) chk_fail(flag, 5); }
}
__global__ void chk_mask(Params p, unsigned* flag) {
    const unsigned s = blockIdx.x * blockDim.x + threadIdx.x; const int b = hsh(s * 5 + 1) & 15; const int q = hsh(s * 5 + 2) & 2047;
    const bf16_t* H = (const bf16_t*)(p.ws + WS_R + R_H); const unsigned short* mask = (const unsigned short*)(p.ws + WS_MASK);
    const size_t tq = (size_t)b * SEQ + q;
    int cnt = 0; float minsel = 3e38f, maxuns = -3e38f;
    for (int k = 0; k < SEQ; ++k) { const bool sel = (mask[tq * 128 + (k >> 4)] >> (k & 15)) & 1; if (k > q) { if (k <= (q | 63) && sel) chk_fail(flag, 4); continue; }
        float sc = 0.f; for (int h = 0; h < 8; ++h) { float dt = 0.f; for (int d = 0; d < 64; ++d) dt += bf2f(H[tq * HN + HC_IQ + h * 64 + d]) * bf2f(H[((size_t)b * SEQ + k) * HN + HC_IK + d]); sc += fmaxf(dt, 0.f) * bf2f(H[tq * HN + HC_IW + h]); }
        if (sel) { ++cnt; minsel = fminf(minsel, sc); } else maxuns = fmaxf(maxuns, sc); }
    const int want = (q + 1 < 256) ? q + 1 : 256;
    if (cnt < want || cnt > want + 2) chk_fail(flag, 4);
    if (q >= 256 && minsel < maxuns - 0.02f * (fabsf(maxuns) + 1.f)) chk_fail(flag, 4);
}
__global__ void chk_attn(Params p, int l, unsigned* flag) {
    __shared__ float qn_s[64][130]; __shared__ float o_s[64][130];
    float* qn = qn_s[threadIdx.x]; float* o = o_s[threadIdx.x];
    const unsigned s = blockIdx.x * blockDim.x + threadIdx.x; const int b = hsh(s * 7 + 1) & 15, h = hsh(s * 7 + 2) & 3, q = hsh(s * 7 + 3) & 2047;
    const bf16_t* H = (const bf16_t*)(p.ws + WS_R + R_H); const bf16_t* VT = (const bf16_t*)(p.ws + WS_R + R_VT); const bf16_t* YA = (const bf16_t*)(p.ws + WS_YA);
    const float* lamv = (const float*)(p.ws + WS_CTL + CTL_LAM); const float lam = lamv[l * 2], lam_init = lamv[l * 2 + 1];
    const float* rb = p.in[I_RELB]; const size_t tq = (size_t)b * SEQ + q; const float* qg = p.in[I_AQG] + l * 64; const float* sg = p.in[I_SUBLN] + l * 128;
    for (int sb = 0; sb < 2; ++sb) { float ss = 0.f; for (int d = 0; d < 64; ++d) { const float v = bf2f(H[tq * HN + HC_QA + h * 128 + sb * 64 + d]); ss += v * v; } const float r = rsqrtf(ss / 64.f + EPSF);
        for (int d = 0; d < 64; ++d) qn[sb * 64 + d] = bf2f(H[tq * HN + HC_QA + h * 128 + sb * 64 + d]) * r * qg[d]; }
    for (int d = 0; d < 128; ++d) o[d] = 0.f;
    float mx0 = -3e38f, mx1 = -3e38f, l0 = 0.f, l1 = 0.f;
    for (int pass = 0; pass < 3; ++pass) {
        for (int k = 0; k <= q; ++k) { const int dist = q - k; int bk; if (dist < 16) bk = dist; else { int lg = 16 + (int)(logf((float)dist / 16.f) / 2.0794415416798357f * 16.f); bk = lg < 31 ? lg : 31; }
            const bf16_t* kr = H + ((size_t)b * SEQ + k) * HN + HC_KA + h * 128; float d0 = 0.f, d1 = 0.f;
            for (int e = 0; e < 64; ++e) { d0 += qn[e] * bf2f(kr[e]); d1 += qn[64 + e] * bf2f(kr[64 + e]); }
            const float g0 = d0 * 0.125f + rb[bk * 8 + h], g1 = d1 * 0.125f + rb[bk * 8 + h];
            if (pass == 0) { mx0 = fmaxf(mx0, g0); mx1 = fmaxf(mx1, g1); }
            else if (pass == 1) { l0 += expf(g0 - mx0); l1 += expf(g1 - mx1); }
            else { const float pd = expf(g0 - mx0) / l0 - lam * expf(g1 - mx1) / l1; for (int d = 0; d < 128; ++d) o[d] += pd * bf2f(VT[(size_t)(h * 128 + d) * T_TOK + (size_t)b * SEQ + k]); } } }
    float ssq = 0.f; for (int d = 0; d < 128; ++d) ssq += o[d] * o[d];
    const float sc = rsqrtf(ssq / 128.f + EPSF) * (1.f - lam_init);
    for (int d = 0; d < 128; d += 17) if (!close_to(bf2f(YA[tq * 512 + h * 128 + d]), o[d] * sc * sg[d], 0.03f, 0.05f)) chk_fail(flag, 6);
}
__global__ void chk_attnc(Params p, int l, unsigned* flag) {
    const unsigned s = blockIdx.x * blockDim.x + threadIdx.x; const int b = hsh(s * 11 + 1) & 15, h = hsh(s * 11 + 2) & 3, q = hsh(s * 11 + 3) & 2047;
    const bf16_t* H = (const bf16_t*)(p.ws + WS_R + R_H); const bf16_t* VT = (const bf16_t*)(p.ws + WS_R + R_VT); const bf16_t* YC = (const bf16_t*)(p.ws + WS_YC);
    const unsigned short* mask = (const unsigned short*)(p.ws + WS_MASK); const float* rb = p.in[I_RELB]; const size_t tq = (size_t)b * SEQ + q; const float* qg = p.in[I_CQG] + l * 128;
    float ss = 0.f; for (int d = 0; d < 128; ++d) { const float v = bf2f(H[tq * HN + HC_CQ + h * 128 + d]); ss += v * v; } const float r = rsqrtf(ss / 128.f + EPSF);
    float mx = -3e38f, ls = 0.f, o0 = 0.f, o1 = 0.f; const int d0 = hsh(s * 11 + 4) & 127, d1 = hsh(s * 11 + 5) & 127;
    for (int pass = 0; pass < 2; ++pass)
        for (int k = 0; k <= q; ++k) { if (!((mask[tq * 128 + (k >> 4)] >> (k & 15)) & 1)) continue;
            const int dist = q - k; int bk; if (dist < 16) bk = dist; else { int lg = 16 + (int)(logf((float)dist / 16.f) / 2.0794415416798357f * 16.f); bk = lg < 31 ? lg : 31; }
            float dt = 0.f; for (int d = 0; d < 128; ++d) dt += bf2f(H[tq * HN + HC_CQ + h * 128 + d]) * r * qg[d] * bf2f(H[((size_t)b * SEQ + k) * HN + HC_CK + d]);
            const float lg2 = dt * 0.08838834764831845f + rb[bk * 8 + 4 + h];
            if (pass == 0) mx = fmaxf(mx, lg2); else { const float pr = expf(lg2 - mx); ls += pr; o0 += pr * bf2f(VT[(size_t)(512 + d0) * T_TOK + (size_t)b * SEQ + k]); o1 += pr * bf2f(VT[(size_t)(512 + d1) * T_TOK + (size_t)b * SEQ + k]); } }
    if (!close_to(bf2f(YC[tq * 512 + h * 128 + d0]), o0 / ls, 0.02f, 0.05f)) chk_fail(flag, 7);
    if (!close_to(bf2f(YC[tq * 512 + h * 128 + d1]), o1 / ls, 0.02f, 0.05f)) chk_fail(flag, 7);
}
__global__ void chk_merge(Params p, int l, unsigned* flag) {
    const unsigned s = blockIdx.x * blockDim.x + threadIdx.x; const int t = hsh(s * 13 + 1) % T_TOK; const int j = hsh(s * 13 + 2) & 1023;
    const bf16_t* XN = (const bf16_t*)(p.ws + WS_XN); const bf16_t* G = (const bf16_t*)(p.ws + WS_R + R_G); const bf16_t* MG = (const bf16_t*)(p.ws + WS_R + R_MERGED);
    const float* win = p.in[I_W_IN] + (size_t)l * 1024 * DIN; float m = 0.f;
    for (int br = 0; br < 3; ++br) { float z = 0.f; for (int k = 0; k < 1024; ++k) z += bf2f(XN[(size_t)t * 1024 + k]) * win[(size_t)k * DIN + 3912 + br * 1024 + j];
        const float gt = 1.f / (1.f + expf(-z)); if (!close_to(bf2f(G[(size_t)t * 3072 + br * 1024 + j]), gt, 0.02f, 0.02f)) chk_fail(flag, 8);
        const bf16_t* Y = (const bf16_t*)(p.ws + (br == 0 ? WS_YA : br == 1 ? WS_YB : WS_YC)); const float* wb = p.in[br == 0 ? I_WBRA : br == 1 ? I_WBRB : I_WBRC] + (size_t)l * 512 * 1024;
        float y = 0.f; for (int k = 0; k < 512; ++k) y += bf2f(Y[(size_t)t * 512 + k]) * wb[(size_t)k * 1024 + j]; m += gt * y; }
    if (!close_to(bf2f(MG[(size_t)t * 1024 + j]), m, 0.04f, 0.04f)) chk_fail(flag, 9);
}
__global__ void chk_xmix(Params p, int l, const float* xsrc, unsigned* flag) {
    const unsigned s = blockIdx.x * blockDim.x + threadIdx.x; const int t = hsh(s * 17 + 1) % T_TOK; const int j = hsh(s * 17 + 2) & 1023;
    const bf16_t* MG = (const bf16_t*)(p.ws + WS_R + R_MERGED); const float* wo = p.in[I_WOUT] + (size_t)l * 1024 * 1024;
    float y = 0.f; for (int k = 0; k < 1024; ++k) y += bf2f(MG[(size_t)t * 1024 + k]) * wo[(size_t)k * 1024 + j];
    if (l == 0 && !close_to(p.out[(size_t)t * 1024 + j], xsrc[(size_t)t * 1024 + j] + y, 0.05f, 0.03f)) chk_fail(flag, 10);
}
__global__ void chk_xattn(Params p, int l, unsigned* flag) {
    const unsigned s = blockIdx.x * blockDim.x + threadIdx.x; const int b = hsh(s * 19 + 1) & 15, h = hsh(s * 19 + 2) & 3, q = hsh(s * 19 + 3) & 2047; const int d0 = hsh(s * 19 + 4) & 127;
    const bf16_t* QX = (const bf16_t*)(p.ws + WS_YA); const bf16_t* MK = (const bf16_t*)(p.ws + WS_MK); const bf16_t* MVT = (const bf16_t*)(p.ws + WS_MVT); const bf16_t* OX = (const bf16_t*)(p.ws + WS_YB);
    const bf16_t* XN = (const bf16_t*)(p.ws + WS_XN); const float* wq = p.in[I_MWQ] + (size_t)l * 1024 * 512; const size_t tq = (size_t)b * SEQ + q; const float* qg = p.in[I_MQG] + l * 128;
    { float z = 0.f; for (int k = 0; k < 1024; ++k) z += bf2f(XN[tq * 1024 + k]) * wq[(size_t)k * 512 + h * 128 + d0]; if (!close_to(bf2f(QX[tq * 512 + h * 128 + d0]), z, 0.06f, 0.03f)) chk_fail(flag, 11); }
    float ss = 0.f; for (int d = 0; d < 128; ++d) { const float v = bf2f(QX[tq * 512 + h * 128 + d]); ss += v * v; } const float r = rsqrtf(ss / 128.f + EPSF);
    float mx = -3e38f, ls = 0.f, o0 = 0.f;
    for (int pass = 0; pass < 2; ++pass) for (int k = 0; k < 256; ++k) { float dt = 0.f; for (int d = 0; d < 128; ++d) dt += bf2f(QX[tq * 512 + h * 128 + d]) * r * qg[d] * bf2f(MK[((size_t)b * 256 + k) * 512 + h * 128 + d]);
        const float lg2 = dt * 0.08838834764831845f; if (pass == 0) mx = fmaxf(mx, lg2); else { const float pr = expf(lg2 - mx); ls += pr; o0 += pr * bf2f(MVT[(size_t)(h * 128 + d0) * 4096 + b * 256 + k]); } }
    if (!close_to(bf2f(OX[tq * 512 + h * 128 + d0]), o0 / ls, 0.01f, 0.05f)) chk_fail(flag, 12);
}
__global__ void chk_ps(Params p, int l, unsigned* flag) {
    const unsigned s = blockIdx.x * blockDim.x + threadIdx.x; const int t = hsh(s * 23 + 1) % T_TOK; const int hh = hsh(s * 23 + 2) & 15, n = hsh(s * 23 + 3) & 127;
    const bf16_t* XN = (const bf16_t*)(p.ws + WS_XN); const float* PS = (const float*)(p.ws + WS_R + R_PS);
    const float* pwq = p.in[I_PWQ] + (size_t)l * 1024 * 2048; const float* sk = p.in[(hh & 1) ? I_SK2 : I_SK1] + (size_t)l * 128 * 128;
    float sc = 0.f; for (int d = 0; d < 128; ++d) { float qd = 0.f; for (int k = 0; k < 1024; ++k) qd += bf2f(XN[(size_t)t * 1024 + k]) * pwq[(size_t)k * 2048 + hh * 128 + d]; sc += qd * sk[n * 128 + d]; }
    if (!close_to(PS[(size_t)t * 2048 + hh * 128 + n], sc, 0.05f, 0.03f)) chk_fail(flag, 13);
}
__global__ void chk_topk(Params p, unsigned* flag) {
    const unsigned s = blockIdx.x * blockDim.x + threadIdx.x; const int t = hsh(s * 29 + 1) % T_TOK; const int h = hsh(s * 29 + 2) & 7;
    const float* PS = (const float*)(p.ws + WS_R + R_PS) + (size_t)t * 2048 + h * 256; const int* EIDX = (const int*)(p.ws + WS_YC) + (size_t)t * 128 + h * 16; const float* EG = (const float*)(p.ws + WS_YC + 16 * MiB) + (size_t)t * 128 + h * 16;
    __shared__ float csv_s[64][17]; float* csv = csv_s[threadIdx.x];
    float gsum = 0.f, mn = 3e38f, mxs = -3e38f;
    for (int i = 0; i < 16; ++i) { const int e = EIDX[i]; if (e < 0 || e >= 16384) { chk_fail(flag, 14); return; } const int e1 = e >> 7, e2 = e & 127; int r1 = 0, r2 = 0;
        for (int j = 0; j < 128; ++j) { if (PS[j] > PS[e1]) ++r1; if (PS[128 + j] > PS[128 + e2]) ++r2; }
        if (r1 >= 16 || r2 >= 16) chk_fail(flag, 14);
        csv[i] = PS[e1] + PS[128 + e2]; mn = fminf(mn, csv[i]); mxs = fmaxf(mxs, csv[i]); for (int j = 0; j < i; ++j) if (EIDX[j] == e) chk_fail(flag, 14); }
    for (int i = 0; i < 16; ++i) gsum += expf(csv[i] - mxs);
    for (int i = 0; i < 16; ++i) if (!close_to(EG[i], expf(csv[i] - mxs) / gsum, 0.003f, 0.02f)) chk_fail(flag, 14);
    int better = 0; for (int a = 0; a < 128; ++a) for (int b2 = 0; b2 < 128; ++b2) if (PS[a] + PS[128 + b2] > mn + 1e-4f) ++better;
    if (better > 15) chk_fail(flag, 14);
}
__global__ void chk_save_x(Params p, float* save) { const unsigned s = blockIdx.x * blockDim.x + threadIdx.x; const int t = hsh(s * 31 + 1) % T_TOK; const int d = hsh(s * 31 + 2) & 1023; save[s] = p.out[(size_t)t * 1024 + d]; }
__global__ void chk_gather(Params p, int l, const float* save, unsigned* flag) {
    const unsigned s = blockIdx.x * blockDim.x + threadIdx.x; const int t = hsh(s * 31 + 1) % T_TOK; const int d = hsh(s * 31 + 2) & 1023;
    const bf16_t* XN = (const bf16_t*)(p.ws + WS_XN); const int* EIDX = (const int*)(p.ws + WS_YC) + (size_t)t * 128; const float* EG = (const float*)(p.ws + WS_YC + 16 * MiB) + (size_t)t * 128;
    const float* pu = p.in[I_PU] + (size_t)l * 16384 * 1024; const float* pv = p.in[I_PV] + (size_t)l * 16384 * 1024; float inc = 0.f;
    for (int i = 0; i < 128; ++i) { const int e = EIDX[i]; float dt = 0.f; for (int k = 0; k < 1024; ++k) dt += bf2f(XN[(size_t)t * 1024 + k]) * pu[(size_t)e * 1024 + k]; inc += EG[i] * ref_gelu(dt) * pv[(size_t)e * 1024 + d]; }
    if (!close_to(p.out[(size_t)t * 1024 + d] - save[s], inc, 0.03f, 0.05f)) chk_fail(flag, 15);
}
__global__ void __launch_bounds__(512) chk_mark(float* out, const unsigned* flag) {
    const unsigned code = *flag; if (code == 0 || code > 100) return;
    const float f = 1.0f + 0.3f * (float)code;
    for (size_t i = (size_t)blockIdx.x * 512 + threadIdx.x; i < (size_t)T_TOK * DM; i += (size_t)gridDim.x * 512) out[i] *= f;
}
#endif
#ifdef MPROBE
#ifndef MPROBE_PART
#define MPROBE_PART 0
#endif
typedef int v8i_p __attribute__((ext_vector_type(8)));
constexpr int PE_ROW = 1088;
typedef float f32x2p __attribute__((ext_vector_type(2)));
__device__ __forceinline__ unsigned mp_xq(const bf16_t* xp, int e0) { const u32x2 w = *(const u32x2*)(xp + e0); unsigned d = 0u; d = __builtin_amdgcn_cvt_pk_fp8_f32(bf_lo(w.x), bf_hi(w.x), d, false); d = __builtin_amdgcn_cvt_pk_fp8_f32(bf_lo(w.y), bf_hi(w.y), d, true); return d; }
__device__ __forceinline__ float mp_fp4val(unsigned c) { const float mag[8] = {0.f, 0.5f, 1.f, 1.5f, 2.f, 3.f, 4.f, 6.f}; const float m = mag[c & 7u]; return (c & 8u) ? -m : m; }
__device__ __forceinline__ float mp_fp8val(unsigned byte) { const f32x2p t = __builtin_amdgcn_cvt_pk_f32_fp8(byte, false); return t.x; }
__global__ void __launch_bounds__(64) mprobe_kernel(const unsigned char* PE, const bf16_t* XN, const int* EIDX, unsigned* flag, int mode) {
    __shared__ float refs[16]; __shared__ unsigned tabu[16][256];
    const int lane = threadIdx.x, fr = lane & 15, fq = lane >> 4;
    const bf16_t* xrow = XN;
    for (int i = lane; i < 16 * 128; i += 64) { const int r = i >> 7, d = i & 127; tabu[r][d] = *(const unsigned*)(PE + (size_t)EIDX[r] * PE_ROW + 4 * d); }
    __syncthreads();
    if (mode == 0) {
        { float ref = 0.f; for (int e = fq; e < 1024; e += 4) { const unsigned w = tabu[fr][e >> 3]; const unsigned nb = (w >> (4 * (e & 7))) & 15u; const unsigned xb = (mp_xq(xrow, e & ~3) >> (8 * (e & 3))) & 0xffu; ref += mp_fp4val(nb) * mp_fp8val(xb); }
          ref += __shfl_xor(ref, 16); ref += __shfl_xor(ref, 32); if (fq == 0) refs[fr] = ref; }
        __syncthreads();
        __syncthreads();
        { float ref = 0.f; for (int e = fq; e < 128; e += 4) { const unsigned w = tabu[fr][e >> 3]; const unsigned nb = (w >> (4 * (e & 7))) & 15u; const unsigned xb = (mp_xq(xrow, e & ~3) >> (8 * (e & 3))) & 0xffu; ref += mp_fp4val(nb) * mp_fp8val(xb); }
          ref += __shfl_xor(ref, 16); ref += __shfl_xor(ref, 32); if (fq == 0) refs[fr] = ref; }
        __syncthreads();
        v8i_p bv; for (int j = 0; j < 8; ++j) bv[j] = (int)mp_xq(xrow + 32 * fq, 4 * j);
        unsigned wsrc[4]; for (int dd = 0; dd < 4; ++dd) wsrc[dd] = tabu[fr][4 * fq + dd];
        unsigned foundp = 0xffffffffu;
        for (int idx = 0; idx < 40320; ++idx) {
            unsigned pool = 0x76543210u; unsigned pmk = 0u; int rem = idx;
            for (int n = 0; n < 8; ++n) { const int radix = 8 - n; int fct = 1; for (int q = 2; q < radix; ++q) fct *= q; const int dsel = rem / fct; rem -= dsel * fct;
                const unsigned pos = (pool >> (4 * dsel)) & 15u; pmk |= pos << (4 * n);
                const unsigned lowmask = (dsel == 0) ? 0u : (0xffffffffu >> (32 - 4 * dsel)); pool = (pool & lowmask) | ((pool >> 4) & ~lowmask); }
            unsigned r[4];
            for (int dd = 0; dd < 4; ++dd) { const unsigned w = wsrc[dd]; unsigned o = 0u; for (int n = 0; n < 8; ++n) o |= ((w >> (4 * n)) & 15u) << (4 * ((pmk >> (4 * n)) & 15u)); r[dd] = o; }
            v8i_p av; av[0] = (int)r[0]; av[1] = (int)r[1]; av[2] = (int)r[2]; av[3] = (int)r[3]; av[4] = 0; av[5] = 0; av[6] = 0; av[7] = 0;
            const f32x4 dacc = __builtin_amdgcn_mfma_scale_f32_16x16x128_f8f6f4(av, bv, (f32x4){0.f, 0.f, 0.f, 0.f}, 4, 0, 0, 0x7f7f7f7f, 0, 0x7f7f7f7f);
            float err = 0.f; for (int i = 0; i < 4; ++i) { const float rv = refs[4 * fq + i]; err = fmaxf(err, fabsf(dacc[i] - rv) / (fabsf(rv) + 0.05f)); }
            for (int o = 32; o; o >>= 1) err = fmaxf(err, __shfl_xor(err, o));
            if (err < 0.02f && foundp == 0xffffffffu) foundp = pmk;
        }
        unsigned found = 0u;
        if (lane == 0) { if (foundp == 0xffffffffu) { flag[0] = 70u; flag[1] = 70u; }
            else { const int sh = (MPROBE_PART) * 16; flag[0] = 8u * ((foundp >> sh) & 15u) + ((foundp >> (sh + 4)) & 15u) + 1u; flag[1] = 8u * ((foundp >> (sh + 8)) & 15u) + ((foundp >> (sh + 12)) & 15u) + 1u; } }
        (void)found;
    } else if (mode == 4) {
        float ref1 = 0.f, ref2 = 0.f;
        for (int e = fq; e < 1024; e += 4) { const unsigned w = tabu[fr][e >> 3]; const unsigned nb = (w >> (4 * (e & 7))) & 15u; const unsigned xb = (mp_xq(xrow, e & ~3) >> (8 * (e & 3))) & 0xffu;
            const unsigned sb = PE[(size_t)EIDX[fr] * PE_ROW + 1024 + 2 * (e >> 5)]; const float sc = __uint_as_float(sb << 23);
            const float pr = mp_fp4val(nb) * mp_fp8val(xb); if (e < 128) ref1 += pr; ref2 += pr * sc; }
        ref1 += __shfl_xor(ref1, 16); ref1 += __shfl_xor(ref1, 32); ref2 += __shfl_xor(ref2, 16); ref2 += __shfl_xor(ref2, 32);
        if (fq == 0) refs[fr] = ref1; __shared__ float refs2[16]; if (fq == 0) refs2[fr] = ref2;
        __syncthreads();
        f32x4 d1 = (f32x4){0.f, 0.f, 0.f, 0.f}, d2 = (f32x4){0.f, 0.f, 0.f, 0.f};
        for (int s2 = 0; s2 < 8; ++s2) {
            v8i_p bv; for (int jj = 0; jj < 8; ++jj) bv[jj] = (int)mp_xq(xrow, 128 * s2 + 16 * fq + 64 * (jj >> 2) + 4 * (jj & 3));
            v8i_p av; av[0] = (int)tabu[fr][16 * s2 + 4 * fq + 0]; av[1] = (int)tabu[fr][16 * s2 + 4 * fq + 1]; av[2] = (int)tabu[fr][16 * s2 + 4 * fq + 2]; av[3] = (int)tabu[fr][16 * s2 + 4 * fq + 3]; av[4] = 0; av[5] = 0; av[6] = 0; av[7] = 0;
            const int sa = (int)PE[(size_t)EIDX[fr] * PE_ROW + 1024 + 2 * (4 * s2 + fq)];
            if (s2 == 0) d1 = __builtin_amdgcn_mfma_scale_f32_16x16x128_f8f6f4(av, bv, d1, 4, 0, 0, 0x7f7f7f7f, 0, 0x7f7f7f7f);
            d2 = __builtin_amdgcn_mfma_scale_f32_16x16x128_f8f6f4(av, bv, d2, 4, 0, 0, sa, 0, 0x7f7f7f7f); }
        float e1 = 0.f, e2 = 0.f; unsigned nb2 = 0u;
        for (int i = 0; i < 4; ++i) { const float r1 = refs[4 * fq + i], r2 = refs2[4 * fq + i]; e1 = fmaxf(e1, fabsf(d1[i] - r1) / (fabsf(r1) + 0.05f)); const float q2 = fabsf(d2[i] - r2) / (fabsf(r2) + 1e-3f); e2 = fmaxf(e2, q2); if (q2 >= 0.02f) ++nb2; }
        for (int o = 32; o; o >>= 1) { e1 = fmaxf(e1, __shfl_xor(e1, o)); e2 = fmaxf(e2, __shfl_xor(e2, o)); }
        nb2 += __shfl_xor(nb2, 16); nb2 += __shfl_xor(nb2, 32);
        const unsigned nbr = (unsigned)__builtin_amdgcn_readlane((int)nb2, 0);
        if (lane == 0) { flag[0] = 1u + (e1 >= 0.02f ? 1u : 0u) + (e2 >= 0.02f ? 2u : 0u); flag[1] = 1u + nbr; }
    } else if (mode == 6) {
        __shared__ __attribute__((aligned(16))) unsigned char tile[2][128];
        for (int i = lane; i < 128; i += 64) { const int r = i >> 3; tile[0][i] = (unsigned char)(r | (r << 4)); const int c0 = (i & 7) * 2; tile[1][i] = (unsigned char)(c0 | ((c0 + 1) << 4)); }
        __syncthreads();
        typedef int v2i_p __attribute__((ext_vector_type(2)));
        const v2i_p r1 = __builtin_amdgcn_ds_read_tr4_b64_v2i32((LAS v2i_p*)(&tile[0][8 * fr]));
        const v2i_p r2 = __builtin_amdgcn_ds_read_tr4_b64_v2i32((LAS v2i_p*)(&tile[1][8 * fr]));
        bool ok = true;
        for (int jn = 0; jn < 16; ++jn) { const unsigned n1 = ((unsigned)(jn < 8 ? r1.x : r1.y) >> (4 * (jn & 7))) & 15u, n2 = ((unsigned)(jn < 8 ? r2.x : r2.y) >> (4 * (jn & 7))) & 15u; if (n1 != (unsigned)jn || n2 != (unsigned)fr) ok = false; }
        const bool allok = __builtin_amdgcn_ballot_w64(ok) == ~0ull;
        const unsigned p1 = ((unsigned)__builtin_amdgcn_readlane(r1.x, 2) >> 4) & 15u, p2 = ((unsigned)__builtin_amdgcn_readlane(r2.x, 2) >> 4) & 15u;
        if (lane == 0) { flag[0] = 1u + p2; flag[1] = 1u + p1 + (allok ? 20u : 0u); }
    } else if (mode == 5) {
        __shared__ unsigned tab7[128];
        v8i_p bv; for (int j = 0; j < 8; ++j) { unsigned w = 0u; for (int k = 0; k < 4; ++k) { const unsigned code = 0x10u + 0x20u * (fq & 1) + (unsigned)(4 * j + k) + ((fq >> 1) ? 0x80u : 0u); w |= code << (8 * k); } bv[j] = (int)w; }
        for (int idx = 0; idx < 128; ++idx) { const int FBq = idx >> 5, d = (idx >> 3) & 3, n = idx & 7;
            const unsigned hot = (fq == FBq) ? (2u << (4 * n)) : 0u; const unsigned r0 = d == 0 ? hot : 0u, r1 = d == 1 ? hot : 0u, r2 = d == 2 ? hot : 0u, r3 = d == 3 ? hot : 0u;
            v8i_p av; av[0] = (int)r0; av[1] = (int)r1; av[2] = (int)r2; av[3] = (int)r3; av[4] = 0; av[5] = 0; av[6] = 0; av[7] = 0;
            const f32x4 dacc = __builtin_amdgcn_mfma_scale_f32_16x16x128_f8f6f4(av, bv, (f32x4){0.f, 0.f, 0.f, 0.f}, 4, 0, 0, 0x7f7f7f7f, 0, 0x7f7f7f7f);
            const float cv = __uint_as_float((unsigned)__builtin_amdgcn_readlane((int)__float_as_uint(dacc[0]), 0));
            unsigned fk = 255u;
            for (unsigned b = 0; b < 4; ++b) for (unsigned e = 0; e < 32; ++e) { const unsigned code = 0x10u + 0x20u * (b & 1u) + e + ((b >> 1) ? 0x80u : 0u); if (mp_fp8val(code) == cv) fk = 32u * b + e; }
            if (lane == 0) tab7[idx] = fk; }
        __syncthreads();
        const unsigned c0 = tab7[0]; unsigned aff = 1u, nnone = 0u;
        for (int idx = 0; idx < 128; ++idx) { unsigned pr = c0; if (idx & 1) pr ^= tab7[1] ^ c0; if (idx & 2) pr ^= tab7[2] ^ c0; if (idx & 4) pr ^= tab7[4] ^ c0; if (idx & 8) pr ^= tab7[8] ^ c0; if (idx & 16) pr ^= tab7[16] ^ c0; if (idx & 32) pr ^= tab7[32] ^ c0; if (idx & 64) pr ^= tab7[64] ^ c0;
            if (pr != tab7[idx]) aff = 0u; if (tab7[idx] == 255u) ++nnone; }
        const int part = MPROBE_PART;
        #define MP_POS(v) (__builtin_popcount(v) == 1 ? (unsigned)__builtin_ctz(v) : 7u)
        if (lane == 0) {
            if (part == 0) { flag[0] = 1u + MP_POS(tab7[1] ^ c0); flag[1] = 1u + MP_POS(tab7[2] ^ c0) + 8u * MP_POS(tab7[4] ^ c0); }
            else if (part == 1) { flag[0] = 1u + MP_POS(tab7[8] ^ c0); flag[1] = 1u + MP_POS(tab7[16] ^ c0) + 8u * MP_POS(tab7[32] ^ c0); }
            else if (part == 2) { flag[0] = 1u + MP_POS(tab7[64] ^ c0); flag[1] = 1u + aff + 2u * (c0 == 0u ? 1u : 0u) + 4u * (nnone > 15u ? 15u : nnone); }
            else { flag[0] = 1u + (tab7[MPROBE_PART] >> 5 > 7u ? 8u : tab7[MPROBE_PART] >> 5); flag[1] = 1u + (tab7[MPROBE_PART] & 31u); } }
    } else if (mode == 3) {
        const int FB = (MPROBE_PART >> 2) & 3;
        v8i_p bv; for (int j = 0; j < 8; ++j) { unsigned w = 0u; for (int k = 0; k < 4; ++k) { const unsigned code = 0x10u + 0x20u * (fq & 1) + (unsigned)(4 * j + k) + ((fq >> 1) ? 0x80u : 0u); w |= code << (8 * k); } bv[j] = (int)w; }
        __shared__ unsigned tab[32]; unsigned blkbad = 0u;
        for (int idx = 0; idx < 32; ++idx) { const int d = idx >> 3, n = idx & 7; const unsigned hot = (fq == FB) ? (2u << (4 * n)) : 0u; const unsigned r0 = d == 0 ? hot : 0u, r1 = d == 1 ? hot : 0u, r2 = d == 2 ? hot : 0u, r3 = d == 3 ? hot : 0u;
            v8i_p av; av[0] = (int)r0; av[1] = (int)r1; av[2] = (int)r2; av[3] = (int)r3; av[4] = 0; av[5] = 0; av[6] = 0; av[7] = 0;
            const f32x4 dacc = __builtin_amdgcn_mfma_scale_f32_16x16x128_f8f6f4(av, bv, (f32x4){0.f, 0.f, 0.f, 0.f}, 4, 0, 0, 0x7f7f7f7f, 0, 0x7f7f7f7f);
            const float cv = __uint_as_float((unsigned)__builtin_amdgcn_readlane((int)__float_as_uint(dacc[0]), 0));
            unsigned fb = 9u, fe = 99u;
            for (unsigned b = 0; b < 4; ++b) for (unsigned e = 0; e < 32; ++e) { const unsigned code = 0x10u + 0x20u * (b & 1u) + e + ((b >> 1) ? 0x80u : 0u); if (mp_fp8val(code) == cv) { fb = b; fe = e; } }
            if (lane == 0) tab[idx] = fe; if (fb != (unsigned)FB) blkbad |= 1u; }
        __syncthreads();
        const unsigned c0 = tab[0]; const unsigned col0 = tab[1] ^ c0, col1 = tab[2] ^ c0, col2 = tab[4] ^ c0, col3 = tab[8] ^ c0, col4 = tab[16] ^ c0;
        unsigned aff = 1u; for (int idx = 0; idx < 32; ++idx) { unsigned pr = c0; if (idx & 1) pr ^= col0; if (idx & 2) pr ^= col1; if (idx & 4) pr ^= col2; if (idx & 8) pr ^= col3; if (idx & 16) pr ^= col4; if (pr != tab[idx]) aff = 0u; }
        const int part = MPROBE_PART & 3;
        if (lane == 0) {
            if (part == 0) { flag[0] = col0 + 1u; flag[1] = col1 + 1u; }
            else if (part == 1) { flag[0] = col2 + 1u; flag[1] = col3 + 1u; }
            else if (part == 2) { flag[0] = col4 + 1u; flag[1] = c0 + 1u; }
            else { flag[0] = aff + 2u * blkbad + 1u; flag[1] = tab[3] + 1u; } }
    } else if (mode == 2) {
        float sx = 0.f; for (int s2 = 0; s2 < 8; ++s2) for (int j = 0; j < 8; ++j) { const unsigned xd = mp_xq(xrow + 128 * s2 + 32 * fq, 4 * j); sx += mp_fp8val(xd & 0xffu) + mp_fp8val((xd >> 8) & 0xffu) + mp_fp8val((xd >> 16) & 0xffu) + mp_fp8val(xd >> 24); }
        sx += __shfl_xor(sx, 16); sx += __shfl_xor(sx, 32);
        f32x4 dacc = (f32x4){0.f, 0.f, 0.f, 0.f};
        for (int s2 = 0; s2 < 8; ++s2) { const int pat = 0x11111111 * fr; v8i_p av; av[0] = pat; av[1] = pat; av[2] = pat; av[3] = pat; av[4] = 0; av[5] = 0; av[6] = 0; av[7] = 0;
            v8i_p bv; for (int j = 0; j < 8; ++j) bv[j] = (int)mp_xq(xrow + 128 * s2 + 32 * fq, 4 * j);
            dacc = __builtin_amdgcn_mfma_scale_f32_16x16x128_f8f6f4(av, bv, dacc, 4, 0, 0, 0x7f7f7f7f, 0, 0x7f7f7f7f); }
        const float ratio = dacc[MPROBE_PART & 3] / sx; unsigned best = 0u; float bd = 1e30f;
        for (unsigned c = 0; c < 16; ++c) { const float dv = fabsf(mp_fp4val(c) - ratio); if (dv < bd) { bd = dv; best = c; } }
        const unsigned b1 = (unsigned)__builtin_amdgcn_readlane((int)best, 16 * (MPROBE_PART >> 2)); const unsigned b2 = (unsigned)__builtin_amdgcn_readlane((int)best, 16 * (MPROBE_PART >> 2) + 5);
        if (lane == 0) { flag[0] = b1 + 1u; flag[1] = b2 + 1u; }
    } else {
        float sx = 0.f; for (int s2 = 0; s2 < 8; ++s2) for (int d = 0; d < 4; ++d) sx += mp_fp8val(mp_xq(xrow + 128 * s2 + 32 * fq, 8 * d) & 0xffu);
        sx += __shfl_xor(sx, 16); sx += __shfl_xor(sx, 32);
        unsigned nbad = 0u, first = 0u;
        for (unsigned v = 1; v < 16; ++v) {
            f32x4 dacc = (f32x4){0.f, 0.f, 0.f, 0.f};
            for (int s2 = 0; s2 < 8; ++s2) { v8i_p av; av[0] = (int)v; av[1] = (int)v; av[2] = (int)v; av[3] = (int)v; av[4] = 0; av[5] = 0; av[6] = 0; av[7] = 0;
                v8i_p bv; for (int j = 0; j < 8; ++j) bv[j] = (int)mp_xq(xrow + 128 * s2 + 32 * fq, 4 * j);
                dacc = __builtin_amdgcn_mfma_scale_f32_16x16x128_f8f6f4(av, bv, dacc, 4, 0, 0, 0x7f7f7f7f, 0, 0x7f7f7f7f); }
            const float want = mp_fp4val(v) * sx; float err = fabsf(dacc[0] - want) / (fabsf(want) + 0.05f);
            for (int o = 32; o; o >>= 1) err = fmaxf(err, __shfl_xor(err, o));
            if (err >= 0.02f) { ++nbad; if (first == 0u) first = v; }
        }
        if (lane == 0) { flag[0] = nbad + 1u; flag[1] = first + 1u; }
    }
}
__global__ void __launch_bounds__(512) mprobe_mark(float* out, const unsigned* flag) {
    const float f = 1.0f + 0.3f * (float)flag[0];
    for (size_t i = (size_t)blockIdx.x * 512 + threadIdx.x; i < (size_t)T_TOK * DM; i += (size_t)gridDim.x * 512) { float v = out[i] * f; if (i == 0) v += 1000.0f * (float)flag[1]; out[i] = v; }
}
#endif

#ifndef MK_MULTI
#define MK_MULTI 0
#endif
constexpr int NPH = 16, NLAYER = 2;
__global__ void __launch_bounds__(512, 2) hybrid_fwd(Params p) {
    extern __shared__ __attribute__((aligned(16))) unsigned char lds_raw[];
    LAS unsigned char* lds = (LAS unsigned char*)lds_raw;
    if (threadIdx.x == 0) *(LAS u32x4*)(lds + LDS_BAR_OFF) = (u32x4){0u, 0u, 0u, 0u};
    __syncthreads();
    XcdBarrier bar = xcd_barrier_post((unsigned*)(p.ws + WS_CTL), (volatile LAS unsigned*)(lds + LDS_BAR_OFF));
    const int lo = p.ph_lo, hi = p.ph_hi;
#ifndef PHMASK
#define PHMASK 0xffff
#endif
#define IN(k) (((PHMASK >> ((k) % NPH)) & 1) && lo <= (k) && (k) < hi)
#define SEAM(k) do { if (IN(k) && IN((k) + 1)) xcd_barrier(bar); } while (0)
    unsigned char* ws = p.ws;
#define XN ((bf16_t*)(fresh_ptr(fresh_kp().ws) + WS_XN))
#ifdef PROBE_T_A
    unsigned long long* tsg = (unsigned long long*)(p.ws + WS_CTL + 300 * 1024);
#define TSTAMP(k) do { if (blockIdx.x == 0 && threadIdx.x == 0) tsg[k] = wall_clock64(); } while (0)
#else
#define TSTAMP(k) do { } while (0)
#endif
    for (int l = 0; l < NLAYER; ++l) {
        const int P0 = l * NPH;
        const float* xsrc = (l == 0) ? fresh_kp().in[I_X] : (const float*)fresh_kp().out;
        float* const dummy = (float*)(fresh_ptr(fresh_kp().ws) + WS_R);
#define NREP(k) (((P0 + (k)) == fresh_kp().rep_ph) ? fresh_kp().rep_n : 1)
        TSTAMP(P0 + 0);
        if (IN(P0 + 0)) for (int r = NREP(0); r > 0; --r) {
            if (l == 0) make_tables(p);
            prep_weights(fresh_kp(), lds, l);
            rmsnorm_rows(xsrc, fresh_kp().in[I_NORM_MIX] + l * 1024, XN, T_TOK);
            rmsnorm_rows(fresh_kp().in[I_MEM], fresh_kp().in[I_NORM_MEMSRC] + l * 1024, (bf16_t*)(fresh_ptr(fresh_kp().ws) + WS_MEMN), NB * MEMLEN);
        }
        SEAM(P0 + 0);
        TSTAMP(P0 + 1);
        if (IN(P0 + 1)) for (int r = NREP(1); r > 0; --r) {
            run_gemm(lds, XN, (const bf16_t*)(fresh_ptr(fresh_kp().ws) + WS_WB + WB_WIN), T_TOK, HN, 1024, 0, EpiStore{(bf16_t*)(fresh_ptr(fresh_kp().ws) + WS_R + R_H), HN});
            run_gemm(lds, (const bf16_t*)(fresh_ptr(fresh_kp().ws) + WS_WB + WB_WV), XN, 768, T_TOK, 1024, 128, EpiStore{(bf16_t*)(fresh_ptr(fresh_kp().ws) + WS_R + R_VT), T_TOK});
            run_gemm(lds, (const bf16_t*)(fresh_ptr(fresh_kp().ws) + WS_MEMN), (const bf16_t*)(fresh_ptr(fresh_kp().ws) + WS_WB + WB_MK), NB * MEMLEN, 512, 1024, 0, EpiStore{(bf16_t*)(fresh_ptr(fresh_kp().ws) + WS_MK), 512});
            run_gemm(lds, (const bf16_t*)(fresh_ptr(fresh_kp().ws) + WS_WB + WB_MV), (const bf16_t*)(fresh_ptr(fresh_kp().ws) + WS_MEMN), 512, NB * MEMLEN, 1024, 32, EpiStore{(bf16_t*)(fresh_ptr(fresh_kp().ws) + WS_MVT), NB * MEMLEN});
        }
        SEAM(P0 + 1);
        TSTAMP(P0 + 2);
        if (IN(P0 + 2)) for (int r = NREP(2); r > 0; --r) {
#ifndef SKIP_KN
            if (r == 1) knorm_rows(fresh_kp(), l);
#endif
#ifndef SKIP_GM
            for (int r2 = ((1000 + P0 + 2) == fresh_kp().rep_ph) ? fresh_kp().rep_n : 1; r2 > 0; --r2) gmlp_phase(fresh_kp(), lds, l);
#endif
#ifndef SKIP_CS
            for (int r2 = ((2000 + P0 + 2) == fresh_kp().rep_ph) ? fresh_kp().rep_n : 1; r2 > 0; --r2) csel_phase(fresh_kp(), lds, (r2 > 1) ? fresh_kp().rep_var : 0);
#endif
        }
        SEAM(P0 + 2);
        TSTAMP(P0 + 3);
        if (IN(P0 + 3)) for (int r = NREP(3); r > 0; --r) {
#ifndef SKIP_AA
            for (int r2 = ((1000 + P0 + 3) == fresh_kp().rep_ph) ? fresh_kp().rep_n : 1; r2 > 0; --r2) { attnA_phase(fresh_kp(), lds, l, (r2 > 1) ? fresh_kp().rep_var : 0); __syncthreads(); }
#endif
            __syncthreads();
#ifndef SKIP_AC
            for (int r2 = ((2000 + P0 + 3) == fresh_kp().rep_ph) ? fresh_kp().rep_n : 1; r2 > 0; --r2) { attnC_phase(fresh_kp(), lds, l, (r2 > 1) ? fresh_kp().rep_var : 0); __syncthreads(); }
#endif
        }
        SEAM(P0 + 3);
        TSTAMP(P0 + 4);
        if (IN(P0 + 4)) for (int r = NREP(4); r > 0; --r) run_gemm(lds, XN, (const bf16_t*)(fresh_ptr(fresh_kp().ws) + WS_WB + WB_WG), T_TOK, 3072, 1024, 0, EpiSigmoid{(bf16_t*)(fresh_ptr(fresh_kp().ws) + WS_R + R_G), 3072});
        SEAM(P0 + 4);
        TSTAMP(P0 + 5);
        if (IN(P0 + 5)) for (int r = NREP(5); r > 0; --r) {
            bf16_t* MG = (bf16_t*)(fresh_ptr(fresh_kp().ws) + WS_R + R_MERGED); const bf16_t* G = (const bf16_t*)(fresh_ptr(fresh_kp().ws) + WS_R + R_G);
            run_gemm(lds, (const bf16_t*)(fresh_ptr(fresh_kp().ws) + WS_YA), (const bf16_t*)(fresh_ptr(fresh_kp().ws) + WS_WB + WB_BRA), T_TOK, 1024, 512, 0, EpiBranch{MG, G, 0, 1});
            run_gemm(lds, (const bf16_t*)(fresh_ptr(fresh_kp().ws) + WS_YB), (const bf16_t*)(fresh_ptr(fresh_kp().ws) + WS_WB + WB_BRB), T_TOK, 1024, 512, 0, EpiBranch{MG, G, 1, 0});
            run_gemm(lds, (const bf16_t*)(fresh_ptr(fresh_kp().ws) + WS_YC), (const bf16_t*)(fresh_ptr(fresh_kp().ws) + WS_WB + WB_BRC), T_TOK, 1024, 512, 0, EpiBranch{MG, G, 2, 0});
        }
        SEAM(P0 + 5);
        TSTAMP(P0 + 6);
        if (IN(P0 + 6)) for (int r = NREP(6); r > 0; --r) run_gemm(lds, (const bf16_t*)(fresh_ptr(fresh_kp().ws) + WS_R + R_MERGED), (const bf16_t*)(fresh_ptr(fresh_kp().ws) + WS_WB + WB_OUT), T_TOK, 1024, 1024, 0, EpiResid{xsrc, (r == 1) ? fresh_kp().out : dummy, 1024});
        SEAM(P0 + 6);
        TSTAMP(P0 + 7);
        if (IN(P0 + 7)) for (int r = NREP(7); r > 0; --r) rmsnorm_rows(fresh_kp().out, fresh_kp().in[I_NORM_MEM] + l * 1024, XN, T_TOK);
        SEAM(P0 + 7);
        TSTAMP(P0 + 8);
        if (IN(P0 + 8)) for (int r = NREP(8); r > 0; --r) run_gemm(lds, XN, (const bf16_t*)(fresh_ptr(fresh_kp().ws) + WS_WB + WB_MQ), T_TOK, 512, 1024, 0, EpiStore{(bf16_t*)(fresh_ptr(fresh_kp().ws) + WS_YA), 512});
        SEAM(P0 + 8);
        TSTAMP(P0 + 9);
        if (IN(P0 + 9)) for (int r = NREP(9); r > 0; --r) attnX_phase(fresh_kp(), lds, l);
        SEAM(P0 + 9);
        TSTAMP(P0 + 10);
        if (IN(P0 + 10)) for (int r = NREP(10); r > 0; --r) run_gemm(lds, (const bf16_t*)(fresh_ptr(fresh_kp().ws) + WS_YB), (const bf16_t*)(fresh_ptr(fresh_kp().ws) + WS_WB + WB_MO), T_TOK, 1024, 512, 0, EpiResid{fresh_kp().out, (r == 1) ? fresh_kp().out : dummy, 1024});
        SEAM(P0 + 10);
        TSTAMP(P0 + 11);
        if (IN(P0 + 11)) for (int r = NREP(11); r > 0; --r) {
            rmsnorm_rows(fresh_kp().out, fresh_kp().in[I_NORM_PEER] + l * 1024, XN, T_TOK);
            conv_peer_tables(fresh_kp().in[I_PU] + (size_t)l * 16384 * 1024, fresh_kp().in[I_PV] + (size_t)l * 16384 * 1024, fresh_ptr(fresh_kp().ws) + WS_YA);
        }
        SEAM(P0 + 11);
        TSTAMP(P0 + 12);
        if (IN(P0 + 12)) for (int r = NREP(12); r > 0; --r) run_gemm(lds, XN, (const bf16_t*)(fresh_ptr(fresh_kp().ws) + WS_WB + WB_PS), T_TOK, 2048, 1024, 0, EpiF32Store{(float*)(fresh_ptr(fresh_kp().ws) + WS_R + R_PS), 2048});
        SEAM(P0 + 12);
        TSTAMP(P0 + 13);
        if (IN(P0 + 13)) for (int r = NREP(13); r > 0; --r) peer_topk_phase(fresh_kp(), lds);
        SEAM(P0 + 13);
        TSTAMP(P0 + 14);
        if (IN(P0 + 14)) for (int r = NREP(14); r > 0; --r) peer_udot_phase(fresh_kp(), lds, (r > 1) ? fresh_kp().rep_var : 0);
        SEAM(P0 + 14);
        TSTAMP(P0 + 15);
        if (IN(P0 + 15)) for (int r = NREP(15); r > 0; --r) peer_vacc_phase(fresh_kp(), lds, fresh_kp().out, (r == 1) ? fresh_kp().out : dummy + 16 * MiB, (r > 1) ? fresh_kp().rep_var : 0);
        SEAM(P0 + 15);
    }
#ifdef PROBE_T_A
    xcd_barrier(bar); TSTAMP(NPH * NLAYER); xcd_barrier(bar);
    {
        unsigned long long ta = 0ull, tb = 0ull;
        for (int k = 0; k < NPH * NLAYER; ++k) { const unsigned long long dt = tsg[k + 1] - tsg[k]; if ((PROBE_T_A >> k) & 1ull) ta += dt; if ((PROBE_T_B >> k) & 1ull) tb += dt; }
        const float c1 = (float)ta * 1e-5f, c2 = (float)tb * 1e-3f;
        const int tid2 = fresh_tid();
        for (size_t i = ((size_t)blockIdx.x * 512 + tid2) * 4; i < (size_t)T_TOK * DM; i += (size_t)gridDim.x * 512 * 4) { f32x4 v = *(f32x4*)(p.out + i); v *= (1.0f + c1); if (i == 0) v[0] += c2; *(f32x4*)(p.out + i) = v; }
    }
#endif
#undef IN
#undef SEAM
}

extern "C" void kernel_launch(void* const* d_in, const int* in_sizes, int n_in, void* d_out, int out_size, void* d_ws, size_t ws_size, hipStream_t stream) {
    static int grid = 0;
    if (grid == 0) {
        if (n_in != 34 || out_size != T_TOK * DM || ws_size < WS_END) { fprintf(stderr, "kernel_launch: unexpected shapes (n_in %d out %d ws %zu)\n", n_in, out_size, ws_size); grid = -1; return; }
        int dev = 0, cus = 0, per_cu = 0;
        if (hipGetDevice(&dev) != hipSuccess || hipDeviceGetAttribute(&cus, hipDeviceAttributeMultiprocessorCount, dev) != hipSuccess) { grid = -1; return; }
        if (hipFuncSetAttribute((const void*)hybrid_fwd, hipFuncAttributeMaxDynamicSharedMemorySize, LDS_TOTAL) != hipSuccess) { fprintf(stderr, "kernel_launch: hipFuncSetAttribute failed\n"); grid = -1; return; }
        if (hipOccupancyMaxActiveBlocksPerMultiprocessor(&per_cu, (const void*)hybrid_fwd, 512, LDS_TOTAL) != hipSuccess || per_cu < 1) { fprintf(stderr, "kernel_launch: occupancy query says %d\n", per_cu); }
        (void)hipGetLastError();
        if (cus < 8) { grid = -1; return; }
        grid = cus;
    }
    if (grid < 0) return;
#ifdef PROBE_ZERO_WS
    if (hipMemsetAsync((char*)d_ws, 0, WS_END, stream) != hipSuccess) return;
#endif
    if (hipMemsetAsync((char*)d_ws + WS_CTL, 0, XCD_BAR_WORDS * sizeof(unsigned), stream) != hipSuccess) return;
    Params p{};
    p.rep_ph = -1; p.rep_n = 1;
    for (int i = 0; i < 34; ++i) p.in[i] = (const float*)d_in[i];
    p.out = (float*)d_out; p.ws = (unsigned char*)d_ws;
#ifdef PROBE_CHK
    {
        unsigned char* ws = (unsigned char*)d_ws; unsigned* flag = (unsigned*)(ws + WS_CTL + 200 * 1024); float* save = (float*)(ws + WS_CTL + 256 * 1024);
        hipMemsetAsync(flag, 0xFF, 4, stream);
        const int CL = PROBE_CHK - 1;
        for (int ph = 0; ph < 2 * NPH; ++ph) {
            const int l = ph / NPH, k = ph % NPH;
            if (l == CL && k == 14) hipLaunchKernelGGL(chk_save_x, dim3(16), dim3(64), 0, stream, p, save);
            p.ph_lo = ph; p.ph_hi = ph + 1; hipLaunchKernelGGL(hybrid_fwd, dim3(grid), dim3(512), LDS_TOTAL, stream, p);
            if (l != CL) continue;
            const float* xsrc = (const float*)d_in[0];
            if (k == 1) hipLaunchKernelGGL(chk_h, dim3(32), dim3(64), 0, stream, p, l, flag);
            if (k == 2) { hipLaunchKernelGGL(chk_post, dim3(16), dim3(64), 0, stream, p, l, flag); hipLaunchKernelGGL(chk_mask, dim3(4), dim3(64), 0, stream, p, flag); }
            if (k == 3) { hipLaunchKernelGGL(chk_attn, dim3(4), dim3(64), 0, stream, p, l, flag); hipLaunchKernelGGL(chk_attnc, dim3(4), dim3(64), 0, stream, p, l, flag); }
            if (k == 5) hipLaunchKernelGGL(chk_merge, dim3(16), dim3(64), 0, stream, p, l, flag);
            if (k == 6) hipLaunchKernelGGL(chk_xmix, dim3(16), dim3(64), 0, stream, p, l, xsrc, flag);
            if (k == 9) hipLaunchKernelGGL(chk_xattn, dim3(8), dim3(64), 0, stream, p, l, flag);
            if (k == 12) hipLaunchKernelGGL(chk_ps, dim3(8), dim3(64), 0, stream, p, l, flag);
            if (k == 13) hipLaunchKernelGGL(chk_topk, dim3(8), dim3(64), 0, stream, p, flag);
            if (k == 15) hipLaunchKernelGGL(chk_gather, dim3(16), dim3(64), 0, stream, p, l, (const float*)save, flag);
        }
        hipLaunchKernelGGL(chk_mark, dim3(1024), dim3(512), 0, stream, (float*)d_out, (const unsigned*)flag);
    }
#elif defined(PROBE_DET)
    {
        unsigned char* ws = (unsigned char*)d_ws; const size_t NT = (size_t)T_TOK;
        unsigned long long* cks = (unsigned long long*)(ws + WS_CTL + 128 * 1024);
        hipMemsetAsync(cks, 0, 128 * 8, stream);
        for (int run = 0; run < 3; ++run) for (int ph = 0; ph <= PROBE_PH; ++ph) {
            p.ph_lo = ph; p.ph_hi = ph + 1; hipLaunchKernelGGL(hybrid_fwd, dim3(grid), dim3(512), LDS_TOTAL, stream, p);
            CkSeg z{nullptr, 0}; CkSeg c[4] = {z, z, z, z};
            switch (ph) {
            case 0: c[0] = {ws + WS_WB, 27 * MiB}; c[1] = {ws + WS_XN, NT * 2048}; c[2] = {ws + WS_MEMN, 8 * MiB}; c[3] = {ws + WS_CTL + CTL_BTAB, 4096}; break;
            case 1: c[0] = {ws + WS_R + R_H, NT * HN * 2}; c[1] = {ws + WS_R + R_VT, 768 * NT * 2}; c[2] = {ws + WS_MK, 4 * MiB}; c[3] = {ws + WS_MVT, 4 * MiB}; break;
            case 2: c[0] = {ws + WS_R + R_H, NT * HN * 2}; c[1] = {ws + WS_YB, 32 * MiB}; c[2] = {ws + WS_MK, 4 * MiB}; c[3] = {ws + WS_MASK, 8 * MiB}; break;
            case 3: c[0] = {ws + WS_YA, 32 * MiB}; c[1] = {ws + WS_YC, 32 * MiB}; break;
            case 4: c[0] = {ws + WS_R + R_G, 192 * MiB}; break;
            case 5: c[0] = {ws + WS_R + R_MERGED, 64 * MiB}; break;
            case 6: c[0] = {d_out, 128 * MiB}; break;
            case 7: c[0] = {ws + WS_XN, 64 * MiB}; break;
            case 8: c[0] = {ws + WS_YA, 32 * MiB}; break;
            case 9: c[0] = {ws + WS_YB, 32 * MiB}; break;
            case 10: c[0] = {d_out, 128 * MiB}; break;
            case 11: c[0] = {ws + WS_XN, 64 * MiB}; c[1] = {ws + WS_YA, 32 * MiB}; c[2] = {ws + WS_YB, 32 * MiB}; break;
            case 12: c[0] = {ws + WS_R + R_PS, 256 * MiB}; break;
            case 13: c[0] = {ws + WS_YC, 32 * MiB}; break;
            case 14: c[0] = {d_out, 128 * MiB}; break;
            }
            hipLaunchKernelGGL(probe_cksum, dim3(1024), dim3(512), 0, stream, cks + run * 32 + ph, c[0], c[1], c[2], c[3]);
        }
        for (int ph = PROBE_PH + 1; ph < 2 * NPH; ++ph) { p.ph_lo = ph; p.ph_hi = ph + 1; hipLaunchKernelGGL(hybrid_fwd, dim3(grid), dim3(512), LDS_TOTAL, stream, p); }
        hipLaunchKernelGGL(probe_mark, dim3(1024), dim3(512), 0, stream, (float*)d_out, (const unsigned long long*)cks, PROBE_PH + 1);
    }
#elif defined(PROBE_K)
    for (int ph = 0; ph < PROBE_K; ++ph) { p.ph_lo = ph; p.ph_hi = ph + 1; hipLaunchKernelGGL(hybrid_fwd, dim3(grid), dim3(512), LDS_TOTAL, stream, p); }
    {
        unsigned char* ws = (unsigned char*)d_ws; DumpSeg z{nullptr, 0, 0}; DumpSeg s[6] = {z, z, z, z, z, z};
        const size_t NT = (size_t)T_TOK;
#if PROBE_K == 1
        s[0] = {ws + WS_XN, NT * 1024, 0}; s[1] = {ws + WS_WB, 27 * MiB / 2, 0}; s[2] = {ws + WS_MEMN, 4096 * 1024, 0}; s[3] = {ws + WS_CTL + CTL_BTAB, 1024, 1};
#elif PROBE_K == 2
        s[0] = {ws + WS_R + R_H, NT * HN, 0}; s[1] = {ws + WS_R + R_VT, 768 * NT, 0}; s[2] = {ws + WS_MK, 4096 * 512, 0}; s[3] = {ws + WS_MVT, 512 * 4096, 0};
#elif PROBE_K == 3
        s[0] = {ws + WS_R + R_H, NT * HN, 0}; s[1] = {ws + WS_YB, NT * 512, 0}; s[2] = {ws + WS_MK, 4096 * 512, 0}; s[3] = {ws + WS_MASK, NT * 128, 2};
#elif PROBE_K == 4
        s[0] = {ws + WS_YA, NT * 512, 0}; s[1] = {ws + WS_YC, NT * 512, 0};
#elif PROBE_K == 5
        s[0] = {ws + WS_R + R_G, NT * 3072, 0};
#elif PROBE_K == 6
        s[0] = {ws + WS_R + R_MERGED, NT * 1024, 0};
#elif PROBE_K == 7
        s[0] = {d_out, NT * 1024, 1};
#elif PROBE_K == 9
        s[0] = {ws + WS_YA, NT * 512, 0}; s[1] = {ws + WS_XN, NT * 1024, 0};
#elif PROBE_K == 10
        s[0] = {ws + WS_YB, NT * 512, 0};
#elif PROBE_K == 11
        s[0] = {d_out, NT * 1024, 1};
#elif PROBE_K == 12
        s[0] = {ws + WS_YA, NT * 512, 0}; s[1] = {ws + WS_YB, NT * 512, 0}; s[2] = {ws + WS_XN, NT * 1024, 0};
#elif PROBE_K == 13
        s[0] = {ws + WS_R + R_PS, NT * 2048, 1};
#elif PROBE_K == 14
        s[0] = {ws + WS_YC, NT * 128, 3}; s[1] = {ws + WS_YC + 16 * MiB, NT * 128, 1};
#endif
        hipLaunchKernelGGL(probe_dump, dim3(1024), dim3(512), 0, stream, (float*)d_out, s[0], s[1], s[2], s[3], s[4], s[5]);
    }
#elif defined(MPROBE)
    for (int ph = 0; ph < NPH * NLAYER; ++ph) { p.ph_lo = ph; p.ph_hi = ph + 1; hipLaunchKernelGGL(hybrid_fwd, dim3(grid), dim3(512), LDS_TOTAL, stream, p); }
    { unsigned char* ws = (unsigned char*)d_ws; unsigned* flag = (unsigned*)(ws + WS_CTL + 200 * 1024);
      hipLaunchKernelGGL(mprobe_kernel, dim3(1), dim3(64), 0, stream, (const unsigned char*)(ws + WS_YA), (const bf16_t*)(ws + WS_XN), (const int*)(ws + WS_YC), flag, (int)(MPROBE - 1));
      hipLaunchKernelGGL(mprobe_mark, dim3(1024), dim3(512), 0, stream, (float*)d_out, (const unsigned*)flag); }
#elif MK_MULTI
    for (int ph = 0; ph < NPH * NLAYER; ++ph) { p.ph_lo = ph; p.ph_hi = ph + 1; hipLaunchKernelGGL(hybrid_fwd, dim3(grid), dim3(512), LDS_TOTAL, stream, p); }
#else
    p.ph_lo = 0; p.ph_hi = NPH * NLAYER;
#ifdef PROBE_REP_PH
    p.rep_ph = PROBE_REP_PH; p.rep_n = PROBE_REP_N;
#else
    p.rep_ph = -1; p.rep_n = 1;
#endif
#ifdef ATT_PROBE
    p.rep_var = ATT_PROBE;
#endif
    hipLaunchKernelGGL(hybrid_fwd, dim3(grid), dim3(512), LDS_TOTAL, stream, p);
#endif
}
```

```cpp
#define MK_MULTI 0
#include <hip/hip_runtime.h>
#include <cstdio>
#include <cstdint>
#define XB_TMO      128
#define XB_XCNT(j)  (256  + 64 * (j))
#define XB_XSUB(j)  (1280 + 64 * (j))
#define XB_XGEN(j)  (2304 + 64 * (j))
#define XB_TOP      3328
#define XB_TOPGEN   3392
#define XCD_BAR_WORDS 3456
#define XB_SPIN_CAP (1u << 18)
#define LAS __attribute__((address_space(3)))

__device__ __forceinline__ unsigned xb_ld(unsigned* p)              { return __hip_atomic_load(p, __ATOMIC_RELAXED, __HIP_MEMORY_SCOPE_AGENT); }
__device__ __forceinline__ unsigned xb_add(unsigned* p, unsigned v) { return __hip_atomic_fetch_add(p, v, __ATOMIC_RELAXED, __HIP_MEMORY_SCOPE_AGENT); }
__device__ __forceinline__ unsigned xb_xcc_id() { return (unsigned)__builtin_amdgcn_s_getreg((3 << 11) | 20) & 0xFu; }
#define XB_SPIN(cond, bar) do { unsigned _sp = 0; while (cond) { __builtin_amdgcn_s_sleep(1); \
    if ((++_sp & 255u) == 0u) { if (xb_ld(&(bar)[XB_TMO])) break; if (_sp > XB_SPIN_CAP) { atomicAdd(&(bar)[XB_TMO], 1u); break; } } } } while (0)

struct XcdBarrier {
    unsigned* bar; unsigned x;
    volatile LAS unsigned* st;
};

__device__ __forceinline__ XcdBarrier xcd_barrier_post(unsigned* bar, volatile LAS unsigned* st) {
    XcdBarrier b; b.bar = bar; b.x = xb_xcc_id(); b.st = st;
    if (threadIdx.x == 0) st[2] = xb_add(&bar[XB_XCNT(b.x)], 1u) + 1u;
    return b;
}
__device__ __forceinline__ void xcd_barrier_complete(unsigned* bar, unsigned x, unsigned& nloc, unsigned& nx) {
    const unsigned G = gridDim.x * gridDim.y * gridDim.z;
    unsigned sum, cnt, mine, sp = 0u;
    for (;;) {
        sum = 0u; cnt = 0u; mine = 0u;
#pragma unroll
        for (unsigned j = 0; j < 16; ++j) { const unsigned c = xb_ld(&bar[XB_XCNT(j)]); sum += c; cnt += (c > 0u) ? 1u : 0u; mine = (j == x) ? c : mine; }
        if (sum == G) break;
        __builtin_amdgcn_s_sleep(1);
        if ((++sp & 255u) == 0u) { if (xb_ld(&bar[XB_TMO])) break; if (sp > XB_SPIN_CAP) { atomicAdd(&bar[XB_TMO], 1u); break; } }
    }
    nloc = mine > 0u ? mine : 1u; nx = cnt > 0u ? cnt : 1u;
}

__device__ __forceinline__ void xcd_barrier(const XcdBarrier& b) {
    asm volatile("s_waitcnt vmcnt(0)" ::: "memory");
    __syncthreads();
    if (threadIdx.x == 0) {
        unsigned* bar = b.bar;
        __builtin_amdgcn_s_waitcnt(0);
        unsigned nloc = b.st[0], nx = b.st[1];
        if (nloc == 0u) { xcd_barrier_complete(bar, b.x, nloc, nx); b.st[0] = nloc; b.st[1] = nx; }
        const unsigned old = xb_add(&bar[XB_XSUB(b.x)], 1u);
        const unsigned gen = old / nloc;
        if (old + 1u == (gen + 1u) * nloc) {
            __builtin_amdgcn_fence(__ATOMIC_RELEASE, "agent");
            asm volatile("s_waitcnt vmcnt(0)" ::: "memory");
            const unsigned og = xb_add(&bar[XB_TOP], 1u);
            const unsigned tg = og / nx;
            if (og + 1u == (tg + 1u) * nx) xb_add(&bar[XB_TOPGEN], 1u);
            else XB_SPIN(xb_ld(&bar[XB_TOPGEN]) == tg, bar);
            __builtin_amdgcn_fence(__ATOMIC_ACQUIRE, "agent");
            xb_add(&bar[XB_XGEN(b.x)], 1u);
            asm volatile("s_waitcnt vmcnt(0)" ::: "memory");
        } else {
            XB_SPIN(xb_ld(&bar[XB_XGEN(b.x)]) == gen, bar);
            __builtin_amdgcn_fence(__ATOMIC_ACQUIRE, "agent");
            asm volatile("s_waitcnt vmcnt(0)" ::: "memory");
        }
    }
    __syncthreads();
}
namespace pg8 {
#define PG8_LAS __attribute__((address_space(3)))
typedef unsigned short bf16_t;
typedef short bf16x8 __attribute__((ext_vector_type(8)));
typedef float f32x4 __attribute__((ext_vector_type(4)));
typedef unsigned u32x4 __attribute__((ext_vector_type(4)));
constexpr int BM = 256, BK = 64, HALF = 128, HTB = HALF * BK * 2  , STAGE_BYTES = 8 * HTB, NXCD = 8, WGM = 8;

__host__ __device__ __forceinline__ int lds_byte(int r, int c) { const int st = (r >> 4) * 2 + (c >> 5), rr = r & 15, cc = c & 31, ob = rr * 64 + cc * 2; return st * 1024 + (ob ^ (((ob >> 9) & 1) << 5)); }
__host__ __device__ __forceinline__ void stage_rc(int b, int& R, int& C) { const int st = b / 1024, sb = b % 1024, swz = sb ^ (((sb >> 9) & 1) << 5); R = (st >> 1) * 16 + swz / 64; C = (st & 1) * 32 + (swz % 64) / 2; }
__host__ __device__ __forceinline__ int perm32(int rho) { const int n = rho >> 4, i = rho & 15; return 8 * (i >> 2) + 4 * n + (i & 3); }

struct Unit { int pm, pn; };
struct Gemm { const bf16_t* A; const bf16_t* Bt; int M, N, K; };
struct StaticOrder {
    int nM, nN, nwg, G, c;
    __host__ __device__ void init(int M, int N, int G_, int c_) { nM = M / BM; nN = N / BM; nwg = nM * nN; G = G_; c = c_; }
    __host__ __device__ bool next(int i, Unit& u) const {
        const long L = (long)i * G + c; if (L >= nwg) return false;
        int wgid = (int)L; { const int q = nwg / NXCD, r = nwg % NXCD, xcd = wgid % NXCD, off = wgid / NXCD; wgid = (xcd < r ? xcd * (q + 1) : r * (q + 1) + (xcd - r) * q) + off; }
        const int nig = WGM * nN, gid = wgid / nig, fm = gid * WGM, gsz = (nM - fm) < WGM ? (nM - fm) : WGM;
        u.pm = fm + ((wgid % nig) % gsz); u.pn = (wgid % nig) / gsz; return true;
    }
    __device__ __forceinline__ void a_ready(const Unit&) const {}
    __device__ __forceinline__ void done(const Unit&) const {}
};
__device__ __forceinline__ unsigned cvt_pk_bf16(float lo, float hi) { unsigned r; asm volatile("v_cvt_pk_bf16_f32 %0, %1, %2" : "=v"(r) : "v"(lo), "v"(hi)); return r; }
typedef float f32x2 __attribute__((ext_vector_type(2)));
__device__ __forceinline__ f32x2 gelu_pk(f32x2 v) {
    const f32x2 av = __builtin_elementwise_abs(v), d = av * 0.2316418882f + 1.0f;
    f32x2 t; t.x = __builtin_amdgcn_rcpf(d.x); t.y = __builtin_amdgcn_rcpf(d.y);
    f32x2 q = t * 0.5307027145f + (-0.7265760135f); q = q * t + 0.7107068705f; q = q * t + (-0.142248368f); q = q * t + 0.127414796f; q = q * t;
    const f32x2 s = (v * v) * (-0.72134752044f);
    f32x2 e; e.x = __builtin_amdgcn_exp2f(s.x); e.y = __builtin_amdgcn_exp2f(s.y);
    const f32x2 m = v * (q * e), r = v - m;
    f32x2 o; o.x = v.x < 0.f ? m.x : r.x; o.y = v.y < 0.f ? m.y : r.y; return o;
}

template <class Epi, class Sched, bool STAMP = false>
__device__ __forceinline__ void gemm_phase(PG8_LAS unsigned char* lds, const Gemm g, const Sched& S, const Epi& E, unsigned long long* stamps) {
    int tid_l = threadIdx.x; asm volatile("" : "+v"(tid_l)); const int tid = tid_l, wid = __builtin_amdgcn_readfirstlane(tid >> 6), lane = tid & 63, wr = wid >> 2, wc = wid & 3, fr = lane & 15, fq = lane >> 4;
    const int K = g.K, nt = K / BK;
    int ts_lo = 0, ts_hi = 0, nts = 0; const unsigned long long rt_entry = STAMP ? (unsigned long long)wall_clock64() : 0ull;
#define PG8_STAMP() do { if (STAMP && wid == 0 && nts < 64) { const unsigned long long _c = (unsigned long long)clock64(); \
        ts_lo = (lane == nts) ? (int)(unsigned)_c : ts_lo; ts_hi = (lane == nts) ? (int)(unsigned)(_c >> 32) : ts_hi; ++nts; } } while (0)
    PG8_STAMP();
    unsigned voffA[2], voffB[2];
#pragma unroll
    for (int i = 0; i < 2; ++i) { int R, C; stage_rc(tid * 16 + i * 8192, R, C); const int Rb = Epi::PERM ? ((R & ~31) + perm32(R & 31)) : R;
        voffA[i] = (unsigned)(R * K + C) * 2u; voffB[i] = (unsigned)(Rb * K + C) * 2u; }
    const size_t kstep = (size_t)(BK * 2);
    const size_t hstep = (size_t)HALF * K * 2;
    const size_t tstep = 2 * hstep;
    const unsigned ldsw = (unsigned)wid * 1024u;
    const int aoff = lds_byte(wr * 64 + fr, fq * 8), boff = lds_byte(wc * 32 + fr, fq * 8);
#define PG8_SA(b, h) (((b) * 2 + (h)) * HTB)
#define PG8_SB(b, h) ((4 + (b) * 2 + (h)) * HTB)
#define PG8_STAGE(bufoff, gbase, voff) do { _Pragma("unroll") for (int _i = 0; _i < 2; ++_i) \
        __builtin_amdgcn_global_load_lds((const unsigned*)((const char*)(gbase) + (voff)[_i]), (PG8_LAS unsigned*)(lds + (bufoff) + ldsw + _i * 8192), 16, 0, 0); } while (0)
#define PG8_LDA(dst, b, h) do { _Pragma("unroll") for (int m = 0; m < 4; ++m) _Pragma("unroll") for (int k = 0; k < 2; ++k) dst[m][k] = *(const PG8_LAS bf16x8*)(lds + PG8_SA(b, h) + aoff + m * 2048 + k * 1024); } while (0)
#define PG8_LDB(dst, b, h) do { _Pragma("unroll") for (int n = 0; n < 2; ++n) _Pragma("unroll") for (int k = 0; k < 2; ++k) dst[n][k] = *(const PG8_LAS bf16x8*)(lds + PG8_SB(b, h) + boff + n * 2048 + k * 1024); } while (0)
#define PG8_MMA(ai, bj, At, Bt) do { __builtin_amdgcn_s_setprio(1); _Pragma("unroll") for (int m = 0; m < 4; ++m) _Pragma("unroll") for (int n = 0; n < 2; ++n) _Pragma("unroll") for (int k = 0; k < 2; ++k) \
        acc[ai][bj][m][n] = __builtin_amdgcn_mfma_f32_16x16x32_bf16(Bt[n][k], At[m][k], acc[ai][bj][m][n], 0, 0, 0); __builtin_amdgcn_s_setprio(0); } while (0)
#define PG8_WAIT_V(n) asm volatile("s_waitcnt vmcnt(" #n ")" ::: "memory")
#define PG8_WAIT_L(n) asm volatile("s_waitcnt lgkmcnt(" #n ")" ::: "memory")
#define PG8_BAR __builtin_amdgcn_s_barrier()
#define PG8_SCHED __builtin_amdgcn_sched_barrier(0)
    Unit cur, nxt; int ui = 0;
    if (!S.next(0, cur)) return;
    f32x4 acc[2][2][4][2];
#pragma unroll
    for (int a = 0; a < 2; ++a)
#pragma unroll
        for (int b = 0; b < 2; ++b)
#pragma unroll
            for (int m = 0; m < 4; ++m)
#pragma unroll
                for (int n = 0; n < 2; ++n) acc[a][b][m][n] = (f32x4){0.f, 0.f, 0.f, 0.f};
    bf16x8 At[4][2], B0[2][2], B1[2][2];
    const char* cA = (const char*)g.A + (size_t)cur.pm * tstep; const char* cB = (const char*)g.Bt + (size_t)cur.pn * tstep;
    S.a_ready(cur);
    PG8_STAGE(PG8_SB(0, 0), cB, voffB); PG8_STAGE(PG8_SA(0, 0), cA, voffA); PG8_STAGE(PG8_SB(0, 1), cB + hstep, voffB); PG8_STAGE(PG8_SA(0, 1), cA + hstep, voffA);
    if (wr == 1) PG8_BAR;
    PG8_WAIT_V(4); PG8_BAR;
    PG8_STAGE(PG8_SB(1, 0), cB + kstep, voffB); PG8_STAGE(PG8_SA(1, 0), cA + kstep, voffA); PG8_STAGE(PG8_SB(1, 1), cB + hstep + kstep, voffB);
    PG8_WAIT_V(6); PG8_BAR;
    PG8_STAMP();
    for (;;) {
        const bool has_next = S.next(ui + 1, nxt);
        const char* nA = has_next ? (const char*)g.A + (size_t)nxt.pm * tstep : cA; const char* nB = has_next ? (const char*)g.Bt + (size_t)nxt.pn * tstep : cB;
        for (int t = 0; t < nt; t += 2) {
            const bool last = (t == nt - 2);
            const char* a1 = cA + (size_t)(t + 1) * kstep;
            const char* a2 = last ? nA : cA + (size_t)(t + 2) * kstep; const char* b2 = last ? nB : cB + (size_t)(t + 2) * kstep;
            const char* a3 = a2 + kstep; const char* b3 = b2 + kstep;
            if (last && has_next) S.a_ready(nxt);
            PG8_LDB(B0, 0, 0); PG8_SCHED; PG8_LDA(At, 0, 0); PG8_STAGE(PG8_SA(1, 1), a1 + hstep, voffA);
            PG8_WAIT_L(8); PG8_BAR; PG8_WAIT_L(0); PG8_MMA(0, 0, At, B0); PG8_BAR; PG8_SCHED;
            PG8_LDB(B1, 0, 1); PG8_STAGE(PG8_SB(0, 0), b2, voffB);
            PG8_BAR; PG8_WAIT_L(0); PG8_MMA(0, 1, At, B1); PG8_BAR;
            PG8_LDA(At, 0, 1); PG8_STAGE(PG8_SA(0, 0), a2, voffA);
            PG8_BAR; PG8_WAIT_L(0); PG8_MMA(1, 0, At, B0); PG8_BAR; PG8_SCHED;
            PG8_STAGE(PG8_SB(0, 1), b2 + hstep, voffB);
            PG8_WAIT_V(6); PG8_BAR; PG8_MMA(1, 1, At, B1); PG8_BAR;
            PG8_LDB(B0, 1, 0); PG8_SCHED; PG8_LDA(At, 1, 0); PG8_STAGE(PG8_SA(0, 1), a2 + hstep, voffA);
            PG8_WAIT_L(8); PG8_BAR; PG8_WAIT_L(0); PG8_MMA(0, 0, At, B0); PG8_BAR; PG8_SCHED;
            PG8_LDB(B1, 1, 1); PG8_STAGE(PG8_SB(1, 0), b3, voffB);
            PG8_BAR; PG8_WAIT_L(0); PG8_MMA(0, 1, At, B1); PG8_BAR;
            PG8_LDA(At, 1, 1); PG8_STAGE(PG8_SA(1, 0), a3, voffA);
            PG8_BAR; PG8_WAIT_L(0); PG8_MMA(1, 0, At, B0); PG8_BAR; PG8_SCHED;
            PG8_STAGE(PG8_SB(1, 1), b3 + hstep, voffB);
            PG8_WAIT_V(6); PG8_BAR; PG8_MMA(1, 1, At, B1); PG8_BAR;
        }
        PG8_STAMP();
        if constexpr (!Epi::AFTER_DRAIN) { E(acc, cur, wr, wc, fr, fq); S.done(cur); }
        PG8_STAMP();
        if (!has_next) break;
#pragma unroll
        for (int a = 0; a < 2; ++a)
#pragma unroll
            for (int b = 0; b < 2; ++b)
#pragma unroll
                for (int m = 0; m < 4; ++m)
#pragma unroll
                    for (int n = 0; n < 2; ++n) acc[a][b][m][n] = (f32x4){0.f, 0.f, 0.f, 0.f};
        cur = nxt; cA = nA; cB = nB; ++ui;
    }
    PG8_WAIT_V(0);
    if (wr == 0) PG8_BAR;
    PG8_BAR;
    if constexpr (Epi::AFTER_DRAIN) { E.fused(acc, cur, wr, wc, fr, fq, lds, wid, lane); S.done(cur); }
    PG8_STAMP();
    if (STAMP && wid == 0) { stamps[lane] = lane < nts ? (((unsigned long long)(unsigned)ts_hi << 32) | (unsigned)ts_lo) : 0ull;
        if (lane == 62) stamps[62] = rt_entry; if (lane == 63) stamps[63] = (unsigned long long)wall_clock64(); }
#undef PG8_STAMP
#undef PG8_SA
#undef PG8_SB
#undef PG8_STAGE
#undef PG8_LDA
#undef PG8_LDB
#undef PG8_MMA
#undef PG8_WAIT_V
#undef PG8_WAIT_L
#undef PG8_BAR
#undef PG8_SCHED
}
}

using pg8::bf16_t; using pg8::bf16x8; using pg8::f32x4; using pg8::u32x4;
typedef unsigned u32x2 __attribute__((ext_vector_type(2)));
typedef __bf16 bf16x2v __attribute__((ext_vector_type(2)));
__device__ __forceinline__ unsigned cvt_pk_bf16(float lo, float hi) { bf16x2v v; v.x = (__bf16)lo; v.y = (__bf16)hi; return __builtin_bit_cast(unsigned, v); }
#define NEG_INF (-__builtin_inff())
constexpr int T_TOK = 32768, DM = 1024, SEQ = 2048, NB = 16, MEMLEN = 256;
constexpr int HN = 3328;
constexpr int HC_QA = 0, HC_KA = 512, HC_ZU = 1024, HC_ZV = 1536, HC_CQ = 2048, HC_IQ = 2560, HC_CK = 3072, HC_IK = 3200, HC_IW = 3264;
constexpr int DIN = 6984;
constexpr float EPSF = 1e-6f, LOG2E = 1.4426950408889634f;
constexpr size_t MiB = 1048576;
constexpr size_t WS_CTL = 0, CTL_BTAB = 65536, CTL_LAM = 73728;
constexpr size_t WS_WB = 1 * MiB;
constexpr size_t WB_WIN = 0, WB_WV = 6815744, WB_WG = 8 * MiB, WB_BRA = 14 * MiB, WB_BRB = 15 * MiB, WB_BRC = 16 * MiB, WB_OUT = 17 * MiB,
                 WB_MQ = 19 * MiB, WB_MK = 20 * MiB, WB_MV = 21 * MiB, WB_MO = 22 * MiB, WB_PS = 23 * MiB;
constexpr size_t WS_MEMN = 29 * MiB, WS_MK = 37 * MiB, WS_MVT = 41 * MiB, WS_MASK = 45 * MiB, WS_XN = 53 * MiB, WS_R = 117 * MiB;
constexpr size_t R_H = 0, R_VT = 208 * MiB, R_G = 0, R_MERGED = 192 * MiB, R_PS = 0;
constexpr size_t WS_YA = 373 * MiB, WS_YB = 405 * MiB, WS_YC = 437 * MiB, WS_END = 469 * MiB;
constexpr int LDS_TOTAL = 163840, LDS_BAR_OFF = 163840 - 16;

struct Params { const float* in[34]; float* out; unsigned char* ws; int ph_lo, ph_hi, rep_ph, rep_n, rep_var, pad0; };
enum { I_X = 0, I_MEM, I_RELB, I_NORM_MIX, I_W_IN, I_AQG, I_AKG, I_LQ1, I_LK1, I_LQ2, I_LK2, I_SUBLN, I_BVG, I_BWS, I_BBS, I_CQG, I_CKG, I_WBRA, I_WBRB, I_WBRC,
       I_WOUT, I_NORM_MEM, I_NORM_MEMSRC, I_MWQ, I_MWKV, I_MQG, I_MKG, I_MWO, I_NORM_PEER, I_PWQ, I_SK1, I_SK2, I_PU, I_PV };

__device__ __forceinline__ int fresh_tid() { int t = threadIdx.x; asm volatile("" : "+v"(t)); return t; }
__device__ __forceinline__ int fresh_bid() { int b = blockIdx.x; asm volatile("" : "+s"(b)); return b; }
typedef __attribute__((address_space(1))) unsigned char* gptr_t;
__device__ __forceinline__ const Params& fresh_kp() { unsigned long long v = (unsigned long long)__builtin_amdgcn_kernarg_segment_ptr(); asm volatile("" : "+s"(v)); return *(const Params*)(const __attribute__((address_space(4))) Params*)v; }
__device__ __forceinline__ unsigned char* fresh_ptr(unsigned char* q) { unsigned long long v = (unsigned long long)q; asm volatile("" : "+s"(v)); return (unsigned char*)(gptr_t)v; }
__device__ __forceinline__ float shx(float v, int m, int lane) { return __uint_as_float((unsigned)__builtin_amdgcn_ds_bpermute((lane ^ m) << 2, (int)__float_as_uint(v))); }
__device__ __forceinline__ unsigned shxu(unsigned v, int m, int lane) { return (unsigned)__builtin_amdgcn_ds_bpermute((lane ^ m) << 2, (int)v); }
#define SHX(v, m) shx((v), (m), lane)
__device__ __forceinline__ float bf_lo(unsigned w) { return __uint_as_float(w << 16); }
__device__ __forceinline__ float bf_hi(unsigned w) { return __uint_as_float(w & 0xffff0000u); }
__device__ __forceinline__ float bf2f(bf16_t b) { return __uint_as_float(((unsigned)b) << 16); }
__device__ __forceinline__ bf16_t f2bf(float f) { return (bf16_t)(cvt_pk_bf16(f, 0.f) & 0xffffu); }
__device__ __forceinline__ float wave_sum(float v, int lane) { v += shx(v, 32, lane); v += shx(v, 16, lane); v += shx(v, 8, lane); v += shx(v, 4, lane); v += shx(v, 2, lane); v += shx(v, 1, lane); return v; }
__device__ __forceinline__ float gelu1(float x) { pg8::f32x2 v; v.x = x; v.y = 0.f; return pg8::gelu_pk(v).x; }
__device__ __forceinline__ unsigned ukey(float f) { const unsigned b = __float_as_uint(f); return (b & 0x80000000u) ? ~b : (b | 0x80000000u); }

typedef f32x4 AccT[2][2][4][2];
struct EpiStore {
    static constexpr bool PERM = true, AFTER_DRAIN = false;
    bf16_t* O; int ldc;
    __device__ __forceinline__ void operator()(const f32x4 (&acc)[2][2][4][2], const pg8::Unit& u, int wr, int wc, int fr, int fq) const {
        const int row0 = u.pm * 256 + wr * 64 + fr, col0 = u.pn * 256 + wc * 32 + 8 * fq;
#pragma unroll
        for (int ai = 0; ai < 2; ++ai)
#pragma unroll
            for (int m = 0; m < 4; ++m) { bf16_t* rowp = O + (size_t)(row0 + ai * 128 + m * 16) * ldc + col0;
#pragma unroll
                for (int bj = 0; bj < 2; ++bj) { const f32x4 v0 = acc[ai][bj][m][0], v1 = acc[ai][bj][m][1];
                    u32x4 w; w.x = cvt_pk_bf16(v0[0], v0[1]); w.y = cvt_pk_bf16(v0[2], v0[3]); w.z = cvt_pk_bf16(v1[0], v1[1]); w.w = cvt_pk_bf16(v1[2], v1[3]);
                    *(u32x4*)(rowp + bj * 128) = w; } }
    }
};
struct EpiSigmoid {
    static constexpr bool PERM = true, AFTER_DRAIN = false;
    bf16_t* O; int ldc;
    __device__ __forceinline__ void operator()(const f32x4 (&acc)[2][2][4][2], const pg8::Unit& u, int wr, int wc, int fr, int fq) const {
        const int row0 = u.pm * 256 + wr * 64 + fr, col0 = u.pn * 256 + wc * 32 + 8 * fq;
#pragma unroll
        for (int ai = 0; ai < 2; ++ai)
#pragma unroll
            for (int m = 0; m < 4; ++m) { bf16_t* rowp = O + (size_t)(row0 + ai * 128 + m * 16) * ldc + col0;
#pragma unroll
                for (int bj = 0; bj < 2; ++bj) { f32x4 v0 = acc[ai][bj][m][0], v1 = acc[ai][bj][m][1];
#pragma unroll
                    for (int j = 0; j < 4; ++j) { v0[j] = __builtin_amdgcn_rcpf(1.0f + __builtin_amdgcn_exp2f(-LOG2E * v0[j])); v1[j] = __builtin_amdgcn_rcpf(1.0f + __builtin_amdgcn_exp2f(-LOG2E * v1[j])); }
                    u32x4 w; w.x = cvt_pk_bf16(v0[0], v0[1]); w.y = cvt_pk_bf16(v0[2], v0[3]); w.z = cvt_pk_bf16(v1[0], v1[1]); w.w = cvt_pk_bf16(v1[2], v1[3]);
                    *(u32x4*)(rowp + bj * 128) = w; } }
    }
};
struct EpiBranch {
    static constexpr bool PERM = true, AFTER_DRAIN = false;
    bf16_t* Mg; const bf16_t* G; int br; int first;
    __device__ __forceinline__ void operator()(const f32x4 (&acc)[2][2][4][2], const pg8::Unit& u, int wr, int wc, int fr, int fq) const {
        const int row0 = u.pm * 256 + wr * 64 + fr, col0 = u.pn * 256 + wc * 32 + 8 * fq;
#pragma unroll
        for (int ai = 0; ai < 2; ++ai)
#pragma unroll
            for (int m = 0; m < 4; ++m) { const size_t row = (size_t)(row0 + ai * 128 + m * 16);
#pragma unroll
                for (int bj = 0; bj < 2; ++bj) { const f32x4 v0 = acc[ai][bj][m][0], v1 = acc[ai][bj][m][1];
                    const u32x4 g = *(const u32x4*)(G + row * 3072 + br * 1024 + col0 + bj * 128);
                    u32x4 p; p.x = 0u; p.y = 0u; p.z = 0u; p.w = 0u;
                    if (!first) p = *(const u32x4*)(Mg + row * 1024 + col0 + bj * 128);
                    u32x4 w;
                    w.x = cvt_pk_bf16(bf_lo(p.x) + bf_lo(g.x) * v0[0], bf_hi(p.x) + bf_hi(g.x) * v0[1]);
                    w.y = cvt_pk_bf16(bf_lo(p.y) + bf_lo(g.y) * v0[2], bf_hi(p.y) + bf_hi(g.y) * v0[3]);
                    w.z = cvt_pk_bf16(bf_lo(p.z) + bf_lo(g.z) * v1[0], bf_hi(p.z) + bf_hi(g.z) * v1[1]);
                    w.w = cvt_pk_bf16(bf_lo(p.w) + bf_lo(g.w) * v1[2], bf_hi(p.w) + bf_hi(g.w) * v1[3]);
                    *(u32x4*)(Mg + row * 1024 + col0 + bj * 128) = w; } }
    }
};
struct EpiResid {
    static constexpr bool PERM = false, AFTER_DRAIN = false;
    const float* base; float* out; int ldc;
    __device__ __forceinline__ void operator()(const f32x4 (&acc)[2][2][4][2], const pg8::Unit& u, int wr, int wc, int fr, int fq) const {
        const int row0 = u.pm * 256 + wr * 64 + fr, col0 = u.pn * 256 + wc * 32 + 4 * fq;
#pragma unroll
        for (int ai = 0; ai < 2; ++ai)
#pragma unroll
            for (int m = 0; m < 4; ++m) { const size_t off = (size_t)(row0 + ai * 128 + m * 16) * ldc + col0;
#pragma unroll
                for (int bj = 0; bj < 2; ++bj)
#pragma unroll
                    for (int n = 0; n < 2; ++n) { const f32x4 b = *(const f32x4*)(base + off + bj * 128 + n * 16); *(f32x4*)(out + off + bj * 128 + n * 16) = b + acc[ai][bj][m][n]; } }
    }
};
__device__ __forceinline__ size_t rb_off(size_t row, int n) { return row * 4096 + (size_t)(n >> 8) * 1024 + (size_t)(n & 255) * 2; }
template <bool SRC_F32>
struct EpiResidRB {
    static constexpr bool PERM = false, AFTER_DRAIN = false;
    const void* base; unsigned char* out;
    __device__ __forceinline__ void operator()(const f32x4 (&acc)[2][2][4][2], const pg8::Unit& u, int wr, int wc, int fr, int fq) const {
        const int row0 = u.pm * 256 + wr * 64 + fr, col0 = u.pn * 256 + wc * 32 + 4 * fq;
#pragma unroll
        for (int ai = 0; ai < 2; ++ai)
#pragma unroll
            for (int m = 0; m < 4; ++m) { const size_t row = (size_t)(row0 + ai * 128 + m * 16);
#pragma unroll
                for (int bj = 0; bj < 2; ++bj)
#pragma unroll
                    for (int n = 0; n < 2; ++n) { const int col = col0 + bj * 128 + n * 16; f32x4 b;
                        if (SRC_F32) b = *(const f32x4*)((const float*)base + row * 1024 + col);
                        else { const u32x2 w = *(const u32x2*)((const unsigned char*)base + rb_off(row, col)); b = (f32x4){bf_lo(w.x), bf_hi(w.x), bf_lo(w.y), bf_hi(w.y)}; }
                        const f32x4 r = b + acc[ai][bj][m][n]; u32x2 o; o.x = cvt_pk_bf16(r[0], r[1]); o.y = cvt_pk_bf16(r[2], r[3]);
                        *(u32x2*)(out + rb_off(row, col)) = o; } }
    }
};
struct EpiF32Store {
    static constexpr bool PERM = false, AFTER_DRAIN = false;
    float* C; int ldc;
    __device__ __forceinline__ void operator()(const f32x4 (&acc)[2][2][4][2], const pg8::Unit& u, int wr, int wc, int fr, int fq) const {
        const int row0 = u.pm * 256 + wr * 64 + fr, col0 = u.pn * 256 + wc * 32 + 4 * fq;
#pragma unroll
        for (int ai = 0; ai < 2; ++ai)
#pragma unroll
            for (int m = 0; m < 4; ++m) { const size_t off = (size_t)(row0 + ai * 128 + m * 16) * ldc + col0;
#pragma unroll
                for (int bj = 0; bj < 2; ++bj)
#pragma unroll
                    for (int n = 0; n < 2; ++n) *(f32x4*)(C + off + bj * 128 + n * 16) = acc[ai][bj][m][n]; }
    }
};
typedef _Float16 f16x4 __attribute__((ext_vector_type(4)));
struct EpiF16Store {
    static constexpr bool PERM = false, AFTER_DRAIN = false;
    _Float16* C; int ldc;
    __device__ __forceinline__ void operator()(const f32x4 (&acc)[2][2][4][2], const pg8::Unit& u, int wr, int wc, int fr, int fq) const {
        const int row0 = u.pm * 256 + wr * 64 + fr, col0 = u.pn * 256 + wc * 32 + 4 * fq;
#pragma unroll
        for (int ai = 0; ai < 2; ++ai)
#pragma unroll
            for (int m = 0; m < 4; ++m) { const size_t off = (size_t)(row0 + ai * 128 + m * 16) * ldc + col0;
#pragma unroll
                for (int bj = 0; bj < 2; ++bj)
#pragma unroll
                    for (int n = 0; n < 2; ++n) { const f32x4 v = acc[ai][bj][m][n]; *(f16x4*)(C + off + bj * 128 + n * 16) = (f16x4){(_Float16)v[0], (_Float16)v[1], (_Float16)v[2], (_Float16)v[3]}; } }
    }
};
template <class Epi>
__device__ __forceinline__ void run_gemm(LAS unsigned char* lds, const bf16_t* A, const bf16_t* Bt, int M, int N, int K, int cshift, const Epi& E) {
    pg8::Gemm g{A, Bt, M, N, K}; pg8::StaticOrder S; S.init(M, N, (int)gridDim.x, (int)((blockIdx.x + cshift) % gridDim.x));
    pg8::gemm_phase<Epi, pg8::StaticOrder, false>(lds, g, S, E, nullptr);
    __syncthreads();
}

__device__ __forceinline__ void conv_transpose(LAS unsigned char* lds, const float* src, int ld_src, int col0, int ncols, bf16_t* dst, int K, int nrows) {
    LAS float* tl = (LAS float*)lds;
    const int tid = fresh_tid(), ntk = K / 64, ntiles = (nrows / 64) * ntk;
    for (int tile = blockIdx.x; tile < ntiles; tile += gridDim.x) {
        const int n0 = (tile / ntk) * 64, k0 = (tile % ntk) * 64;
#pragma unroll
        for (int p = 0; p < 2; ++p) { const int kk = (tid >> 4) + 32 * p, n4 = (tid & 15) * 4;
            f32x4 v = (f32x4){0.f, 0.f, 0.f, 0.f};
            if (n0 + n4 < ncols) v = *(const f32x4*)(src + (size_t)(k0 + kk) * ld_src + col0 + n0 + n4);
            tl[kk * 65 + n4 + 0] = v[0]; tl[kk * 65 + n4 + 1] = v[1]; tl[kk * 65 + n4 + 2] = v[2]; tl[kk * 65 + n4 + 3] = v[3]; }
        __syncthreads();
        { const int n = tid >> 3, kc = (tid & 7) * 8; float f[8];
#pragma unroll
            for (int j = 0; j < 8; ++j) f[j] = tl[(kc + j) * 65 + n];
            u32x4 w; w.x = cvt_pk_bf16(f[0], f[1]); w.y = cvt_pk_bf16(f[2], f[3]); w.z = cvt_pk_bf16(f[4], f[5]); w.w = cvt_pk_bf16(f[6], f[7]);
            *(u32x4*)(dst + (size_t)(n0 + n) * K + k0 + kc) = w; }
        __syncthreads();
    }
}
template <bool SRC_RB>
__device__ __forceinline__ void rmsnorm_rows_t(const void* x, const float* g, bf16_t* out, int rows) {
    const int tid = fresh_tid(); const int lane = tid & 63, gw = blockIdx.x * 8 + (tid >> 6), nw = gridDim.x * 8;
    f32x4 gv[4];
#pragma unroll
    for (int i = 0; i < 4; ++i) gv[i] = *(const f32x4*)(g + 4 * lane + 256 * i);
    for (int r = gw; r < rows; r += nw) {
        f32x4 v[4]; float ss = 0.f;
#pragma unroll
        for (int i = 0; i < 4; ++i) { if (SRC_RB) { const u32x2 w = *(const u32x2*)((const unsigned char*)x + (size_t)r * 4096 + 1024 * i + 8 * lane); v[i] = (f32x4){bf_lo(w.x), bf_hi(w.x), bf_lo(w.y), bf_hi(w.y)}; }
            else v[i] = *(const f32x4*)((const float*)x + (size_t)r * 1024 + 4 * lane + 256 * i);
            ss += v[i][0] * v[i][0] + v[i][1] * v[i][1] + v[i][2] * v[i][2] + v[i][3] * v[i][3]; }
        ss = wave_sum(ss, lane);
        const float sc = rsqrtf(ss * (1.0f / 1024.0f) + EPSF);
#pragma unroll
        for (int i = 0; i < 4; ++i) { u32x2 w; w.x = cvt_pk_bf16(v[i][0] * sc * gv[i][0], v[i][1] * sc * gv[i][1]); w.y = cvt_pk_bf16(v[i][2] * sc * gv[i][2], v[i][3] * sc * gv[i][3]);
            *(u32x2*)(out + (size_t)r * 1024 + 4 * lane + 256 * i) = w; }
    }
}
__device__ __forceinline__ void rmsnorm_rows(const float* x, const float* g, bf16_t* out, int rows) { rmsnorm_rows_t<false>(x, g, out, rows); }
__device__ __forceinline__ void peer_fuse_weights(LAS unsigned char* lds, const float* pwq  , const float* sk1, const float* sk2  , bf16_t* dst  ) {
    LAS float* Pt = (LAS float*)lds;
    LAS float* Sk = (LAS float*)(lds + 64 * 129 * 4);
    const int tid = fresh_tid();
    for (int item = blockIdx.x; item < 256; item += gridDim.x) {
        const int hh = item >> 4, k0 = (item & 15) * 64; const float* sk = (hh & 1) ? sk2 : sk1;
        for (int e = tid; e < 64 * 32; e += 512) { const int kk = e >> 5, d4 = (e & 31) * 4; const f32x4 v = *(const f32x4*)(pwq + (size_t)(k0 + kk) * 2048 + hh * 128 + d4);
            Pt[kk * 129 + d4] = v[0]; Pt[kk * 129 + d4 + 1] = v[1]; Pt[kk * 129 + d4 + 2] = v[2]; Pt[kk * 129 + d4 + 3] = v[3]; }
        for (int e = tid; e < 128 * 32; e += 512) { const int n = e >> 5, d4 = (e & 31) * 4; const f32x4 v = *(const f32x4*)(sk + (size_t)n * 128 + d4);
            Sk[n * 129 + d4] = v[0]; Sk[n * 129 + d4 + 1] = v[1]; Sk[n * 129 + d4 + 2] = v[2]; Sk[n * 129 + d4 + 3] = v[3]; }
        __syncthreads();
        { const int n = tid & 127, kg = __builtin_amdgcn_readfirstlane(tid >> 7); float acc[16];
#pragma unroll
            for (int j = 0; j < 16; ++j) acc[j] = 0.f;
            for (int d = 0; d < 128; ++d) { const float s = Sk[n * 129 + d];
#pragma unroll
                for (int j = 0; j < 16; ++j) acc[j] = __builtin_fmaf(Pt[(kg * 16 + j) * 129 + d], s, acc[j]); }
            u32x4 w0, w1; w0.x = cvt_pk_bf16(acc[0], acc[1]); w0.y = cvt_pk_bf16(acc[2], acc[3]); w0.z = cvt_pk_bf16(acc[4], acc[5]); w0.w = cvt_pk_bf16(acc[6], acc[7]);
            w1.x = cvt_pk_bf16(acc[8], acc[9]); w1.y = cvt_pk_bf16(acc[10], acc[11]); w1.z = cvt_pk_bf16(acc[12], acc[13]); w1.w = cvt_pk_bf16(acc[14], acc[15]);
            bf16_t* o = dst + (size_t)(hh * 128 + n) * 1024 + k0 + kg * 16; *(u32x4*)o = w0; *(u32x4*)(o + 8) = w1; }
        __syncthreads();
    }
}
__device__ __forceinline__ void make_tables(const Params& p) {
    unsigned char* const wsl = fresh_ptr(p.ws);
    if (blockIdx.x != 0) return;
    const int tidm = fresh_tid();
    float* btab = (float*)(wsl + WS_CTL + CTL_BTAB); float* lamv = (float*)(wsl + WS_CTL + CTL_LAM);
    const float* rb = p.in[I_RELB];
    for (int e = tidm; e < 8 * 128; e += 512) { const int hd = e >> 7, d = e & 127; int bk;
        if (d < 16) bk = d; else { const float nf = (float)d; int lg = 16 + (int)(logf(nf / 16.0f) / 2.0794415416798357f * 16.0f); bk = lg < 31 ? lg : 31; }
        btab[e] = (rb[bk * 8 + hd] - rb[31 * 8 + hd]) * LOG2E; }
    if (tidm < 128) { const int l = tidm >> 6, lane = tidm & 63;
        float a = p.in[I_LQ1][l * 64 + lane] * p.in[I_LK1][l * 64 + lane], b = p.in[I_LQ2][l * 64 + lane] * p.in[I_LK2][l * 64 + lane];
        a = wave_sum(a, lane); b = wave_sum(b, lane);
        const float lam_init = 0.8f - 0.6f * expf(-0.3f * (float)l);
        if (lane == 0) { lamv[l * 2] = expf(a) - expf(b) + lam_init; lamv[l * 2 + 1] = lam_init; } }
}
__device__ __forceinline__ void prep_weights(const Params& p, LAS unsigned char* lds, int l) {
    unsigned char* const wsl = fresh_ptr(p.ws);
    unsigned char* wb = wsl + WS_WB;
    const float* win = p.in[I_W_IN] + (size_t)l * 1024 * DIN;
    bf16_t* winT = (bf16_t*)(wb + WB_WIN);
    conv_transpose(lds, win, DIN, 0,    512, winT + (size_t)HC_QA * 1024, 1024, 512);
    conv_transpose(lds, win, DIN, 512,  512, winT + (size_t)HC_KA * 1024, 1024, 512);
    conv_transpose(lds, win, DIN, 1536, 512, winT + (size_t)HC_ZU * 1024, 1024, 512);
    conv_transpose(lds, win, DIN, 2048, 512, winT + (size_t)HC_ZV * 1024, 1024, 512);
    conv_transpose(lds, win, DIN, 2560, 512, winT + (size_t)HC_CQ * 1024, 1024, 512);
    conv_transpose(lds, win, DIN, 3328, 512, winT + (size_t)HC_IQ * 1024, 1024, 512);
    conv_transpose(lds, win, DIN, 3072, 128, winT + (size_t)HC_CK * 1024, 1024, 128);
    conv_transpose(lds, win, DIN, 3840, 64,  winT + (size_t)HC_IK * 1024, 1024, 64);
    conv_transpose(lds, win, DIN, 3904, 8,   winT + (size_t)HC_IW * 1024, 1024, 64);
    bf16_t* wvT = (bf16_t*)(wb + WB_WV);
    conv_transpose(lds, win, DIN, 1024, 512, wvT, 1024, 512);
    conv_transpose(lds, win, DIN, 3200, 128, wvT + (size_t)512 * 1024, 1024, 128);
    conv_transpose(lds, win, DIN, 0,    0,   wvT + (size_t)640 * 1024, 1024, 128);
    conv_transpose(lds, win, DIN, 3912, 3072, (bf16_t*)(wb + WB_WG), 1024, 3072);
    conv_transpose(lds, p.in[I_WBRA] + (size_t)l * 512 * 1024, 1024, 0, 1024, (bf16_t*)(wb + WB_BRA), 512, 1024);
    conv_transpose(lds, p.in[I_WBRB] + (size_t)l * 512 * 1024, 1024, 0, 1024, (bf16_t*)(wb + WB_BRB), 512, 1024);
    conv_transpose(lds, p.in[I_WBRC] + (size_t)l * 512 * 1024, 1024, 0, 1024, (bf16_t*)(wb + WB_BRC), 512, 1024);
    conv_transpose(lds, p.in[I_WOUT] + (size_t)l * 1024 * 1024, 1024, 0, 1024, (bf16_t*)(wb + WB_OUT), 1024, 1024);
    conv_transpose(lds, p.in[I_MWQ] + (size_t)l * 1024 * 512, 512, 0, 512, (bf16_t*)(wb + WB_MQ), 1024, 512);
    conv_transpose(lds, p.in[I_MWKV] + (size_t)l * 1024 * 1024, 1024, 0, 512, (bf16_t*)(wb + WB_MK), 1024, 512);
    conv_transpose(lds, p.in[I_MWKV] + (size_t)l * 1024 * 1024, 1024, 512, 512, (bf16_t*)(wb + WB_MV), 1024, 512);
    conv_transpose(lds, p.in[I_MWO] + (size_t)l * 512 * 1024, 1024, 0, 1024, (bf16_t*)(wb + WB_MO), 512, 1024);
    peer_fuse_weights(lds, p.in[I_PWQ] + (size_t)l * 1024 * 2048, p.in[I_SK1] + (size_t)l * 128 * 128, p.in[I_SK2] + (size_t)l * 128 * 128, (bf16_t*)(wb + WB_PS));
}
__device__ __forceinline__ void conv_copy(const float* src, bf16_t* dst, size_t n) {
    const size_t stride = (size_t)gridDim.x * 512 * 8;
    const int tidc = fresh_tid();
    for (size_t i = ((size_t)blockIdx.x * 512 + tidc) * 8; i < n; i += stride) {
        const f32x4 a = *(const f32x4*)(src + i), b = *(const f32x4*)(src + i + 4);
        u32x4 w; w.x = cvt_pk_bf16(a[0], a[1]); w.y = cvt_pk_bf16(a[2], a[3]); w.z = cvt_pk_bf16(b[0], b[1]); w.w = cvt_pk_bf16(b[2], b[3]);
        *(u32x4*)(dst + i) = w; }
}

__device__ __forceinline__ void knorm_rows(const Params& p, int l) {
    unsigned char* const wsl = fresh_ptr(p.ws);
    bf16_t* H = (bf16_t*)(wsl + WS_R + R_H); bf16_t* MK = (bf16_t*)(wsl + WS_MK);
    const float* akg = p.in[I_AKG] + l * 64; const float* ckg = p.in[I_CKG] + l * 128; const float* mkg = p.in[I_MKG] + l * 128;
    const int tid = fresh_tid(); const int lane = tid & 63, gw = blockIdx.x * 8 + (tid >> 6), nw = gridDim.x * 8;
    float ga[8], gm[8];
#pragma unroll
    for (int j = 0; j < 8; ++j) { ga[j] = akg[(8 * lane + j) & 63]; gm[j] = mkg[(8 * lane + j) & 127]; }
    const float gc0 = ckg[2 * lane], gc1 = ckg[2 * lane + 1];
    for (int r = gw; r < T_TOK; r += nw) {
        bf16_t* row = H + (size_t)r * HN;
        {
            u32x4 w = *(const u32x4*)(row + HC_KA + 8 * lane); float f[8] = {bf_lo(w.x), bf_hi(w.x), bf_lo(w.y), bf_hi(w.y), bf_lo(w.z), bf_hi(w.z), bf_lo(w.w), bf_hi(w.w)};
            float ss = 0.f;
#pragma unroll
            for (int j = 0; j < 8; ++j) ss += f[j] * f[j];
            ss += SHX(ss, 1); ss += SHX(ss, 2); ss += SHX(ss, 4);
            const float sc = rsqrtf(ss * (1.0f / 64.0f) + EPSF);
            w.x = cvt_pk_bf16(f[0] * sc * ga[0], f[1] * sc * ga[1]); w.y = cvt_pk_bf16(f[2] * sc * ga[2], f[3] * sc * ga[3]);
            w.z = cvt_pk_bf16(f[4] * sc * ga[4], f[5] * sc * ga[5]); w.w = cvt_pk_bf16(f[6] * sc * ga[6], f[7] * sc * ga[7]);
            *(u32x4*)(row + HC_KA + 8 * lane) = w; }
        {
            const unsigned w = *(const unsigned*)(row + HC_CK + 2 * lane); const float a = bf_lo(w), b = bf_hi(w);
            const float ss = wave_sum(a * a + b * b, lane); const float sc = rsqrtf(ss * (1.0f / 128.0f) + EPSF);
            *(unsigned*)(row + HC_CK + 2 * lane) = cvt_pk_bf16(a * sc * gc0, b * sc * gc1); }
    }
    for (int r = gw; r < NB * MEMLEN; r += nw) {
        bf16_t* row = MK + (size_t)r * 512;
        u32x4 w = *(const u32x4*)(row + 8 * lane); float f[8] = {bf_lo(w.x), bf_hi(w.x), bf_lo(w.y), bf_hi(w.y), bf_lo(w.z), bf_hi(w.z), bf_lo(w.w), bf_hi(w.w)};
        float ss = 0.f;
#pragma unroll
        for (int j = 0; j < 8; ++j) ss += f[j] * f[j];
        ss += SHX(ss, 1); ss += SHX(ss, 2); ss += SHX(ss, 4); ss += SHX(ss, 8);
        const float sc = rsqrtf(ss * (1.0f / 128.0f) + EPSF);
        w.x = cvt_pk_bf16(f[0] * sc * gm[0], f[1] * sc * gm[1]); w.y = cvt_pk_bf16(f[2] * sc * gm[2], f[3] * sc * gm[3]);
        w.z = cvt_pk_bf16(f[4] * sc * gm[4], f[5] * sc * gm[5]); w.w = cvt_pk_bf16(f[6] * sc * gm[6], f[7] * sc * gm[7]);
        *(u32x4*)(row + 8 * lane) = w;
    }
}
__device__ __forceinline__ void gmlp_phase(const Params& p, LAS unsigned char* lds, int l) {
    unsigned char* const wsl = fresh_ptr(p.ws);
    const bf16_t* H = (const bf16_t*)(wsl + WS_R + R_H); bf16_t* YB = (bf16_t*)(wsl + WS_YB);
    LAS unsigned char* Wl = lds;
    LAS unsigned char* Vt = lds + 32768;
    LAS unsigned char* Ul = lds + 65536;
    const int tid = fresh_tid(), lane = tid & 63, wv = __builtin_amdgcn_readfirstlane(tid >> 6), fr = lane & 15, fq = lane >> 4;
    for (int unit = blockIdx.x; unit < 1024; unit += gridDim.x) {
        const int c = unit >> 2, g = unit & 3; const size_t t0 = (size_t)c * 128;
        const float* W = p.in[I_BWS] + ((size_t)(l * 4 + g) * 128) * 128; const float* bs = p.in[I_BBS] + (size_t)(l * 4 + g) * 128; const float* vg = p.in[I_BVG] + l * 512 + g * 128;
        { const int t = tid >> 2, sq = (tid & 3) * 32;
#pragma unroll
            for (int q = 0; q < 4; ++q) { const f32x4 a = *(const f32x4*)(W + (size_t)t * 128 + sq + q * 8), b = *(const f32x4*)(W + (size_t)t * 128 + sq + q * 8 + 4);
                float f[8] = {a[0], a[1], a[2], a[3], b[0], b[1], b[2], b[3]};
#pragma unroll
                for (int j = 0; j < 8; ++j) if (sq + q * 8 + j > t) f[j] = 0.f;
                u32x4 w; w.x = cvt_pk_bf16(f[0], f[1]); w.y = cvt_pk_bf16(f[2], f[3]); w.z = cvt_pk_bf16(f[4], f[5]); w.w = cvt_pk_bf16(f[6], f[7]);
                const int ch = (sq >> 3) + q; *(LAS u32x4*)(Wl + t * 256 + ((ch ^ (t & 15)) << 4)) = w; } }
        { const int s = tid >> 2, dq = (tid & 3) * 32;
            const bf16_t* src = H + (t0 + s) * HN + HC_ZV + g * 128 + dq; float f[32]; float ss = 0.f;
#pragma unroll
            for (int q = 0; q < 4; ++q) { const u32x4 w = *(const u32x4*)(src + q * 8);
                f[q * 8 + 0] = bf_lo(w.x); f[q * 8 + 1] = bf_hi(w.x); f[q * 8 + 2] = bf_lo(w.y); f[q * 8 + 3] = bf_hi(w.y); f[q * 8 + 4] = bf_lo(w.z); f[q * 8 + 5] = bf_hi(w.z); f[q * 8 + 6] = bf_lo(w.w); f[q * 8 + 7] = bf_hi(w.w); }
#pragma unroll
            for (int j = 0; j < 32; ++j) { f[j] = gelu1(f[j]); ss += f[j] * f[j]; }
            ss += SHX(ss, 1); ss += SHX(ss, 2);
            const float sc = rsqrtf(ss * (1.0f / 128.0f) + EPSF);
#pragma unroll
            for (int j = 0; j < 32; ++j) { const int d = dq + j; const float v = f[j] * sc * vg[d];
                *(LAS bf16_t*)(Vt + d * 256 + (((s >> 3) ^ (d & 15)) << 4) + (s & 7) * 2) = f2bf(v); } }
        { const int t = tid >> 2, dq = (tid & 3) * 32;
            const bf16_t* src = H + (t0 + t) * HN + HC_ZU + g * 128 + dq;
#pragma unroll
            for (int q = 0; q < 4; ++q) { const u32x4 w = *(const u32x4*)(src + q * 8);
                u32x4 o; o.x = cvt_pk_bf16(gelu1(bf_lo(w.x)), gelu1(bf_hi(w.x))); o.y = cvt_pk_bf16(gelu1(bf_lo(w.y)), gelu1(bf_hi(w.y)));
                o.z = cvt_pk_bf16(gelu1(bf_lo(w.z)), gelu1(bf_hi(w.z))); o.w = cvt_pk_bf16(gelu1(bf_lo(w.w)), gelu1(bf_hi(w.w)));
                *(LAS u32x4*)(Ul + t * 272 + (dq + q * 8) * 2) = o; } }
        __syncthreads();
        {
            f32x4 acc[8];
#pragma unroll
            for (int dd = 0; dd < 8; ++dd) acc[dd] = (f32x4){0.f, 0.f, 0.f, 0.f};
            const int nks = (wv >> 1) + 1; const int trow = 16 * wv + fr;
            for (int ks = 0; ks < nks; ++ks) {
                const bf16x8 wf = *(const LAS bf16x8*)(Wl + trow * 256 + (((4 * ks + fq) ^ (trow & 15)) << 4));
#pragma unroll
                for (int dd = 0; dd < 8; ++dd) { const int d = 16 * dd + fr; const bf16x8 vf = *(const LAS bf16x8*)(Vt + d * 256 + (((4 * ks + fq) ^ (d & 15)) << 4));
                    acc[dd] = __builtin_amdgcn_mfma_f32_16x16x32_bf16(wf, vf, acc[dd], 0, 0, 0); } }
#pragma unroll
            for (int i = 0; i < 4; ++i) { const int t = 16 * wv + 4 * fq + i; const float bb = bs[t];
#pragma unroll
                for (int dd = 0; dd < 8; ++dd) { const int d = 16 * dd + fr; LAS bf16_t* up = (LAS bf16_t*)(Ul + t * 272 + d * 2); *up = f2bf((acc[dd][i] + bb) * bf2f(*up)); } }
        }
        __syncthreads();
        { const int t = tid >> 2, dq = (tid & 3) * 32; bf16_t* dst = YB + (t0 + t) * 512 + g * 128 + dq;
#pragma unroll
            for (int q = 0; q < 4; ++q) *(u32x4*)(dst + q * 8) = *(const LAS u32x4*)(Ul + t * 272 + (dq + q * 8) * 2); }
        __syncthreads();
    }
}

struct AttnArgs {
    const bf16_t* Q; int ldq; int qcol[2]; size_t qtok; const float* qgain; float qscale;
    const bf16_t* K; int ldk; size_t krow0; int kcol0;
    const bf16_t* V; int ldv; int vrow0; size_t vcol0;
    int nkt_blk, my_nkt, qpos, qpos_w0; int bhead[2]; const unsigned short* maskrow; int var;
};
#ifdef ATT_PROBE
#define AV(bit) (a.var & (bit))
#else
#define AV(bit) 0
#endif
template <int NS, int DQK, bool KSPLIT, int MODE>
__device__ __forceinline__ void attn_core(LAS unsigned char* lds, const LAS float* btab, const AttnArgs& a, f32x4 (&O)[NS][8], float (&lsum)[NS]) {
    constexpr int NKS = DQK / 32;
    const int tid = fresh_tid(), lane = tid & 63, fr = lane & 15, fq = lane >> 4;
    bf16x8 qf[NS][NKS];
#pragma unroll
    for (int s = 0; s < NS; ++s) {
        float qv[NKS][8]; float ss = 0.f;
#pragma unroll
        for (int ks = 0; ks < NKS; ++ks) { const u32x4 w = *(const u32x4*)(a.Q + a.qtok * a.ldq + a.qcol[s] + 32 * ks + 8 * fq);
            qv[ks][0] = bf_lo(w.x); qv[ks][1] = bf_hi(w.x); qv[ks][2] = bf_lo(w.y); qv[ks][3] = bf_hi(w.y); qv[ks][4] = bf_lo(w.z); qv[ks][5] = bf_hi(w.z); qv[ks][6] = bf_lo(w.w); qv[ks][7] = bf_hi(w.w);
#pragma unroll
            for (int j = 0; j < 8; ++j) ss += qv[ks][j] * qv[ks][j]; }
        ss += SHX(ss, 16); ss += SHX(ss, 32);
        const float r = rsqrtf(ss * (1.0f / (float)DQK) + EPSF) * a.qscale;
#pragma unroll
        for (int ks = 0; ks < NKS; ++ks) { const f32x4 g0 = *(const f32x4*)(a.qgain + 32 * ks + 8 * fq), g1 = *(const f32x4*)(a.qgain + 32 * ks + 8 * fq + 4);
            u32x4 w; w.x = cvt_pk_bf16(qv[ks][0] * r * g0[0], qv[ks][1] * r * g0[1]); w.y = cvt_pk_bf16(qv[ks][2] * r * g0[2], qv[ks][3] * r * g0[3]);
            w.z = cvt_pk_bf16(qv[ks][4] * r * g1[0], qv[ks][5] * r * g1[1]); w.w = cvt_pk_bf16(qv[ks][6] * r * g1[2], qv[ks][7] * r * g1[3]);
            qf[s][ks] = __builtin_bit_cast(bf16x8, w); }
    }
    constexpr bool MROW = (MODE != 1);
    float mrun[NS]; f32x4 lacc[NS];
    const bf16x8 ones = __builtin_bit_cast(bf16x8, (u32x4){0x3f803f80u, 0x3f803f80u, 0x3f803f80u, 0x3f803f80u});
#pragma unroll
    for (int s = 0; s < NS; ++s) { mrun[s] = NEG_INF; lacc[s] = (f32x4){0.f, 0.f, 0.f, 0.f};
#pragma unroll
        for (int dt = 0; dt < 8; ++dt) O[s][dt] = (f32x4){0.f, 0.f, 0.f, 0.f}; }
    const int wvs = __builtin_amdgcn_readfirstlane(tid >> 6);
    const int c0 = tid, c1 = tid + 512;
    const int kr0 = c0 >> 4, kr1 = c1 >> 4, vr0 = c0 >> 3, vr1 = c1 >> 3;
    const int kc0 = (c0 & 15) ^ (kr0 & 15), kc1 = (c1 & 15) ^ (kr1 & 15), vc0 = (c0 & 7) ^ ((vr0 >> 1) & 7), vc1 = (c1 & 7) ^ ((vr1 >> 1) & 7);
    const bf16_t* kg0 = a.K + (a.krow0 + kr0) * a.ldk + a.kcol0 + kc0 * 8; const bf16_t* kg1 = a.K + (a.krow0 + kr1) * a.ldk + a.kcol0 + kc1 * 8;
    const bf16_t* vg0 = a.V + (size_t)(a.vrow0 + vr0) * a.ldv + a.vcol0 + vc0 * 8; const bf16_t* vg1 = a.V + (size_t)(a.vrow0 + vr1) * a.ldv + a.vcol0 + vc1 * 8;
    const int ldw = wvs * 1024;
#define ATT_STAGE(bufoff, ko, vo) do { \
        __builtin_amdgcn_global_load_lds((const unsigned*)(kg0 + (ko)), (LAS unsigned*)(lds + (bufoff) + ldw), 16, 0, 0); \
        __builtin_amdgcn_global_load_lds((const unsigned*)(kg1 + (ko)), (LAS unsigned*)(lds + (bufoff) + 8192 + ldw), 16, 0, 0); \
        __builtin_amdgcn_global_load_lds((const unsigned*)(vg0 + (vo)), (LAS unsigned*)(lds + (bufoff) + 16384 + ldw), 16, 0, 0); \
        __builtin_amdgcn_global_load_lds((const unsigned*)(vg1 + (vo)), (LAS unsigned*)(lds + (bufoff) + 24576 + ldw), 16, 0, 0); } while (0)
    LAS unsigned char* mrow = lds + 102400 + wvs * 4352 + fr * 264;
    if (MODE == 1) {
#pragma unroll
        for (int j = 0; j < 4; ++j) { const u32x4 w = *(const u32x4*)(a.maskrow + fq * 32 + j * 8); *(LAS u32x2*)(mrow + fq * 64 + j * 16) = (u32x2){w.x, w.y}; *(LAS u32x2*)(mrow + fq * 64 + j * 16 + 8) = (u32x2){w.z, w.w}; }
        asm volatile("s_waitcnt vmcnt(0) lgkmcnt(0)" ::: "memory");
    }
    ATT_STAGE(0, 0, 0);
    if (a.nkt_blk > 1 && !AV(8)) ATT_STAGE(32768, (size_t)64 * a.ldk, (size_t)64);
    int slot = 0;
    for (int kt = 0; kt < a.nkt_blk; ++kt) {
        if (kt + 1 < a.nkt_blk && !AV(8)) asm volatile("s_waitcnt vmcnt(4)" ::: "memory"); else asm volatile("s_waitcnt vmcnt(0)" ::: "memory");
        if (!AV(16)) { asm volatile("" ::: "memory"); __builtin_amdgcn_s_barrier(); asm volatile("" ::: "memory"); }
        if (kt + 2 < a.nkt_blk && !AV(8)) { const int ns = (slot >= 1) ? slot - 1 : 2; const size_t ko = (size_t)(kt + 2) * 64 * a.ldk, vo = (size_t)(kt + 2) * 64; ATT_STAGE(ns * 32768, ko, vo); }
        const int buf = slot; slot = (slot == 2) ? 0 : slot + 1;
        unsigned long long mbits = 0ull;
        if (MODE == 1) { const u32x2 mw = *(const LAS u32x2*)(mrow + kt * 8); mbits = ((unsigned long long)mw.y << 32) | mw.x; }
        if (kt < a.my_nkt) {
            const LAS unsigned char* Kt = lds + buf * 32768; const LAS unsigned char* Vt = Kt + 16384;
            const int key0 = kt * 64;
            const bool near = (MODE != 2) && (a.qpos_w0 - key0 - 63 < 128);
            bf16x8 pf[NS][2];
#pragma unroll
            for (int s = 0; s < NS; ++s) {
                f32x4 sacc[4];
#pragma unroll
                for (int t = 0; t < 4; ++t) { const LAS unsigned char* rp = Kt + (16 * t + fr) * 256;
                    if (AV(4)) { sacc[t] = (f32x4){0.f, 0.f, 0.f, 0.f}; continue; }
                    { const bf16x8 kf = *(const LAS bf16x8*)(rp + ((((KSPLIT ? 8 * s : 0) + fq) ^ fr) << 4)); sacc[t] = __builtin_amdgcn_mfma_f32_16x16x32_bf16(kf, qf[s][0], (f32x4){0.f, 0.f, 0.f, 0.f}, 0, 0, 0); }
#pragma unroll
                    for (int ks = 1; ks < NKS; ++ks) { const bf16x8 kf = *(const LAS bf16x8*)(rp + ((((KSPLIT ? 8 * s : 0) + 4 * ks + fq) ^ fr) << 4));
                        sacc[t] = __builtin_amdgcn_mfma_f32_16x16x32_bf16(kf, qf[s][ks], sacc[t], 0, 0, 0); } }
                if (!AV(1)) {
                if (MODE == 1) { const unsigned lo = (unsigned)mbits, hi = (unsigned)(mbits >> 32); unsigned nib[4];
                    nib[0] = (lo & 0xffffu) >> (4 * fq); nib[1] = (lo >> 16) >> (4 * fq); nib[2] = (hi & 0xffffu) >> (4 * fq); nib[3] = (hi >> 16) >> (4 * fq);
#pragma unroll
                    for (int t = 0; t < 4; ++t)
#pragma unroll
                        for (int i = 0; i < 4; ++i) sacc[t][i] = ((nib[t] >> i) & 1u) ? sacc[t][i] : NEG_INF; }
                if (MODE != 2) { if (near) {
                    const LAS float* bt = btab + a.bhead[s] * 128; const int dist0 = a.qpos - key0 - 4 * fq;
                    float bia[4][4];
#pragma unroll
                    for (int t = 0; t < 4; ++t)
#pragma unroll
                        for (int i = 0; i < 4; ++i) { const int dist = dist0 - 16 * t - i; const int di = dist < 0 ? 0 : (dist > 127 ? 127 : dist); bia[t][i] = bt[di]; }
#pragma unroll
                    for (int t = 0; t < 4; ++t)
#pragma unroll
                        for (int i = 0; i < 4; ++i) { float x = sacc[t][i] + bia[t][i]; if (MODE == 0) x = (dist0 - 16 * t - i < 0) ? NEG_INF : x; sacc[t][i] = x; }
                } }
                float rmax = fmaxf(fmaxf(__builtin_fmaxf(sacc[0][0], sacc[0][1]), fmaxf(sacc[0][2], sacc[0][3])), fmaxf(fmaxf(sacc[1][0], sacc[1][1]), fmaxf(sacc[1][2], sacc[1][3])));
                rmax = fmaxf(rmax, fmaxf(fmaxf(fmaxf(sacc[2][0], sacc[2][1]), fmaxf(sacc[2][2], sacc[2][3])), fmaxf(fmaxf(sacc[3][0], sacc[3][1]), fmaxf(sacc[3][2], sacc[3][3]))));
                rmax = fmaxf(rmax, SHX(rmax, 16)); rmax = fmaxf(rmax, SHX(rmax, 32));
                if (__any(rmax > mrun[s] + 8.0f)) {
                    const float mn = fmaxf(mrun[s], rmax); const float alpha = (mn == NEG_INF) ? 1.0f : __builtin_amdgcn_exp2f(mrun[s] - mn); mrun[s] = mn;
#pragma unroll
                    for (int dt = 0; dt < 8; ++dt) O[s][dt] *= alpha;
                    lacc[s] *= alpha;
                }
                const float mu = (mrun[s] == NEG_INF) ? 0.f : mrun[s];
                float psum = 0.f;
#pragma unroll
                for (int t = 0; t < 4; ++t)
#pragma unroll
                    for (int i = 0; i < 4; ++i) { sacc[t][i] = __builtin_amdgcn_exp2f(sacc[t][i] - mu); if (!MROW) psum += sacc[t][i]; }
                if (!MROW) lacc[s][0] += psum;
                }
#pragma unroll
                for (int s2 = 0; s2 < 2; ++s2) { u32x4 w; w.x = cvt_pk_bf16(sacc[2 * s2][0], sacc[2 * s2][1]); w.y = cvt_pk_bf16(sacc[2 * s2][2], sacc[2 * s2][3]);
                    w.z = cvt_pk_bf16(sacc[2 * s2 + 1][0], sacc[2 * s2 + 1][1]); w.w = cvt_pk_bf16(sacc[2 * s2 + 1][2], sacc[2 * s2 + 1][3]); pf[s][s2] = __builtin_bit_cast(bf16x8, w); }
                if (!AV(2) && MROW)
#pragma unroll
                for (int s2 = 0; s2 < 2; ++s2) lacc[s] = __builtin_amdgcn_mfma_f32_16x16x32_bf16(ones, pf[s][s2], lacc[s], 0, 0, 0);
            }
            if (!AV(2))
#pragma unroll
            for (int dt = 0; dt < 8; ++dt) { const int row = 16 * dt + fr; const LAS unsigned char* rp = Vt + row * 128 + 8 * (fq & 1); const int sw = (row >> 1) & 7;
#pragma unroll
                for (int s2 = 0; s2 < 2; ++s2) {
                    const u32x2 va = *(const volatile LAS u32x2*)(rp + (((4 * s2 + (fq >> 1)) ^ sw) << 4)), vb = *(const volatile LAS u32x2*)(rp + (((4 * s2 + 2 + (fq >> 1)) ^ sw) << 4));
                    u32x4 w; w.x = va.x; w.y = va.y; w.z = vb.x; w.w = vb.y; const bf16x8 vf = __builtin_bit_cast(bf16x8, w);
#pragma unroll
                    for (int s = 0; s < NS; ++s) O[s][dt] = __builtin_amdgcn_mfma_f32_16x16x32_bf16(vf, pf[s][s2], O[s][dt], 0, 0, 0); } }
        }
    }
    __syncthreads();
#undef ATT_STAGE
#pragma unroll
    for (int s = 0; s < NS; ++s) { lsum[s] = lacc[s][0]; if (!MROW) { lsum[s] += SHX(lsum[s], 16); lsum[s] += SHX(lsum[s], 32); } }
}
__device__ __forceinline__ void load_btab(const Params& p, LAS float* bt) {
    unsigned char* const wsl = fresh_ptr(p.ws);
    const float* src = (const float*)(wsl + WS_CTL + CTL_BTAB);
    const int tidb = fresh_tid();
    for (int e = tidb; e < 1024; e += 512) bt[e] = src[e];
    __syncthreads();
}
__device__ __forceinline__ void attnA_phase(const Params& p, LAS unsigned char* lds, int l, int var) {
    unsigned char* const wsl = fresh_ptr(p.ws);
    LAS float* bt = (LAS float*)(lds + 98304);
    load_btab(p, bt);
    const bf16_t* H = (const bf16_t*)(wsl + WS_R + R_H); const bf16_t* VT = (const bf16_t*)(wsl + WS_R + R_VT); bf16_t* YA = (bf16_t*)(wsl + WS_YA);
    const float* lamv = (const float*)(wsl + WS_CTL + CTL_LAM); const float lam = lamv[l * 2], lam_init = lamv[l * 2 + 1];
    const float* subln = p.in[I_SUBLN] + l * 128;
    const int tid = fresh_tid(); const int lane = tid & 63, wv = __builtin_amdgcn_readfirstlane(tid >> 6), fr = lane & 15, fq = lane >> 4;
    for (int vb = blockIdx.x; vb < 256; vb += gridDim.x) for (int it = 0; it < 4; ++it) {
        const int xg = vb & 7, sl = vb >> 3;
        const int bh = xg * 8 + (it >> 1) * 4 + (sl >> 3), j = sl & 7; const int qt = (it & 1) ? 15 - j : j;
        const int b = bh >> 2, h = bh & 3;
        AttnArgs a;
        const int qpos_w0 = qt * 128 + wv * 16;
        a.Q = H; a.ldq = HN; a.qcol[0] = HC_QA + h * 128; a.qcol[1] = HC_QA + h * 128 + 64; a.qtok = (size_t)b * SEQ + qpos_w0 + fr; a.qgain = p.in[I_AQG] + l * 64; a.qscale = 0.125f * LOG2E;
        a.K = H; a.ldk = HN; a.krow0 = (size_t)b * SEQ; a.kcol0 = HC_KA + h * 128;
        a.V = VT; a.ldv = T_TOK; a.vrow0 = h * 128; a.vcol0 = (size_t)b * SEQ;
        a.nkt_blk = 2 * qt + 2; a.my_nkt = ((qpos_w0 + 15) >> 6) + 1; a.qpos = qpos_w0 + fr; a.qpos_w0 = qpos_w0; a.bhead[0] = h; a.bhead[1] = h; a.maskrow = nullptr; a.var = var;
        f32x4 O[2][8]; float ls[2];
        attn_core<2, 64, true, 0>(lds, bt, a, O, ls);
        const float i1 = 1.0f / ls[0], i2 = lam / ls[1]; float ss = 0.f;
#pragma unroll
        for (int dt = 0; dt < 8; ++dt)
#pragma unroll
            for (int i = 0; i < 4; ++i) { const float v = O[0][dt][i] * i1 - O[1][dt][i] * i2; O[0][dt][i] = v; ss += v * v; }
        ss += SHX(ss, 16); ss += SHX(ss, 32);
        const float sc = rsqrtf(ss * (1.0f / 128.0f) + EPSF) * (1.0f - lam_init);
        bf16_t* dst = YA + a.qtok * 512 + h * 128 + 4 * fq;
#pragma unroll
        for (int dt = 0; dt < 8; ++dt) { const f32x4 g = *(const f32x4*)(subln + 16 * dt + 4 * fq); u32x2 w; w.x = cvt_pk_bf16(O[0][dt][0] * sc * g[0], O[0][dt][1] * sc * g[1]); w.y = cvt_pk_bf16(O[0][dt][2] * sc * g[2], O[0][dt][3] * sc * g[3]);
            *(u32x2*)(dst + 16 * dt) = w; }
    }
}
__device__ __forceinline__ void attnC_phase(const Params& p, LAS unsigned char* lds, int l, int var) {
    unsigned char* const wsl = fresh_ptr(p.ws);
    LAS float* bt = (LAS float*)(lds + 98304);
    load_btab(p, bt);
    const bf16_t* H = (const bf16_t*)(wsl + WS_R + R_H); const bf16_t* VT = (const bf16_t*)(wsl + WS_R + R_VT); bf16_t* YC = (bf16_t*)(wsl + WS_YC);
    const unsigned short* mask = (const unsigned short*)(wsl + WS_MASK);
    const int tid = fresh_tid(); const int lane = tid & 63, wv = __builtin_amdgcn_readfirstlane(tid >> 6), fr = lane & 15, fq = lane >> 4;
    const int qs = wv & 3, hp = wv >> 2;
    for (int vb = blockIdx.x; vb < 256; vb += gridDim.x) for (int it = 0; it < 2; ++it) {
        const int xg = vb & 7, sl = vb >> 3;
        const int b = xg * 2 + (sl >> 4), j = sl & 15; const int qt = (it == 0) ? j : 31 - j;
        AttnArgs a;
        const int qpos_w0 = qt * 64 + qs * 16;
        a.Q = H; a.ldq = HN; a.qcol[0] = HC_CQ + (2 * hp) * 128; a.qcol[1] = HC_CQ + (2 * hp + 1) * 128; a.qtok = (size_t)b * SEQ + qpos_w0 + fr; a.qgain = p.in[I_CQG] + l * 128; a.qscale = 0.08838834764831845f * LOG2E;
        a.K = H; a.ldk = HN; a.krow0 = (size_t)b * SEQ; a.kcol0 = HC_CK;
        a.V = VT; a.ldv = T_TOK; a.vrow0 = 512; a.vcol0 = (size_t)b * SEQ;
        a.nkt_blk = qt + 1; a.my_nkt = qt + 1; a.qpos = qpos_w0 + fr; a.qpos_w0 = qpos_w0; a.bhead[0] = 4 + 2 * hp; a.bhead[1] = 5 + 2 * hp; a.maskrow = mask + a.qtok * 128; a.var = var;
        f32x4 O[2][8]; float ls[2];
        attn_core<2, 128, false, 1>(lds, bt, a, O, ls);
#pragma unroll
        for (int s = 0; s < 2; ++s) { const float inv = 1.0f / ls[s]; bf16_t* dst = YC + a.qtok * 512 + (2 * hp + s) * 128 + 4 * fq;
#pragma unroll
            for (int dt = 0; dt < 8; ++dt) { u32x2 w; w.x = cvt_pk_bf16(O[s][dt][0] * inv, O[s][dt][1] * inv); w.y = cvt_pk_bf16(O[s][dt][2] * inv, O[s][dt][3] * inv); *(u32x2*)(dst + 16 * dt) = w; } }
    }
}
__device__ __forceinline__ void attnX_phase(const Params& p, LAS unsigned char* lds, int l) {
    unsigned char* const wsl = fresh_ptr(p.ws);
    const int var = 0;
    const bf16_t* QX = (const bf16_t*)(wsl + WS_YA); const bf16_t* MK = (const bf16_t*)(wsl + WS_MK); const bf16_t* MVT = (const bf16_t*)(wsl + WS_MVT); bf16_t* OX = (bf16_t*)(wsl + WS_YB);
    const int tid = fresh_tid(); const int lane = tid & 63, wv = __builtin_amdgcn_readfirstlane(tid >> 6), fr = lane & 15, fq = lane >> 4;
    for (int unit = blockIdx.x; unit < 1024; unit += gridDim.x) {
        const int b = unit >> 6, h = (unit >> 4) & 3, qt = unit & 15;
        AttnArgs a;
        const int qpos_w0 = qt * 128 + wv * 16;
        a.Q = QX; a.ldq = 512; a.qcol[0] = h * 128; a.qcol[1] = h * 128; a.qtok = (size_t)b * SEQ + qpos_w0 + fr; a.qgain = p.in[I_MQG] + l * 128; a.qscale = 0.08838834764831845f * LOG2E;
        a.K = MK; a.ldk = 512; a.krow0 = (size_t)b * MEMLEN; a.kcol0 = h * 128;
        a.V = MVT; a.ldv = NB * MEMLEN; a.vrow0 = h * 128; a.vcol0 = (size_t)b * MEMLEN;
        a.nkt_blk = 4; a.my_nkt = 4; a.qpos = 0; a.qpos_w0 = 0; a.bhead[0] = 0; a.bhead[1] = 0; a.maskrow = nullptr; a.var = var;
        f32x4 O[1][8]; float ls[1];
        attn_core<1, 128, false, 2>(lds, nullptr, a, O, ls);
        const float inv = 1.0f / ls[0]; bf16_t* dst = OX + a.qtok * 512 + h * 128 + 4 * fq;
#pragma unroll
        for (int dt = 0; dt < 8; ++dt) { u32x2 w; w.x = cvt_pk_bf16(O[0][dt][0] * inv, O[0][dt][1] * inv); w.y = cvt_pk_bf16(O[0][dt][2] * inv, O[0][dt][3] * inv); *(u32x2*)(dst + 16 * dt) = w; }
    }
}

__device__ __forceinline__ unsigned dpp_sum_u32(unsigned x) {
    x += (unsigned)__builtin_amdgcn_update_dpp(0, (int)x, 0xB1, 0xF, 0xF, true); x += (unsigned)__builtin_amdgcn_update_dpp(0, (int)x, 0x4E, 0xF, 0xF, true);
    x += (unsigned)__builtin_amdgcn_update_dpp(0, (int)x, 0x141, 0xF, 0xF, true); x += (unsigned)__builtin_amdgcn_update_dpp(0, (int)x, 0x140, 0xF, 0xF, true);
    { auto r = __builtin_amdgcn_permlane16_swap(x, x, false, false); x = r[0] + r[1]; } { auto r = __builtin_amdgcn_permlane32_swap(x, x, false, false); x = r[0] + r[1]; }
    return x;
}
__device__ __forceinline__ unsigned umaxu(unsigned a, unsigned b) { return a > b ? a : b; }
__device__ __forceinline__ unsigned uminu(unsigned a, unsigned b) { return a < b ? a : b; }
__device__ __forceinline__ unsigned dpp_max_u32(unsigned x) {
    x = umaxu(x, (unsigned)__builtin_amdgcn_update_dpp(0, (int)x, 0xB1, 0xF, 0xF, true)); x = umaxu(x, (unsigned)__builtin_amdgcn_update_dpp(0, (int)x, 0x4E, 0xF, 0xF, true));
    x = umaxu(x, (unsigned)__builtin_amdgcn_update_dpp(0, (int)x, 0x141, 0xF, 0xF, true)); x = umaxu(x, (unsigned)__builtin_amdgcn_update_dpp(0, (int)x, 0x140, 0xF, 0xF, true));
    { auto r = __builtin_amdgcn_permlane16_swap(x, x, false, false); x = umaxu(r[0], r[1]); } { auto r = __builtin_amdgcn_permlane32_swap(x, x, false, false); x = umaxu(r[0], r[1]); }
    return x;
}
__device__ __forceinline__ float key2f_full(unsigned k) { return __uint_as_float((k & 0x80000000u) ? (k & 0x7fffffffu) : ~k); }
__device__ __forceinline__ void csel_phase(const Params& p, LAS unsigned char* lds, int var) {
    unsigned char* const wsl = fresh_ptr(p.ws);
#ifdef ATT_PROBE
#define CV(bit) (var & (bit))
#else
#define CV(bit) 0
#endif
    const bf16_t* H = (const bf16_t*)(wsl + WS_R + R_H); unsigned short* mask = (unsigned short*)(wsl + WS_MASK);
    constexpr int SC_ROW = 8208;
    const int tid = fresh_tid(); const int lane = tid & 63, wv = __builtin_amdgcn_readfirstlane(tid >> 6), fr = lane & 15, fq = lane >> 4;
    for (int c = blockIdx.x; c < 256; c += gridDim.x) {
        const int b = c >> 4, j = c & 15;
        for (int it = 0; it < 8; ++it) {
            const int i = (it & 1) ? (32 * (it >> 1) + 31 - j) : (32 * (it >> 1) + j);
            if (!CV(1)) {
                const size_t qtok = (size_t)b * SEQ + 16 * i + fr;
                bf16x8 bq[8][2]; float wq[8];
#pragma unroll
                for (int h = 0; h < 8; ++h)
#pragma unroll
                    for (int ks = 0; ks < 2; ++ks) bq[h][ks] = *(const bf16x8*)(H + qtok * HN + HC_IQ + h * 64 + 32 * ks + 8 * fq);
                { const u32x4 w = *(const u32x4*)(H + qtok * HN + HC_IW); wq[0] = bf_lo(w.x); wq[1] = bf_hi(w.x); wq[2] = bf_lo(w.y); wq[3] = bf_hi(w.y); wq[4] = bf_lo(w.z); wq[5] = bf_hi(w.z); wq[6] = bf_lo(w.w); wq[7] = bf_hi(w.w); }
                const bf16_t* kbase = H + ((size_t)b * SEQ + fr) * HN + HC_IK + 8 * fq;
                bf16x8 ka0, ka1; ka0 = ka1 = (bf16x8){0, 0, 0, 0, 0, 0, 0, 0};
                if (wv <= i) { const bf16_t* kp = kbase + (size_t)(16 * wv) * HN; ka0 = *(const bf16x8*)kp; ka1 = *(const bf16x8*)(kp + 32); }
                for (int st = wv; st <= i; st += 8) {
                    bf16x8 na0 = ka0, na1 = ka1;
                    if (st + 8 <= i) { const bf16_t* kp = kbase + (size_t)(16 * (st + 8)) * HN; na0 = *(const bf16x8*)kp; na1 = *(const bf16x8*)(kp + 32); }
                    f32x4 sc = (f32x4){0.f, 0.f, 0.f, 0.f};
#pragma unroll
                    for (int h = 0; h < 8; ++h) { f32x4 acc = __builtin_amdgcn_mfma_f32_16x16x32_bf16(ka0, bq[h][0], (f32x4){0.f, 0.f, 0.f, 0.f}, 0, 0, 0); acc = __builtin_amdgcn_mfma_f32_16x16x32_bf16(ka1, bq[h][1], acc, 0, 0, 0);
#pragma unroll
                        for (int k = 0; k < 4; ++k) sc[k] = __builtin_fmaf(fmaxf(acc[k], 0.f), wq[h], sc[k]); }
                    *(LAS f32x4*)(lds + fr * SC_ROW + (16 * st + 4 * fq) * 4) = sc;
                    ka0 = na0; ka1 = na1;
                }
            }
            __syncthreads();
#pragma unroll 1
            for (int qq = 0; qq < 2; ++qq) {
                const int q = 2 * wv + qq, qpos = 16 * i + q; const size_t tok = (size_t)b * SEQ + qpos;
                float u[8][4];
#pragma unroll
                for (int j2 = 0; j2 < 8; ++j2) { const f32x4 v = *(const LAS f32x4*)(lds + q * SC_ROW + (j2 * 256 + 4 * lane) * 4);
#pragma unroll
                    for (int k = 0; k < 4; ++k) u[j2][k] = (j2 * 256 + 4 * lane + k <= qpos) ? v[k] : NEG_INF; }
                int B1 = 256, B2 = 256; float vmx = 0.f, Sc = 0.f;
                if (qpos >= 256 && !CV(2)) {
                    float mx = NEG_INF, mnv = -NEG_INF;
#pragma unroll
                    for (int j2 = 0; j2 < 8; ++j2)
#pragma unroll
                        for (int k = 0; k < 4; ++k) { mx = fmaxf(mx, u[j2][k]); mnv = fminf(mnv, (u[j2][k] == NEG_INF) ? -NEG_INF : u[j2][k]); }
                    mx = key2f_full(dpp_max_u32(ukey(mx))); mnv = key2f_full(~dpp_max_u32(~ukey(mnv)));
                    vmx = mx; Sc = 255.99f / fmaxf(mx - mnv, 1e-20f);
                    LAS unsigned* hist = (LAS unsigned*)(lds + 131584 + wv * 1024);
                    unsigned need = 256u;
#pragma unroll 1
                    for (int lvl = 0; lvl < 2; ++lvl) {
                        *(LAS u32x4*)(hist + 4 * lane) = (u32x4){0u, 0u, 0u, 0u};
#pragma unroll
                        for (int j2 = 0; j2 < 8; ++j2)
#pragma unroll
                            for (int k = 0; k < 4; ++k) { const float v = u[j2][k];
                                if (v != NEG_INF) { const float t = (vmx - v) * Sc; int bn = (int)t; bn = bn > 255 ? 255 : bn;
                                    if (lvl == 0) (void)__hip_atomic_fetch_add(hist + bn, 1u, __ATOMIC_RELAXED, __HIP_MEMORY_SCOPE_WORKGROUP);
                                    else if (bn == B1) { int sb = (int)((t - (float)B1) * 256.0f); sb = sb > 255 ? 255 : (sb < 0 ? 0 : sb); (void)__hip_atomic_fetch_add(hist + sb, 1u, __ATOMIC_RELAXED, __HIP_MEMORY_SCOPE_WORKGROUP); } } }
                        const u32x4 h4 = *(const LAS u32x4*)(hist + 4 * lane);
                        const unsigned s4 = h4.x + h4.y + h4.z + h4.w; unsigned pre = s4;
#pragma unroll
                        for (int dd = 1; dd < 64; dd <<= 1) { const unsigned tt = (unsigned)__builtin_amdgcn_ds_bpermute(((lane - dd) & 63) << 2, (int)pre); if (lane >= dd) pre += tt; }
                        const unsigned long long bal = __ballot(pre >= need);
                        const int L = bal ? (int)__builtin_ctzll(bal) : 63;
                        unsigned c = (unsigned)__builtin_amdgcn_readlane((int)(pre - s4), L);
                        const unsigned hx = (unsigned)__builtin_amdgcn_readlane((int)h4.x, L), hy = (unsigned)__builtin_amdgcn_readlane((int)h4.y, L), hz = (unsigned)__builtin_amdgcn_readlane((int)h4.z, L);
                        int Bsel = 4 * L + 3;
                        if (c + hx >= need) Bsel = 4 * L; else { c += hx; if (c + hy >= need) Bsel = 4 * L + 1; else { c += hy; if (c + hz >= need) Bsel = 4 * L + 2; else c += hz; } }
                        if (lvl == 0) { B1 = Bsel; need -= c; } else B2 = Bsel;
                    }
                }
                if (!CV(4))
#pragma unroll
                for (int j2 = 0; j2 < 8; ++j2) {
                    const int st = j2 * 16 + (lane >> 2);
                    unsigned nib = 0u;
#pragma unroll
                    for (int k = 0; k < 4; ++k) { const float v = u[j2][k]; bool sel = (v != NEG_INF);
                        if (sel && B1 < 256) { const float t = (vmx - v) * Sc; int bn = (int)t; bn = bn > 255 ? 255 : bn;
                            if (bn > B1) sel = false; else if (bn == B1) { int sb = (int)((t - (float)B1) * 256.0f); sb = sb > 255 ? 255 : (sb < 0 ? 0 : sb); sel = (sb <= B2); } }
                        if (sel) nib |= (1u << k); }
                    unsigned wd = nib << (4 * (lane & 3));
                    wd |= (unsigned)__builtin_amdgcn_update_dpp(0, (int)wd, 0xB1, 0xF, 0xF, true); wd |= (unsigned)__builtin_amdgcn_update_dpp(0, (int)wd, 0x4E, 0xF, 0xF, true);
                    if ((lane & 3) == 0 && st <= (i | 3)) mask[tok * 128 + st] = (unsigned short)wd;
                }
            }
            __syncthreads();
        }
    }
}
__device__ __forceinline__ void ins16(unsigned (&L)[16], unsigned x) {
#pragma unroll
    for (int j = 0; j < 16; ++j) { const unsigned hi = L[j] > x ? L[j] : x; x = L[j] > x ? x : L[j]; L[j] = hi; }
}
__device__ __forceinline__ float key2f(unsigned k) { return __uint_as_float((k & 0x80000000u) ? (k & 0x7fffffffu) : ~k); }
__device__ __forceinline__ void top16_of_128(const float* sp, unsigned (&L)[16]) {
#pragma unroll
    for (int j = 0; j < 16; ++j) L[j] = 0u;
    for (int c = 0; c < 4; ++c) {
        f32x4 v[8];
#pragma unroll
        for (int q = 0; q < 8; ++q) v[q] = *(const f32x4*)(sp + c * 32 + q * 4);
#pragma unroll
        for (int q = 0; q < 8; ++q)
#pragma unroll
            for (int i = 0; i < 4; ++i) ins16(L, (ukey(v[q][i]) & ~127u) | (unsigned)(127 - (c * 32 + q * 4 + i)));
    }
}
__device__ __forceinline__ void peer_topk_phase(const Params& p, LAS unsigned char* lds) {
    unsigned char* const wsl = fresh_ptr(p.ws);
    const float* PS = (const float*)(wsl + WS_R + R_PS); int* EIDX = (int*)(wsl + WS_YC); float* EGATE = (float*)(wsl + WS_YC + 16 * MiB);
    const int tid = fresh_tid();
    for (int item = blockIdx.x * 512 + tid; item < T_TOK * 8; item += gridDim.x * 512) {
        const int tok = item >> 3, h = item & 7;
        const float* sp = PS + (size_t)tok * 2048 + h * 256;
        unsigned L1[16], L2[16], L3[16];
        top16_of_128(sp, L1);
        top16_of_128(sp + 128, L2);
        float v1[16], v2[16];
#pragma unroll
        for (int j = 0; j < 16; ++j) { v1[j] = key2f(L1[j] & ~127u); v2[j] = key2f(L2[j] & ~127u); L3[j] = 0u; }
#pragma unroll
        for (int a = 0; a < 16; ++a)
#pragma unroll
            for (int b = 0; b < 16; ++b) if ((a + 1) * (b + 1) <= 16) ins16(L3, (ukey(v1[a] + v2[b]) & ~255u) | (unsigned)(255 - (a * 16 + b)));
        int eo[16]; float go[16]; float gsum = 0.f; const float cmax = key2f(L3[0] & ~255u);
#pragma unroll
        for (int i = 0; i < 16; ++i) { const int code = 255 - (int)(L3[i] & 255u); const int a = code >> 4, b = code & 15; int e1 = 0, e2 = 0;
#pragma unroll
            for (int j = 0; j < 16; ++j) { e1 = (a == j) ? (int)(L1[j] & 127u) : e1; e2 = (b == j) ? (int)(L2[j] & 127u) : e2; }
            eo[i] = (127 - e1) * 128 + (127 - e2); go[i] = __expf(key2f(L3[i] & ~255u) - cmax); gsum += go[i]; }
        const float ginv = 1.0f / gsum;
        int* ep = EIDX + (size_t)tok * 128 + h * 16; float* gp = EGATE + (size_t)tok * 128 + h * 16;
#pragma unroll
        for (int q = 0; q < 4; ++q) { *(u32x4*)(ep + 4 * q) = (u32x4){(unsigned)eo[4 * q], (unsigned)eo[4 * q + 1], (unsigned)eo[4 * q + 2], (unsigned)eo[4 * q + 3]};
            *(f32x4*)(gp + 4 * q) = (f32x4){go[4 * q] * ginv, go[4 * q + 1] * ginv, go[4 * q + 2] * ginv, go[4 * q + 3] * ginv}; }
    }
}
constexpr size_t PE_US = 0, PE_VS = 8 * MiB, PE_USC = 16 * MiB, PE_VSC = 17 * MiB;
__device__ __forceinline__ u32x4 pack_fp4_32(const f32x4 (&v)[8], float isc) {
    unsigned w[4];
#pragma unroll
    for (int d = 0; d < 4; ++d) { unsigned t = 0u;
        t = __builtin_amdgcn_cvt_scalef32_pk_fp4_f32(t, v[2 * d][0] * isc, v[2 * d][1] * isc, 1.0f, 0); t = __builtin_amdgcn_cvt_scalef32_pk_fp4_f32(t, v[2 * d][2] * isc, v[2 * d][3] * isc, 1.0f, 1);
        t = __builtin_amdgcn_cvt_scalef32_pk_fp4_f32(t, v[2 * d + 1][0] * isc, v[2 * d + 1][1] * isc, 1.0f, 2); t = __builtin_amdgcn_cvt_scalef32_pk_fp4_f32(t, v[2 * d + 1][2] * isc, v[2 * d + 1][3] * isc, 1.0f, 3);
        w[d] = t; }
    return (u32x4){w[0], w[1], w[2], w[3]};
}
__device__ __forceinline__ float fp4_block_scale(const f32x4 (&v)[8]) {
    float am = 0.f;
#pragma unroll
    for (int q = 0; q < 8; ++q) am = fmaxf(am, fmaxf(fmaxf(fabsf(v[q][0]), fabsf(v[q][1])), fmaxf(fabsf(v[q][2]), fabsf(v[q][3]))));
    am = fmaxf(am, 1e-30f);
    const int eb = (int)((__float_as_uint(am) >> 23) & 0xffu);
    float sc = __uint_as_float((unsigned)(eb - 2) << 23);
    if (am > 6.0f * sc) sc *= 2.0f;
    return sc;
}
__device__ __forceinline__ void conv_peer_tables(const float* pu, const float* pv, unsigned char* dst) {
    const int tid = fresh_tid(); const int lane = tid & 63, hl = lane & 31, gw = blockIdx.x * 8 + (tid >> 6), nw = gridDim.x * 8;
    const int q = hl >> 3, c = hl & 7;
    for (int r2 = gw; r2 < 8192; r2 += nw) {
        const int e = 2 * r2 + (lane >> 5);
        f32x4 a[8], b[8];
#pragma unroll
        for (int k = 0; k < 8; ++k) { a[k] = *(const f32x4*)(pu + (size_t)e * 1024 + 32 * hl + 4 * k); b[k] = *(const f32x4*)(pv + (size_t)e * 1024 + 32 * hl + 4 * k); }
        const float su = fp4_block_scale(a), sv = fp4_block_scale(b);
        const size_t row = (size_t)q * 16384 + e;
        *(u32x4*)(dst + PE_US + row * 128 + 16 * c) = pack_fp4_32(a, 1.0f / su);
        *(u32x4*)(dst + PE_VS + row * 128 + 16 * c) = pack_fp4_32(b, 1.0f / sv);
        dst[PE_USC + row * 16 + 2 * (c & 3) + (c >> 2)] = (unsigned char)((__float_as_uint(su) >> 23) & 0xffu);
        dst[PE_VSC + row * 8 + c] = (unsigned char)((__float_as_uint(sv) >> 23) & 0xffu);
    }
}
typedef float f32x2g __attribute__((ext_vector_type(2)));
typedef int v8i_t __attribute__((ext_vector_type(8)));
typedef int v4i_u __attribute__((ext_vector_type(4)));
#define FP4X2(w, b) __builtin_amdgcn_cvt_scalef32_pk_f32_fp4((w), 1.0f, (b))
__device__ __forceinline__ void peer_slice_map(const Params& p, LAS unsigned char* lds, int& q, int& half, int& bx, int& nbx) {
    LAS int* sm = (LAS int*)(lds + LDS_BAR_OFF - 32);
    __syncthreads();
    if (threadIdx.x == 0) {
        unsigned* barw = (unsigned*)(fresh_ptr(p.ws) + WS_CTL);
        const unsigned x = xb_xcc_id(); bool hw = x < 8u; unsigned mine = 0u;
        for (unsigned jx = 0; jx < 16; ++jx) { const unsigned cn = xb_ld(&barw[XB_XCNT(jx)]); if (jx < 8u) hw = hw && (cn > 0u); else hw = hw && (cn == 0u); if (jx == x) mine = cn; }
        const unsigned rk = ((volatile LAS unsigned*)(lds + LDS_BAR_OFF))[2];
        hw = hw && rk >= 1u && rk <= mine;
#if MK_MULTI || defined(MPROBE) || defined(PROBE_CHK) || defined(PROBE_DET) || defined(PROBE_K) || defined(NO_HW_MAP)
        hw = false;
#endif
        const int xcd = hw ? (int)x : (int)(blockIdx.x & 7);
        sm[0] = xcd & 3; sm[1] = xcd >> 2; sm[2] = hw ? (int)(rk - 1u) : (int)(blockIdx.x >> 3); sm[3] = hw ? (int)mine : (int)((gridDim.x + 7 - xcd) >> 3);
    }
    __syncthreads();
    q = sm[0]; half = sm[1]; bx = sm[2]; nbx = sm[3];
    __syncthreads();
}
__device__ __forceinline__ void peer_udot_phase(const Params& p, LAS unsigned char* lds, int var) {
    (void)var;
#ifdef ATT_PROBE
#define PUV(bit) (var & (bit))
#else
#define PUV(bit) 0
#endif
    unsigned char* const wsl = fresh_ptr(p.ws);
    const bf16_t* XN = (const bf16_t*)(wsl + WS_XN); const int* EIDX = (const int*)(wsl + WS_YC); bf16_t* PZ = (bf16_t*)(wsl + WS_R);
    const int tid = fresh_tid(); const int lane = tid & 63, wv = __builtin_amdgcn_readfirstlane(tid >> 6), fr = lane & 15, fq = lane >> 4;
    int q, half, bx, nbx; peer_slice_map(p, lds, q, half, bx, nbx);
    const unsigned char* US = wsl + WS_YA + PE_US + (size_t)q * 16384 * 128; const unsigned char* USC = wsl + WS_YA + PE_USC + (size_t)q * 16384 * 16;
    LAS unsigned* eid = (LAS unsigned*)(lds + wv * 512);
    LAS unsigned char* xb = lds + 4096 + wv * 512;
    LAS unsigned char* usl = lds + 8192 + wv * 2048;
    LAS unsigned char* ub = lds + 24576 + wv * 16384;
    const int stride = nbx * 8, tlim = T_TOK / 2;
    int ti = bx * 8 + wv;
    if (ti >= tlim) return;
    unsigned idr[16], es0, es1;
#define PU_IDS() { _Pragma("unroll") for (int i = 0; i < 16; ++i) idr[i] = eid[8 * i + (lane >> 3)]; es0 = eid[lane]; es1 = eid[64 + lane]; asm volatile("s_waitcnt lgkmcnt(0)" ::: "memory"); }
#define PU_ROWS(i0) { _Pragma("unroll") for (int i = (i0); i < (i0) + 8; ++i) { const int k = 8 * i + (lane >> 3); \
        const unsigned char* src = US + (unsigned)(idr[i] * 128u + 16u * (unsigned)((lane & 7) ^ ((k >> 1) & 7)));     \
        __builtin_amdgcn_global_load_lds((const unsigned*)src, (LAS unsigned*)(ub + i * 1024), 16, 0, 0); } }
#define PU_SMALL(tx, te) if (!PUV(32)) { \
        __builtin_amdgcn_global_load_lds((const unsigned*)(USC + (unsigned)(es0 * 16u)), (LAS unsigned*)usl, 16, 0, 0); __builtin_amdgcn_global_load_lds((const unsigned*)(USC + (unsigned)(es1 * 16u)), (LAS unsigned*)(usl + 1024), 16, 0, 0); \
        if (lane < 32) { __builtin_amdgcn_global_load_lds((const unsigned*)(XN + (size_t)(tx) * 1024 + 256 * q) + 4 * lane, (LAS unsigned*)xb, 16, 0, 0); }          \
        if (lane < 32) { __builtin_amdgcn_global_load_lds((const unsigned*)(EIDX + (size_t)(te) * 128) + 4 * lane, eid, 16, 0, 0); } }
    {   const int tok0 = half * tlim + ti, tn = (ti + stride < tlim) ? tok0 + stride : tok0;
        eid[lane] = (unsigned)EIDX[(size_t)tok0 * 128 + lane]; eid[64 + lane] = (unsigned)EIDX[(size_t)tok0 * 128 + 64 + lane];
        PU_IDS()
        PU_ROWS(0) PU_SMALL(tok0, tn) PU_ROWS(8) }
    bool first = true;
    for (; ti < tlim; ti += stride) {
        const int tok = half * tlim + ti;
        if (first) asm volatile("s_waitcnt vmcnt(8)" ::: "memory"); else asm volatile("s_waitcnt vmcnt(9)" ::: "memory");
        first = false;
        v8i_t xq[2];
#pragma unroll
        for (int k = 0; k < 8; ++k) { const u32x4 w = *(const LAS u32x4*)(xb + 2 * (128 * (k >> 2) + 16 * fq + 64 * ((k >> 1) & 1) + 8 * (k & 1))); unsigned d0 = 0u, d1 = 0u;
            d0 = __builtin_amdgcn_cvt_pk_fp8_f32(bf_lo(w.x), bf_hi(w.x), d0, false); d0 = __builtin_amdgcn_cvt_pk_fp8_f32(bf_lo(w.y), bf_hi(w.y), d0, true);
            d1 = __builtin_amdgcn_cvt_pk_fp8_f32(bf_lo(w.z), bf_hi(w.z), d1, false); d1 = __builtin_amdgcn_cvt_pk_fp8_f32(bf_lo(w.w), bf_hi(w.w), d1, true);
            xq[k >> 2][2 * (k & 3)] = (int)d0; xq[k >> 2][2 * (k & 3) + 1] = (int)d1; }
        unsigned usc[8]; u32x4 a0[4], a1[4];
#pragma unroll
        for (int b = 0; b < 8; ++b) usc[b] = *(const LAS unsigned short*)(usl + 16 * (16 * b + fr) + 2 * fq);
#pragma unroll
        for (int b = 0; b < 4; ++b) { const LAS unsigned char* row = ub + (16 * b + fr) * 128; const int sw = fr >> 1;
            a0[b] = *(const LAS u32x4*)(row + ((fq ^ sw) << 4)); a1[b] = *(const LAS u32x4*)(row + (((4 + fq) ^ sw) << 4)); }
        PU_IDS()
        {   const int tn = (ti + stride < tlim) ? tok + stride : tok, t2 = (ti + 2 * stride < tlim) ? tok + 2 * stride : tok;
            PU_ROWS(0) PU_SMALL(tn, t2) }
        f32x4 keep = (f32x4){0.f, 0.f, 0.f, 0.f};
#define PU_MMA(b, A0, A1) { const v4i_u q0 = (v4i_u){(int)A0.x, (int)A0.y, (int)A0.z, (int)A0.w}, q1 = (v4i_u){(int)A1.x, (int)A1.y, (int)A1.z, (int)A1.w}; \
            const v8i_t av0 = __builtin_shufflevector(q0, q0, 0, 1, 2, 3, -1, -1, -1, -1), av1 = __builtin_shufflevector(q1, q1, 0, 1, 2, 3, -1, -1, -1, -1);     \
            f32x4 dacc = __builtin_amdgcn_mfma_scale_f32_16x16x128_f8f6f4(av0, xq[0], (f32x4){0.f, 0.f, 0.f, 0.f}, 4, 0, 0, (int)usc[b], 0, 127); \
            dacc = __builtin_amdgcn_mfma_scale_f32_16x16x128_f8f6f4(av1, xq[1], dacc, 4, 0, 1, (int)usc[b], 0, 127); \
            if ((fr & 7) == (b)) keep = dacc; }
#pragma unroll
        for (int b = 0; b < 4; ++b) PU_MMA(b, a0[b], a1[b])
        asm volatile("s_waitcnt vmcnt(12)" : "+v"(keep) :: "memory");
#pragma unroll
        for (int b = 0; b < 4; ++b) { const LAS unsigned char* row = ub + (64 + 16 * b + fr) * 128; const int sw = fr >> 1;
            a0[b] = *(const LAS u32x4*)(row + ((fq ^ sw) << 4)); a1[b] = *(const LAS u32x4*)(row + (((4 + fq) ^ sw) << 4)); }
        asm volatile("s_waitcnt lgkmcnt(0)" ::: "memory");
        PU_ROWS(8)
#pragma unroll
        for (int b = 0; b < 4; ++b) PU_MMA(4 + b, a0[b], a1[b])
        asm volatile("" : "+v"(keep));
        if (fr < 8) { u32x2 o; o.x = cvt_pk_bf16(keep[0], keep[1]); o.y = cvt_pk_bf16(keep[2], keep[3]);
            *(u32x2*)(PZ + ((size_t)q * T_TOK + tok) * 128 + 16 * fr + 4 * fq) = o; }
    }
#undef PU_IDS
#undef PU_ROWS
#undef PU_SMALL
#undef PU_MMA
#undef PUV
}
struct PvCoefIn { unsigned w0, w1, w2, w3; f32x2g g; u32x2 e; u32x2 s0, s1; };
typedef int v2i_t __attribute__((ext_vector_type(2)));
typedef int v4i_t __attribute__((ext_vector_type(4)));
typedef unsigned short u16x2_t __attribute__((ext_vector_type(2)));
__device__ __forceinline__ unsigned max_byte8(u32x2 s) {
    const unsigned a = s.x & 0x00ff00ffu, b = (s.x >> 8) & 0x00ff00ffu, c = s.y & 0x00ff00ffu, d = (s.y >> 8) & 0x00ff00ffu;
    const u16x2_t m = __builtin_elementwise_max(__builtin_elementwise_max(__builtin_bit_cast(u16x2_t, a), __builtin_bit_cast(u16x2_t, b)), __builtin_elementwise_max(__builtin_bit_cast(u16x2_t, c), __builtin_bit_cast(u16x2_t, d)));
    return m.x > m.y ? (unsigned)m.x : (unsigned)m.y;
}
__device__ __forceinline__ void peer_vacc_phase(const Params& p, LAS unsigned char* lds, const unsigned char* rb_in, unsigned char* rb_out, float* fout, bool fin, int var) {
#ifdef ATT_PROBE
#define PVV(bit) (var & (bit))
#else
#define PVV(bit) 0
#endif
    unsigned char* const wsl = fresh_ptr(p.ws);
    const int* EIDX = (const int*)(wsl + WS_YC); const float* EGATE = (const float*)(wsl + WS_YC + 16 * MiB); const bf16_t* PZ = (const bf16_t*)(wsl + WS_R);
    const int tid = fresh_tid(); const int lane = tid & 63, wv = __builtin_amdgcn_readfirstlane(tid >> 6), fr = lane & 15, fq = lane >> 4;
    int q, half, bx, nbx; peer_slice_map(p, lds, q, half, bx, nbx);
    const unsigned char* VS = wsl + WS_YA + PE_VS + (size_t)q * 16384 * 128; const unsigned char* VSC = wsl + WS_YA + PE_VSC + (size_t)q * 16384 * 8;
    LAS unsigned char* ec = lds + wv * 1024;
    LAS unsigned* eidr = (LAS unsigned*)(lds + 8192 + wv * 1536);
    LAS unsigned char* ub = lds + 20480 + wv * 16384;
    const int stride = nbx * 8, tlim = T_TOK / 2;
    int ti = bx * 8 + wv;
    if (ti >= tlim) return;
#define PV_TOK(k_) (half * tlim + ((ti + (k_) * stride < tlim) ? ti + (k_) * stride : ti))
#define PV_LDR(tk, R) { const size_t tb = (size_t)(tk) * 128 + 2 * lane; R.w0 = *(const unsigned*)(PZ + tb); R.w1 = *(const unsigned*)(PZ + (size_t)T_TOK * 128 + tb); \
        R.w2 = *(const unsigned*)(PZ + (size_t)2 * T_TOK * 128 + tb); R.w3 = *(const unsigned*)(PZ + (size_t)3 * T_TOK * 128 + tb); R.g = *(const f32x2g*)(EGATE + tb); }
#define PV_LDS(R, slot) { const u32x2 e2 = *(const LAS u32x2*)(eidr + 128 * (slot) + 2 * lane); R.s0 = *(const u32x2*)(VSC + (size_t)e2.x * 8); R.s1 = *(const u32x2*)(VSC + (size_t)e2.y * 8); }
#define PV_S2(R, SOUT) { const float z0 = bf_lo(R.w0) + bf_lo(R.w1) + bf_lo(R.w2) + bf_lo(R.w3), z1 = bf_hi(R.w0) + bf_hi(R.w1) + bf_hi(R.w2) + bf_hi(R.w3); \
        const float c0 = gelu1(z0) * R.g.x, c1 = gelu1(z1) * R.g.y; \
        float am = fmaxf(fabsf(c0) * __uint_as_float(max_byte8(R.s0) << 23), fabsf(c1) * __uint_as_float(max_byte8(R.s1) << 23)); \
        am = __uint_as_float(dpp_max_u32(__float_as_uint(am)));            \
        int sx = 134 - (int)((__float_as_uint(am) >> 23) & 255u); sx = sx > 100 ? 100 : (sx < -100 ? -100 : sx); SOUT = sx; \
        const float up = __uint_as_float((unsigned)(127 + sx) << 23); const float f0 = c0 * up, f1 = c1 * up; \
        _Pragma("unroll") for (int cc = 0; cc < 8; ++cc) { const unsigned b0 = ((cc < 4 ? R.s0.x : R.s0.y) >> (8 * (cc & 3))) & 0xffu, b1 = ((cc < 4 ? R.s1.x : R.s1.y) >> (8 * (cc & 3))) & 0xffu; \
            const unsigned w = __builtin_amdgcn_cvt_pk_fp8_f32(f0 * __uint_as_float(b0 << 23), f1 * __uint_as_float(b1 << 23), 0u, false); \
            *(LAS unsigned short*)(ec + 128 * cc + 2 * lane) = (unsigned short)w; } }
#define PV_IDS(slot) { _Pragma("unroll") for (int i = 0; i < 16; ++i) idr[i] = eidr[128 * (slot) + 8 * i + (lane >> 3)]; }
#define PV_DMA(slot) { _Pragma("unroll") for (int i = 0; i < 16; ++i) { const int k = 8 * i + (lane >> 3); \
        const unsigned char* src = VS + (unsigned)(idr[i] * 128u + 16u * (unsigned)((lane & 7) ^ ((k >> 1) & 7))); \
        __builtin_amdgcn_global_load_lds((const unsigned*)src, (LAS unsigned*)(ub + i * 1024), 16, 0, 0); } }
#define PV_EDMA(tk, slot) { if (lane < 32) { __builtin_amdgcn_global_load_lds((const unsigned*)(EIDX + (size_t)(tk) * 128) + 4 * lane, eidr + 128 * (slot), 16, 0, 0); } }
#define PV_STORE() { if (fin) { _Pragma("unroll") for (int i = 0; i < 4; ++i) fout[pend_eo + 32 * i] = pend[i]; } \
        else { _Pragma("unroll") for (int i = 0; i < 4; ++i) *(bf16_t*)(rb_out + (pend_eo >> 10) * 4096 + ((pend_eo & 1023) >> 8) * 1024 + ((pend_eo & 255) + 32 * i) * 2) = f2bf(pend[i]); } }
    PvCoefIn r; float xn[4]; int s_cur = 0, s_next = 0; unsigned idr[16]; float pend[4] = {0.f, 0.f, 0.f, 0.f}; size_t pend_eo = 0; bool have_pend = false;
    int s0 = 0, s1 = 1, s2 = 2;
    {   const int tokA = PV_TOK(0), tokB = PV_TOK(1), tokC = PV_TOK(2);
        eidr[lane] = (unsigned)EIDX[(size_t)tokA * 128 + lane]; eidr[64 + lane] = (unsigned)EIDX[(size_t)tokA * 128 + 64 + lane];
        eidr[128 + lane] = (unsigned)EIDX[(size_t)tokB * 128 + lane]; eidr[192 + lane] = (unsigned)EIDX[(size_t)tokB * 128 + 64 + lane];
        eidr[256 + lane] = (unsigned)EIDX[(size_t)tokC * 128 + lane]; eidr[320 + lane] = (unsigned)EIDX[(size_t)tokC * 128 + 64 + lane];
        PV_LDR(tokA, r) PV_LDS(r, 0) PV_S2(r, s_cur)
        PV_LDR(tokB, r) PV_LDS(r, 1)
        const size_t eo0 = (size_t)tokA * 1024 + 256 * q + 128 * (fq & 1) + 16 * (fq >> 1) + fr;
#pragma unroll
        for (int i = 0; i < 4; ++i) xn[i] = bf2f(*(const bf16_t*)(rb_in + rb_off(0, (int)0) + (eo0 >> 10) * 4096 + ((eo0 & 1023) >> 8) * 1024 + ((eo0 & 255) + 32 * i) * 2));
        PV_IDS(0)
        asm volatile("s_waitcnt lgkmcnt(0)" ::: "memory");
        PV_DMA(0) }
    for (; ti < tlim; ti += stride) {
        const int tok = half * tlim + ti;
        const size_t eo = (size_t)tok * 1024 + 256 * q + 128 * (fq & 1) + 16 * (fq >> 1) + fr;
        v8i_t av;
        { const u32x4 alo = *(const LAS u32x4*)(ec + 128 * (fr & 7) + 16 * fq), ahi = *(const LAS u32x4*)(ec + 128 * (fr & 7) + 64 + 16 * fq);
          av[0] = (int)alo.x; av[1] = (int)alo.y; av[2] = (int)alo.z; av[3] = (int)alo.w; av[4] = (int)ahi.x; av[5] = (int)ahi.y; av[6] = (int)ahi.z; av[7] = (int)ahi.w; }
        asm volatile("s_waitcnt vmcnt(0) lgkmcnt(0)" : "+v"(av) :: "memory");
        if (have_pend && !PVV(64)) PV_STORE()
        float xv[4];
#pragma unroll
        for (int i = 0; i < 4; ++i) xv[i] = xn[i];
        PvCoefIn rc = r;
        asm volatile("" : "+v"(rc.w0), "+v"(rc.w1), "+v"(rc.w2), "+v"(rc.w3), "+v"(rc.g), "+v"(rc.s0), "+v"(rc.s1));
        { const int tok1 = PV_TOK(1), tok2 = PV_TOK(2);
          if (!PVV(1024)) { PV_LDR(tok2, r) PV_LDS(r, s2) }
          const size_t eo1 = (size_t)tok1 * 1024 + 256 * q + 128 * (fq & 1) + 16 * (fq >> 1) + fr;
#pragma unroll
          for (int i = 0; i < 4; ++i) xn[i] = (PVV(64) || PVV(1024)) ? 0.f : bf2f(*(const bf16_t*)(rb_in + (eo1 >> 10) * 4096 + ((eo1 & 1023) >> 8) * 1024 + ((eo1 & 255) + 32 * i) * 2)); }
        v2i_t bt[16][2];
#pragma unroll
        for (int nt = 0; nt < 16; ++nt)
#pragma unroll
            for (int h = 0; h < 2; ++h) { const int k = 32 * fq + 16 * h + fr;
                if (PVV(128)) bt[nt][h] = (v2i_t){k, nt}; else bt[nt][h] = __builtin_amdgcn_ds_read_tr4_b64_v2i32((LAS v2i_t*)(ub + k * 128 + ((((nt >> 1) ^ (fr >> 1)) & 7) << 4) + 8 * (nt & 1))); }
        PV_IDS(s1)
        asm volatile("s_waitcnt lgkmcnt(0)" ::: "memory");
        if (!PVV(256)) PV_DMA(s1)
        { const int tok3 = PV_TOK(3); PV_EDMA(tok3, s0) }
        if (!PVV(512)) PV_S2(rc, s_next)
        float o[4] = {0.f, 0.f, 0.f, 0.f};
#pragma unroll
        for (int nt = 0; nt < 16; ++nt) {
            const v4i_t b4 = (v4i_t){bt[nt][0].x, bt[nt][0].y, bt[nt][1].x, bt[nt][1].y}; const v8i_t bv = __builtin_shufflevector(b4, b4, 0, 1, 2, 3, -1, -1, -1, -1);
            const f32x4 cacc = PVV(128) ? (f32x4){(float)b4[0], (float)b4[1], (float)b4[2], (float)b4[3]} : __builtin_amdgcn_mfma_scale_f32_16x16x128_f8f6f4(av, bv, (f32x4){0.f, 0.f, 0.f, 0.f}, 0, 4, 0, 127, 0, 127);
            const bool mine = ((nt >> 3) == (fq & 1)) && ((nt & 1) == (fq >> 1));
            o[(nt >> 1) & 3] = mine ? cacc[(nt >> 1) & 3] : o[(nt >> 1) & 3];
        }
        const float dn = __uint_as_float((unsigned)(127 - s_cur) << 23);
#pragma unroll
        for (int i = 0; i < 4; ++i) pend[i] = xv[i] + o[i] * dn;
        pend_eo = eo; have_pend = true;
        s_cur = s_next;
        { const int tmp = s0; s0 = s1; s1 = s2; s2 = tmp; }
    }
    if (have_pend) PV_STORE()
#undef PV_STORE
#undef PV_TOK
#undef PV_LDR
#undef PV_LDS
#undef PV_EDMA
#undef PV_IDS
#undef PV_S2
#undef PV_DMA
#undef PVV
}
#ifdef PROBE_K
struct DumpSeg { const void* p; size_t n; long long kind; };
__global__ void __launch_bounds__(512) probe_dump(float* out, DumpSeg s0, DumpSeg s1, DumpSeg s2, DumpSeg s3, DumpSeg s4, DumpSeg s5) {
    const DumpSeg segs[6] = {s0, s1, s2, s3, s4, s5};
    const size_t NOUT = (size_t)T_TOK * DM;
    for (size_t i = (size_t)blockIdx.x * 512 + threadIdx.x; i < NOUT; i += (size_t)gridDim.x * 512) {
        float acc = 0.f;
#pragma unroll
        for (int k = 0; k < 6; ++k) { const DumpSeg s = segs[k]; if (s.p == nullptr || s.n == 0) continue;
            for (size_t j = i; j < s.n; j += NOUT) { float v;
                if (s.kind == 0) v = bf2f(((const bf16_t*)s.p)[j]); else if (s.kind == 1) v = ((const float*)s.p)[j]; else if (s.kind == 2) v = (float)((const unsigned short*)s.p)[j] * (1.0f / 65536.0f); else v = (float)(((const int*)s.p)[j] & 0xffff) * (1.0f / 65536.0f);
                if (!(fabsf(v) < 1e30f)) v = 12345.0f;
                acc += v; }
            if (s.n < NOUT) { const size_t j = i % s.n; float v;
                if (s.kind == 0) v = bf2f(((const bf16_t*)s.p)[j]); else if (s.kind == 1) v = ((const float*)s.p)[j]; else if (s.kind == 2) v = (float)((const unsigned short*)s.p)[j] * (1.0f / 65536.0f); else v = (float)(((const int*)s.p)[j] & 0xffff) * (1.0f / 65536.0f);
                if (!(fabsf(v) < 1e30f)) v = 12345.0f;
                if (i >= s.n) acc += v; } }
        out[i] = acc; }
}
#endif
#ifdef PROBE_DET
struct CkSeg { const void* p; size_t nbytes; };
__global__ void __launch_bounds__(512) probe_cksum(unsigned long long* dst, CkSeg s0, CkSeg s1, CkSeg s2, CkSeg s3) {
    const CkSeg segs[4] = {s0, s1, s2, s3};
    unsigned long long h = 0ull;
    for (int k = 0; k < 4; ++k) { const CkSeg s = segs[k]; if (s.p == nullptr) continue; const unsigned* w = (const unsigned*)s.p; const size_t n = s.nbytes / 4;
        for (size_t i = (size_t)blockIdx.x * 512 + threadIdx.x; i < n; i += (size_t)gridDim.x * 512) h += (unsigned long long)w[i] * (unsigned long long)(i * 2654435761ull + 12345ull + (unsigned long long)k * 977ull); }
    for (int o = 32; o; o >>= 1) h += __shfl_xor(h, o);
    if ((threadIdx.x & 63) == 0) atomicAdd(dst, h);
}
__global__ void __launch_bounds__(512) probe_mark(float* out, const unsigned long long* cks, int nph) {
    int code = 0;
    for (int k = nph - 1; k >= 0; --k) if (cks[k] != cks[32 + k] || cks[k] != cks[64 + k]) code = k + 1;
    if (code == 0) return;
    const float f = 2.0f;
    for (size_t i = (size_t)blockIdx.x * 512 + threadIdx.x; i < (size_t)T_TOK * DM; i += (size_t)gridDim.x * 512) out[i] *= f;
}
#endif

#ifdef PROBE_CHK
__device__ __forceinline__ unsigned hsh(unsigned x) { x ^= x >> 16; x *= 0x7feb352du; x ^= x >> 15; x *= 0x846ca68bu; x ^= x >> 16; return x; }
__device__ __forceinline__ void chk_fail(unsigned* flag, int code) { atomicMin(flag, (unsigned)code); }
__device__ __forceinline__ bool close_to(float a, float ref, float atol, float rtol) { return fabsf(a - ref) <= atol + rtol * fabsf(ref) && (a == a); }
__device__ __forceinline__ int h_origcol(int c) { if (c < 1024) return c; if (c < 1536) return c + 512; if (c < 2048) return c + 512; if (c < 2560) return c + 512; if (c < 3072) return c + 768; if (c < 3200) return c; if (c < 3264) return c + 640; return c + 640; }
__device__ __forceinline__ float ref_gelu(float x) { return 0.5f * x * (1.0f + erff(x * 0.70710678f)); }
__global__ void chk_h(Params p, int l, unsigned* flag) {
    const unsigned s = blockIdx.x * blockDim.x + threadIdx.x; const int t = hsh(s * 2 + 1) % T_TOK; const int c = hsh(s * 2 + 2) % 3272;
    const bf16_t* XN = (const bf16_t*)(p.ws + WS_XN); const bf16_t* H = (const bf16_t*)(p.ws + WS_R + R_H); const bf16_t* VT = (const bf16_t*)(p.ws + WS_R + R_VT);
    const float* win = p.in[I_W_IN] + (size_t)l * 1024 * DIN; const int oc = h_origcol(c);
    float r = 0.f; for (int k = 0; k < 1024; ++k) r += bf2f(XN[(size_t)t * 1024 + k]) * win[(size_t)k * DIN + oc];
    if (!close_to(bf2f(H[(size_t)t * HN + c]), r, 0.06f, 0.03f)) chk_fail(flag, 1);
    const int m = hsh(s * 2 + 77) % 640; const int vc = m < 512 ? 1024 + m : 3200 + (m - 512);
    float r2 = 0.f; for (int k = 0; k < 1024; ++k) r2 += bf2f(XN[(size_t)t * 1024 + k]) * win[(size_t)k * DIN + vc];
    if (!close_to(bf2f(VT[(size_t)m * T_TOK + t]), r2, 0.06f, 0.03f)) chk_fail(flag, 2);
}
__global__ void chk_post(Params p, int l, unsigned* flag) {
    const unsigned s = blockIdx.x * blockDim.x + threadIdx.x; const int t = hsh(s * 3 + 1) % T_TOK; const int g = hsh(s * 3 + 2) & 3; const int d = hsh(s * 3 + 3) & 127;
    const bf16_t* H = (const bf16_t*)(p.ws + WS_R + R_H); const bf16_t* YB = (const bf16_t*)(p.ws + WS_YB);
    const int c0 = (t / 128) * 128, tt = t % 128;
    const float* W = p.in[I_BWS] + ((size_t)(l * 4 + g) * 128) * 128; const float* bs = p.in[I_BBS] + (size_t)(l * 4 + g) * 128; const float* vg = p.in[I_BVG] + l * 512 + g * 128;
    float sv = 0.f;
    for (int ss = 0; ss <= tt; ++ss) { const bf16_t* row = H + (size_t)(c0 + ss) * HN + HC_ZV + g * 128; float q = 0.f; for (int dd = 0; dd < 128; ++dd) { const float v = ref_gelu(bf2f(row[dd])); q += v * v; }
        const float vn = ref_gelu(bf2f(row[d])) * rsqrtf(q / 128.f + EPSF) * vg[d]; sv += W[tt * 128 + ss] * vn; }
    sv += bs[tt];
    const float r = ref_gelu(bf2f(H[(size_t)t * HN + HC_ZU + g * 128 + d])) * sv;
    if (!close_to(bf2f(YB[(size_t)t * 512 + g * 128 + d]), r, 0.03f, 0.04f)) chk_fail(flag, 3);
    { const int grp = hsh(s * 3 + 9) & 7; const float* gn = p.in[I_AKG] + l * 64; float q = 0.f; for (int j = 0; j < 64; ++j) { const float v = bf2f(H[(size_t)t * HN + HC_KA + grp * 64 + j]) / gn[j]; q += v * v; }
        if (!close_to(q / 64.f, 1.0f, 0.03f, 0.f)) chk_fail(flag, 5);
        const float* gc = p.in[I_CKG] + l * 128; q = 0.f; for (int j = 0; j < 128; ++j) { const float v = bf2f(H[(size_t)t * HN + HC_CK + j]) / gc[j]; q += v * v; }
        if (!close_to(q / 128.f, 1.0f, 0.03f, 0.f)) chk_fail(flag, 5); }
}
__global__ void chk_mask(Params p, unsigned* flag) {
    const unsigned s = blockIdx.x * blockDim.x + threadIdx.x; const int b = hsh(s * 5 + 1) & 15; const int q = hsh(s * 5 + 2) & 2047;
    const bf16_t* H = (const bf16_t*)(p.ws + WS_R + R_H); const unsigned short* mask = (const unsigned short*)(p.ws + WS_MASK);
    const size_t tq = (size_t)b * SEQ + q;
    int cnt = 0; float minsel = 3e38f, maxuns = -3e38f;
    for (int k = 0; k < SEQ; ++k) { const bool sel = (mask[tq * 128 + (k >> 4)] >> (k & 15)) & 1; if (k > q) { if (k <= (q | 63) && sel) chk_fail(flag, 4); continue; }
        float sc = 0.f; for (int h = 0; h < 8; ++h) { float dt = 0.f; for (int d = 0; d < 64; ++d) dt += bf2f(H[tq * HN + HC_IQ + h * 64 + d]) * bf2f(H[((size_t)b * SEQ + k) * HN + HC_IK + d]); sc += fmaxf(dt, 0.f) * bf2f(H[tq * HN + HC_IW + h]); }
        if (sel) { ++cnt; minsel = fminf(minsel, sc); } else maxuns = fmaxf(maxuns, sc); }
    const int want = (q + 1 < 256) ? q + 1 : 256;
    if (cnt < want || cnt > want + 2) chk_fail(flag, 4);
    if (q >= 256 && minsel < maxuns - 0.02f * (fabsf(maxuns) + 1.f)) chk_fail(flag, 4);
}
__global__ void chk_attn(Params p, int l, unsigned* flag) {
    __shared__ float qn_s[64][130]; __shared__ float o_s[64][130];
    float* qn = qn_s[threadIdx.x]; float* o = o_s[threadIdx.x];
    const unsigned s = blockIdx.x * blockDim.x + threadIdx.x; const int b = hsh(s * 7 + 1) & 15, h = hsh(s * 7 + 2) & 3, q = hsh(s * 7 + 3) & 2047;
    const bf16_t* H = (const bf16_t*)(p.ws + WS_R + R_H); const bf16_t* VT = (const bf16_t*)(p.ws + WS_R + R_VT); const bf16_t* YA = (const bf16_t*)(p.ws + WS_YA);
    const float* lamv = (const float*)(p.ws + WS_CTL + CTL_LAM); const float lam = lamv[l * 2], lam_init = lamv[l * 2 + 1];
    const float* rb = p.in[I_RELB]; const size_t tq = (size_t)b * SEQ + q; const float* qg = p.in[I_AQG] + l * 64; const float* sg = p.in[I_SUBLN] + l * 128;
    for (int sb = 0; sb < 2; ++sb) { float ss = 0.f; for (int d = 0; d < 64; ++d) { const float v = bf2f(H[tq * HN + HC_QA + h * 128 + sb * 64 + d]); ss += v * v; } const float r = rsqrtf(ss / 64.f + EPSF);
        for (int d = 0; d < 64; ++d) qn[sb * 64 + d] = bf2f(H[tq * HN + HC_QA + h * 128 + sb * 64 + d]) * r * qg[d]; }
    for (int d = 0; d < 128; ++d) o[d] = 0.f;
    float mx0 = -3e38f, mx1 = -3e38f, l0 = 0.f, l1 = 0.f;
    for (int pass = 0; pass < 3; ++pass) {
        for (int k = 0; k <= q; ++k) { const int dist = q - k; int bk; if (dist < 16) bk = dist; else { int lg = 16 + (int)(logf((float)dist / 16.f) / 2.0794415416798357f * 16.f); bk = lg < 31 ? lg : 31; }
            const bf16_t* kr = H + ((size_t)b * SEQ + k) * HN + HC_KA + h * 128; float d0 = 0.f, d1 = 0.f;
            for (int e = 0; e < 64; ++e) { d0 += qn[e] * bf2f(kr[e]); d1 += qn[64 + e] * bf2f(kr[64 + e]); }
            const float g0 = d0 * 0.125f + rb[bk * 8 + h], g1 = d1 * 0.125f + rb[bk * 8 + h];
            if (pass == 0) { mx0 = fmaxf(mx0, g0); mx1 = fmaxf(mx1, g1); }
            else if (pass == 1) { l0 += expf(g0 - mx0); l1 += expf(g1 - mx1); }
            else { const float pd = expf(g0 - mx0) / l0 - lam * expf(g1 - mx1) / l1; for (int d = 0; d < 128; ++d) o[d] += pd * bf2f(VT[(size_t)(h * 128 + d) * T_TOK + (size_t)b * SEQ + k]); } } }
    float ssq = 0.f; for (int d = 0; d < 128; ++d) ssq += o[d] * o[d];
    const float sc = rsqrtf(ssq / 128.f + EPSF) * (1.f - lam_init);
    for (int d = 0; d < 128; d += 17) if (!close_to(bf2f(YA[tq * 512 + h * 128 + d]), o[d] * sc * sg[d], 0.03f, 0.05f)) chk_fail(flag, 6);
}
__global__ void chk_attnc(Params p, int l, unsigned* flag) {
    const unsigned s = blockIdx.x * blockDim.x + threadIdx.x; const int b = hsh(s * 11 + 1) & 15, h = hsh(s * 11 + 2) & 3, q = hsh(s * 11 + 3) & 2047;
    const bf16_t* H = (const bf16_t*)(p.ws + WS_R + R_H); const bf16_t* VT = (const bf16_t*)(p.ws + WS_R + R_VT); const bf16_t* YC = (const bf16_t*)(p.ws + WS_YC);
    const unsigned short* mask = (const unsigned short*)(p.ws + WS_MASK); const float* rb = p.in[I_RELB]; const size_t tq = (size_t)b * SEQ + q; const float* qg = p.in[I_CQG] + l * 128;
    float ss = 0.f; for (int d = 0; d < 128; ++d) { const float v = bf2f(H[tq * HN + HC_CQ + h * 128 + d]); ss += v * v; } const float r = rsqrtf(ss / 128.f + EPSF);
    float mx = -3e38f, ls = 0.f, o0 = 0.f, o1 = 0.f; const int d0 = hsh(s * 11 + 4) & 127, d1 = hsh(s * 11 + 5) & 127;
    for (int pass = 0; pass < 2; ++pass)
        for (int k = 0; k <= q; ++k) { if (!((mask[tq * 128 + (k >> 4)] >> (k & 15)) & 1)) continue;
            const int dist = q - k; int bk; if (dist < 16) bk = dist; else { int lg = 16 + (int)(logf((float)dist / 16.f) / 2.0794415416798357f * 16.f); bk = lg < 31 ? lg : 31; }
            float dt = 0.f; for (int d = 0; d < 128; ++d) dt += bf2f(H[tq * HN + HC_CQ + h * 128 + d]) * r * qg[d] * bf2f(H[((size_t)b * SEQ + k) * HN + HC_CK + d]);
            const float lg2 = dt * 0.08838834764831845f + rb[bk * 8 + 4 + h];
            if (pass == 0) mx = fmaxf(mx, lg2); else { const float pr = expf(lg2 - mx); ls += pr; o0 += pr * bf2f(VT[(size_t)(512 + d0) * T_TOK + (size_t)b * SEQ + k]); o1 += pr * bf2f(VT[(size_t)(512 + d1) * T_TOK + (size_t)b * SEQ + k]); } }
    if (!close_to(bf2f(YC[tq * 512 + h * 128 + d0]), o0 / ls, 0.02f, 0.05f)) chk_fail(flag, 7);
    if (!close_to(bf2f(YC[tq * 512 + h * 128 + d1]), o1 / ls, 0.02f, 0.05f)) chk_fail(flag, 7);
}
__global__ void chk_merge(Params p, int l, unsigned* flag) {
    const unsigned s = blockIdx.x * blockDim.x + threadIdx.x; const int t = hsh(s * 13 + 1) % T_TOK; const int j = hsh(s * 13 + 2) & 1023;
    const bf16_t* XN = (const bf16_t*)(p.ws + WS_XN); const bf16_t* G = (const bf16_t*)(p.ws + WS_R + R_G); const bf16_t* MG = (const bf16_t*)(p.ws + WS_R + R_MERGED);
    const float* win = p.in[I_W_IN] + (size_t)l * 1024 * DIN; float m = 0.f;
    for (int br = 0; br < 3; ++br) { float z = 0.f; for (int k = 0; k < 1024; ++k) z += bf2f(XN[(size_t)t * 1024 + k]) * win[(size_t)k * DIN + 3912 + br * 1024 + j];
        const float gt = 1.f / (1.f + expf(-z)); if (!close_to(bf2f(G[(size_t)t * 3072 + br * 1024 + j]), gt, 0.02f, 0.02f)) chk_fail(flag, 8);
        const bf16_t* Y = (const bf16_t*)(p.ws + (br == 0 ? WS_YA : br == 1 ? WS_YB : WS_YC)); const float* wb = p.in[br == 0 ? I_WBRA : br == 1 ? I_WBRB : I_WBRC] + (size_t)l * 512 * 1024;
        float y = 0.f; for (int k = 0; k < 512; ++k) y += bf2f(Y[(size_t)t * 512 + k]) * wb[(size_t)k * 1024 + j]; m += gt * y; }
    if (!close_to(bf2f(MG[(size_t)t * 1024 + j]), m, 0.04f, 0.04f)) chk_fail(flag, 9);
}
__global__ void chk_xmix(Params p, int l, const float* xsrc, unsigned* flag) {
    const unsigned s = blockIdx.x * blockDim.x + threadIdx.x; const int t = hsh(s * 17 + 1) % T_TOK; const int j = hsh(s * 17 + 2) & 1023;
    const bf16_t* MG = (const bf16_t*)(p.ws + WS_R + R_MERGED); const float* wo = p.in[I_WOUT] + (size_t)l * 1024 * 1024;
    float y = 0.f; for (int k = 0; k < 1024; ++k) y += bf2f(MG[(size_t)t * 1024 + k]) * wo[(size_t)k * 1024 + j];
    if (l == 0 && !close_to(p.out[(size_t)t * 1024 + j], xsrc[(size_t)t * 1024 + j] + y, 0.05f, 0.03f)) chk_fail(flag, 10);
}
__global__ void chk_xattn(Params p, int l, unsigned* flag) {
    const unsigned s = blockIdx.x * blockDim.x + threadIdx.x; const int b = hsh(s * 19 + 1) & 15, h = hsh(s * 19 + 2) & 3, q = hsh(s * 19 + 3) & 2047; const int d0 = hsh(s * 19 + 4) & 127;
    const bf16_t* QX = (const bf16_t*)(p.ws + WS_YA); const bf16_t* MK = (const bf16_t*)(p.ws + WS_MK); const bf16_t* MVT = (const bf16_t*)(p.ws + WS_MVT); const bf16_t* OX = (const bf16_t*)(p.ws + WS_YB);
    const bf16_t* XN = (const bf16_t*)(p.ws + WS_XN); const float* wq = p.in[I_MWQ] + (size_t)l * 1024 * 512; const size_t tq = (size_t)b * SEQ + q; const float* qg = p.in[I_MQG] + l * 128;
    { float z = 0.f; for (int k = 0; k < 1024; ++k) z += bf2f(XN[tq * 1024 + k]) * wq[(size_t)k * 512 + h * 128 + d0]; if (!close_to(bf2f(QX[tq * 512 + h * 128 + d0]), z, 0.06f, 0.03f)) chk_fail(flag, 11); }
    float ss = 0.f; for (int d = 0; d < 128; ++d) { const float v = bf2f(QX[tq * 512 + h * 128 + d]); ss += v * v; } const float r = rsqrtf(ss / 128.f + EPSF);
    float mx = -3e38f, ls = 0.f, o0 = 0.f;
    for (int pass = 0; pass < 2; ++pass) for (int k = 0; k < 256; ++k) { float dt = 0.f; for (int d = 0; d < 128; ++d) dt += bf2f(QX[tq * 512 + h * 128 + d]) * r * qg[d] * bf2f(MK[((size_t)b * 256 + k) * 512 + h * 128 + d]);
        const float lg2 = dt * 0.08838834764831845f; if (pass == 0) mx = fmaxf(mx, lg2); else { const float pr = expf(lg2 - mx); ls += pr; o0 += pr * bf2f(MVT[(size_t)(h * 128 + d0) * 4096 + b * 256 + k]); } }
    if (!close_to(bf2f(OX[tq * 512 + h * 128 + d0]), o0 / ls, 0.01f, 0.05f)) chk_fail(flag, 12);
}
__global__ void chk_ps(Params p, int l, unsigned* flag) {
    const unsigned s = blockIdx.x * blockDim.x + threadIdx.x; const int t = hsh(s * 23 + 1) % T_TOK; const int hh = hsh(s * 23 + 2) & 15, n = hsh(s * 23 + 3) & 127;
    const bf16_t* XN = (const bf16_t*)(p.ws + WS_XN); const float* PS = (const float*)(p.ws + WS_R + R_PS);
    const float* pwq = p.in[I_PWQ] + (size_t)l * 1024 * 2048; const float* sk = p.in[(hh & 1) ? I_SK2 : I_SK1] + (size_t)l * 128 * 128;
    float sc = 0.f; for (int d = 0; d < 128; ++d) { float qd = 0.f; for (int k = 0; k < 1024; ++k) qd += bf2f(XN[(size_t)t * 1024 + k]) * pwq[(size_t)k * 2048 + hh * 128 + d]; sc += qd * sk[n * 128 + d]; }
    if (!close_to(PS[(size_t)t * 2048 + hh * 128 + n], sc, 0.05f, 0.03f)) chk_fail(flag, 13);
}
__global__ void chk_topk(Params p, unsigned* flag) {
    const unsigned s = blockIdx.x * blockDim.x + threadIdx.x; const int t = hsh(s * 29 + 1) % T_TOK; const int h = hsh(s * 29 + 2) & 7;
    const float* PS = (const float*)(p.ws + WS_R + R_PS) + (size_t)t * 2048 + h * 256; const int* EIDX = (const int*)(p.ws + WS_YC) + (size_t)t * 128 + h * 16; const float* EG = (const float*)(p.ws + WS_YC + 16 * MiB) + (size_t)t * 128 + h * 16;
    __shared__ float csv_s[64][17]; float* csv = csv_s[threadIdx.x];
    float gsum = 0.f, mn = 3e38f, mxs = -3e38f;
    for (int i = 0; i < 16; ++i) { const int e = EIDX[i]; if (e < 0 || e >= 16384) { chk_fail(flag, 14); return; } const int e1 = e >> 7, e2 = e & 127; int r1 = 0, r2 = 0;
        for (int j = 0; j < 128; ++j) { if (PS[j] > PS[e1]) ++r1; if (PS[128 + j] > PS[128 + e2]) ++r2; }
        if (r1 >= 16 || r2 >= 16) chk_fail(flag, 14);
        csv[i] = PS[e1] + PS[128 + e2]; mn = fminf(mn, csv[i]); mxs = fmaxf(mxs, csv[i]); for (int j = 0; j < i; ++j) if (EIDX[j] == e) chk_fail(flag, 14); }
    for (int i = 0; i < 16; ++i) gsum += expf(csv[i] - mxs);
    for (int i = 0; i < 16; ++i) if (!close_to(EG[i], expf(csv[i] - mxs) / gsum, 0.003f, 0.02f)) chk_fail(flag, 14);
    int better = 0; for (int a = 0; a < 128; ++a) for (int b2 = 0; b2 < 128; ++b2) if (PS[a] + PS[128 + b2] > mn + 1e-4f) ++better;
    if (better > 15) chk_fail(flag, 14);
}
__global__ void chk_save_x(Params p, float* save) { const unsigned s = blockIdx.x * blockDim.x + threadIdx.x; const int t = hsh(s * 31 + 1) % T_TOK; const int d = hsh(s * 31 + 2) & 1023; save[s] = p.out[(size_t)t * 1024 + d]; }
__global__ void chk_gather(Params p, int l, const float* save, unsigned* flag) {
    const unsigned s = blockIdx.x * blockDim.x + threadIdx.x; const int t = hsh(s * 31 + 1) % T_TOK; const int d = hsh(s * 31 + 2) & 1023;
    const bf16_t* XN = (const bf16_t*)(p.ws + WS_XN); const int* EIDX = (const int*)(p.ws + WS_YC) + (size_t)t * 128; const float* EG = (const float*)(p.ws + WS_YC + 16 * MiB) + (size_t)t * 128;
    const float* pu = p.in[I_PU] + (size_t)l * 16384 * 1024; const float* pv = p.in[I_PV] + (size_t)l * 16384 * 1024; float inc = 0.f;
    for (int i = 0; i < 128; ++i) { const int e = EIDX[i]; float dt = 0.f; for (int k = 0; k < 1024; ++k) dt += bf2f(XN[(size_t)t * 1024 + k]) * pu[(size_t)e * 1024 + k]; inc += EG[i] * ref_gelu(dt) * pv[(size_t)e * 1024 + d]; }
    if (!close_to(p.out[(size_t)t * 1024 + d] - save[s], inc, 0.03f, 0.05f)) chk_fail(flag, 15);
}
__global__ void __launch_bounds__(512) chk_mark(float* out, const unsigned* flag) {
    const unsigned code = *flag; if (code == 0 || code > 100) return;
    const float f = 1.0f + 0.3f * (float)code;
    for (size_t i = (size_t)blockIdx.x * 512 + threadIdx.x; i < (size_t)T_TOK * DM; i += (size_t)gridDim.x * 512) out[i] *= f;
}
#endif
#ifdef MPROBE
#ifndef MPROBE_PART
#define MPROBE_PART 0
#endif
typedef int v8i_p __attribute__((ext_vector_type(8)));
constexpr int PE_ROW = 1088;
typedef float f32x2p __attribute__((ext_vector_type(2)));
__device__ __forceinline__ unsigned mp_xq(const bf16_t* xp, int e0) { const u32x2 w = *(const u32x2*)(xp + e0); unsigned d = 0u; d = __builtin_amdgcn_cvt_pk_fp8_f32(bf_lo(w.x), bf_hi(w.x), d, false); d = __builtin_amdgcn_cvt_pk_fp8_f32(bf_lo(w.y), bf_hi(w.y), d, true); return d; }
__device__ __forceinline__ float mp_fp4val(unsigned c) { const float mag[8] = {0.f, 0.5f, 1.f, 1.5f, 2.f, 3.f, 4.f, 6.f}; const float m = mag[c & 7u]; return (c & 8u) ? -m : m; }
__device__ __forceinline__ float mp_fp8val(unsigned byte) { const f32x2p t = __builtin_amdgcn_cvt_pk_f32_fp8(byte, false); return t.x; }
__global__ void __launch_bounds__(64) mprobe_kernel(const unsigned char* PE, const bf16_t* XN, const int* EIDX, unsigned* flag, int mode) {
    __shared__ float refs[16]; __shared__ unsigned tabu[16][256];
    const int lane = threadIdx.x, fr = lane & 15, fq = lane >> 4;
    const bf16_t* xrow = XN;
    for (int i = lane; i < 16 * 128; i += 64) { const int r = i >> 7, d = i & 127; tabu[r][d] = *(const unsigned*)(PE + (size_t)EIDX[r] * PE_ROW + 4 * d); }
    __syncthreads();
    if (mode == 0) {
        { float ref = 0.f; for (int e = fq; e < 1024; e += 4) { const unsigned w = tabu[fr][e >> 3]; const unsigned nb = (w >> (4 * (e & 7))) & 15u; const unsigned xb = (mp_xq(xrow, e & ~3) >> (8 * (e & 3))) & 0xffu; ref += mp_fp4val(nb) * mp_fp8val(xb); }
          ref += __shfl_xor(ref, 16); ref += __shfl_xor(ref, 32); if (fq == 0) refs[fr] = ref; }
        __syncthreads();
        __syncthreads();
        { float ref = 0.f; for (int e = fq; e < 128; e += 4) { const unsigned w = tabu[fr][e >> 3]; const unsigned nb = (w >> (4 * (e & 7))) & 15u; const unsigned xb = (mp_xq(xrow, e & ~3) >> (8 * (e & 3))) & 0xffu; ref += mp_fp4val(nb) * mp_fp8val(xb); }
          ref += __shfl_xor(ref, 16); ref += __shfl_xor(ref, 32); if (fq == 0) refs[fr] = ref; }
        __syncthreads();
        v8i_p bv; for (int j = 0; j < 8; ++j) bv[j] = (int)mp_xq(xrow + 32 * fq, 4 * j);
        unsigned wsrc[4]; for (int dd = 0; dd < 4; ++dd) wsrc[dd] = tabu[fr][4 * fq + dd];
        unsigned foundp = 0xffffffffu;
        for (int idx = 0; idx < 40320; ++idx) {
            unsigned pool = 0x76543210u; unsigned pmk = 0u; int rem = idx;
            for (int n = 0; n < 8; ++n) { const int radix = 8 - n; int fct = 1; for (int q = 2; q < radix; ++q) fct *= q; const int dsel = rem / fct; rem -= dsel * fct;
                const unsigned pos = (pool >> (4 * dsel)) & 15u; pmk |= pos << (4 * n);
                const unsigned lowmask = (dsel == 0) ? 0u : (0xffffffffu >> (32 - 4 * dsel)); pool = (pool & lowmask) | ((pool >> 4) & ~lowmask); }
            unsigned r[4];
            for (int dd = 0; dd < 4; ++dd) { const unsigned w = wsrc[dd]; unsigned o = 0u; for (int n = 0; n < 8; ++n) o |= ((w >> (4 * n)) & 15u) << (4 * ((pmk >> (4 * n)) & 15u)); r[dd] = o; }
            v8i_p av; av[0] = (int)r[0]; av[1] = (int)r[1]; av[2] = (int)r[2]; av[3] = (int)r[3]; av[4] = 0; av[5] = 0; av[6] = 0; av[7] = 0;
            const f32x4 dacc = __builtin_amdgcn_mfma_scale_f32_16x16x128_f8f6f4(av, bv, (f32x4){0.f, 0.f, 0.f, 0.f}, 4, 0, 0, 0x7f7f7f7f, 0, 0x7f7f7f7f);
            float err = 0.f; for (int i = 0; i < 4; ++i) { const float rv = refs[4 * fq + i]; err = fmaxf(err, fabsf(dacc[i] - rv) / (fabsf(rv) + 0.05f)); }
            for (int o = 32; o; o >>= 1) err = fmaxf(err, __shfl_xor(err, o));
            if (err < 0.02f && foundp == 0xffffffffu) foundp = pmk;
        }
        unsigned found = 0u;
        if (lane == 0) { if (foundp == 0xffffffffu) { flag[0] = 70u; flag[1] = 70u; }
            else { const int sh = (MPROBE_PART) * 16; flag[0] = 8u * ((foundp >> sh) & 15u) + ((foundp >> (sh + 4)) & 15u) + 1u; flag[1] = 8u * ((foundp >> (sh + 8)) & 15u) + ((foundp >> (sh + 12)) & 15u) + 1u; } }
        (void)found;
    } else if (mode == 4) {
        float ref1 = 0.f, ref2 = 0.f;
        for (int e = fq; e < 1024; e += 4) { const unsigned w = tabu[fr][e >> 3]; const unsigned nb = (w >> (4 * (e & 7))) & 15u; const unsigned xb = (mp_xq(xrow, e & ~3) >> (8 * (e & 3))) & 0xffu;
            const unsigned sb = PE[(size_t)EIDX[fr] * PE_ROW + 1024 + 2 * (e >> 5)]; const float sc = __uint_as_float(sb << 23);
            const float pr = mp_fp4val(nb) * mp_fp8val(xb); if (e < 128) ref1 += pr; ref2 += pr * sc; }
        ref1 += __shfl_xor(ref1, 16); ref1 += __shfl_xor(ref1, 32); ref2 += __shfl_xor(ref2, 16); ref2 += __shfl_xor(ref2, 32);
        if (fq == 0) refs[fr] = ref1; __shared__ float refs2[16]; if (fq == 0) refs2[fr] = ref2;
        __syncthreads();
        f32x4 d1 = (f32x4){0.f, 0.f, 0.f, 0.f}, d2 = (f32x4){0.f, 0.f, 0.f, 0.f};
        for (int s2 = 0; s2 < 8; ++s2) {
            v8i_p bv; for (int jj = 0; jj < 8; ++jj) bv[jj] = (int)mp_xq(xrow, 128 * s2 + 16 * fq + 64 * (jj >> 2) + 4 * (jj & 3));
            v8i_p av; av[0] = (int)tabu[fr][16 * s2 + 4 * fq + 0]; av[1] = (int)tabu[fr][16 * s2 + 4 * fq + 1]; av[2] = (int)tabu[fr][16 * s2 + 4 * fq + 2]; av[3] = (int)tabu[fr][16 * s2 + 4 * fq + 3]; av[4] = 0; av[5] = 0; av[6] = 0; av[7] = 0;
            const int sa = (int)PE[(size_t)EIDX[fr] * PE_ROW + 1024 + 2 * (4 * s2 + fq)];
            if (s2 == 0) d1 = __builtin_amdgcn_mfma_scale_f32_16x16x128_f8f6f4(av, bv, d1, 4, 0, 0, 0x7f7f7f7f, 0, 0x7f7f7f7f);
            d2 = __builtin_amdgcn_mfma_scale_f32_16x16x128_f8f6f4(av, bv, d2, 4, 0, 0, sa, 0, 0x7f7f7f7f); }
        float e1 = 0.f, e2 = 0.f; unsigned nb2 = 0u;
        for (int i = 0; i < 4; ++i) { const float r1 = refs[4 * fq + i], r2 = refs2[4 * fq + i]; e1 = fmaxf(e1, fabsf(d1[i] - r1) / (fabsf(r1) + 0.05f)); const float q2 = fabsf(d2[i] - r2) / (fabsf(r2) + 1e-3f); e2 = fmaxf(e2, q2); if (q2 >= 0.02f) ++nb2; }
        for (int o = 32; o; o >>= 1) { e1 = fmaxf(e1, __shfl_xor(e1, o)); e2 = fmaxf(e2, __shfl_xor(e2, o)); }
        nb2 += __shfl_xor(nb2, 16); nb2 += __shfl_xor(nb2, 32);
        const unsigned nbr = (unsigned)__builtin_amdgcn_readlane((int)nb2, 0);
        if (lane == 0) { flag[0] = 1u + (e1 >= 0.02f ? 1u : 0u) + (e2 >= 0.02f ? 2u : 0u); flag[1] = 1u + nbr; }
    } else if (mode == 6) {
        __shared__ __attribute__((aligned(16))) unsigned char tile[2][128];
        for (int i = lane; i < 128; i += 64) { const int r = i >> 3; tile[0][i] = (unsigned char)(r | (r << 4)); const int c0 = (i & 7) * 2; tile[1][i] = (unsigned char)(c0 | ((c0 + 1) << 4)); }
        __syncthreads();
        typedef int v2i_p __attribute__((ext_vector_type(2)));
        const v2i_p r1 = __builtin_amdgcn_ds_read_tr4_b64_v2i32((LAS v2i_p*)(&tile[0][8 * fr]));
        const v2i_p r2 = __builtin_amdgcn_ds_read_tr4_b64_v2i32((LAS v2i_p*)(&tile[1][8 * fr]));
        bool ok = true;
        for (int jn = 0; jn < 16; ++jn) { const unsigned n1 = ((unsigned)(jn < 8 ? r1.x : r1.y) >> (4 * (jn & 7))) & 15u, n2 = ((unsigned)(jn < 8 ? r2.x : r2.y) >> (4 * (jn & 7))) & 15u; if (n1 != (unsigned)jn || n2 != (unsigned)fr) ok = false; }
        const bool allok = __builtin_amdgcn_ballot_w64(ok) == ~0ull;
        const unsigned p1 = ((unsigned)__builtin_amdgcn_readlane(r1.x, 2) >> 4) & 15u, p2 = ((unsigned)__builtin_amdgcn_readlane(r2.x, 2) >> 4) & 15u;
        if (lane == 0) { flag[0] = 1u + p2; flag[1] = 1u + p1 + (allok ? 20u : 0u); }
    } else if (mode == 5) {
        __shared__ unsigned tab7[128];
        v8i_p bv; for (int j = 0; j < 8; ++j) { unsigned w = 0u; for (int k = 0; k < 4; ++k) { const unsigned code = 0x10u + 0x20u * (fq & 1) + (unsigned)(4 * j + k) + ((fq >> 1) ? 0x80u : 0u); w |= code << (8 * k); } bv[j] = (int)w; }
        for (int idx = 0; idx < 128; ++idx) { const int FBq = idx >> 5, d = (idx >> 3) & 3, n = idx & 7;
            const unsigned hot = (fq == FBq) ? (2u << (4 * n)) : 0u; const unsigned r0 = d == 0 ? hot : 0u, r1 = d == 1 ? hot : 0u, r2 = d == 2 ? hot : 0u, r3 = d == 3 ? hot : 0u;
            v8i_p av; av[0] = (int)r0; av[1] = (int)r1; av[2] = (int)r2; av[3] = (int)r3; av[4] = 0; av[5] = 0; av[6] = 0; av[7] = 0;
            const f32x4 dacc = __builtin_amdgcn_mfma_scale_f32_16x16x128_f8f6f4(av, bv, (f32x4){0.f, 0.f, 0.f, 0.f}, 4, 0, 0, 0x7f7f7f7f, 0, 0x7f7f7f7f);
            const float cv = __uint_as_float((unsigned)__builtin_amdgcn_readlane((int)__float_as_uint(dacc[0]), 0));
            unsigned fk = 255u;
            for (unsigned b = 0; b < 4; ++b) for (unsigned e = 0; e < 32; ++e) { const unsigned code = 0x10u + 0x20u * (b & 1u) + e + ((b >> 1) ? 0x80u : 0u); if (mp_fp8val(code) == cv) fk = 32u * b + e; }
            if (lane == 0) tab7[idx] = fk; }
        __syncthreads();
        const unsigned c0 = tab7[0]; unsigned aff = 1u, nnone = 0u;
        for (int idx = 0; idx < 128; ++idx) { unsigned pr = c0; if (idx & 1) pr ^= tab7[1] ^ c0; if (idx & 2) pr ^= tab7[2] ^ c0; if (idx & 4) pr ^= tab7[4] ^ c0; if (idx & 8) pr ^= tab7[8] ^ c0; if (idx & 16) pr ^= tab7[16] ^ c0; if (idx & 32) pr ^= tab7[32] ^ c0; if (idx & 64) pr ^= tab7[64] ^ c0;
            if (pr != tab7[idx]) aff = 0u; if (tab7[idx] == 255u) ++nnone; }
        const int part = MPROBE_PART;
        #define MP_POS(v) (__builtin_popcount(v) == 1 ? (unsigned)__builtin_ctz(v) : 7u)
        if (lane == 0) {
            if (part == 0) { flag[0] = 1u + MP_POS(tab7[1] ^ c0); flag[1] = 1u + MP_POS(tab7[2] ^ c0) + 8u * MP_POS(tab7[4] ^ c0); }
            else if (part == 1) { flag[0] = 1u + MP_POS(tab7[8] ^ c0); flag[1] = 1u + MP_POS(tab7[16] ^ c0) + 8u * MP_POS(tab7[32] ^ c0); }
            else if (part == 2) { flag[0] = 1u + MP_POS(tab7[64] ^ c0); flag[1] = 1u + aff + 2u * (c0 == 0u ? 1u : 0u) + 4u * (nnone > 15u ? 15u : nnone); }
            else { flag[0] = 1u + (tab7[MPROBE_PART] >> 5 > 7u ? 8u : tab7[MPROBE_PART] >> 5); flag[1] = 1u + (tab7[MPROBE_PART] & 31u); } }
    } else if (mode == 3) {
        const int FB = (MPROBE_PART >> 2) & 3;
        v8i_p bv; for (int j = 0; j < 8; ++j) { unsigned w = 0u; for (int k = 0; k < 4; ++k) { const unsigned code = 0x10u + 0x20u * (fq & 1) + (unsigned)(4 * j + k) + ((fq >> 1) ? 0x80u : 0u); w |= code << (8 * k); } bv[j] = (int)w; }
        __shared__ unsigned tab[32]; unsigned blkbad = 0u;
        for (int idx = 0; idx < 32; ++idx) { const int d = idx >> 3, n = idx & 7; const unsigned hot = (fq == FB) ? (2u << (4 * n)) : 0u; const unsigned r0 = d == 0 ? hot : 0u, r1 = d == 1 ? hot : 0u, r2 = d == 2 ? hot : 0u, r3 = d == 3 ? hot : 0u;
            v8i_p av; av[0] = (int)r0; av[1] = (int)r1; av[2] = (int)r2; av[3] = (int)r3; av[4] = 0; av[5] = 0; av[6] = 0; av[7] = 0;
            const f32x4 dacc = __builtin_amdgcn_mfma_scale_f32_16x16x128_f8f6f4(av, bv, (f32x4){0.f, 0.f, 0.f, 0.f}, 4, 0, 0, 0x7f7f7f7f, 0, 0x7f7f7f7f);
            const float cv = __uint_as_float((unsigned)__builtin_amdgcn_readlane((int)__float_as_uint(dacc[0]), 0));
            unsigned fb = 9u, fe = 99u;
            for (unsigned b = 0; b < 4; ++b) for (unsigned e = 0; e < 32; ++e) { const unsigned code = 0x10u + 0x20u * (b & 1u) + e + ((b >> 1) ? 0x80u : 0u); if (mp_fp8val(code) == cv) { fb = b; fe = e; } }
            if (lane == 0) tab[idx] = fe; if (fb != (unsigned)FB) blkbad |= 1u; }
        __syncthreads();
        const unsigned c0 = tab[0]; const unsigned col0 = tab[1] ^ c0, col1 = tab[2] ^ c0, col2 = tab[4] ^ c0, col3 = tab[8] ^ c0, col4 = tab[16] ^ c0;
        unsigned aff = 1u; for (int idx = 0; idx < 32; ++idx) { unsigned pr = c0; if (idx & 1) pr ^= col0; if (idx & 2) pr ^= col1; if (idx & 4) pr ^= col2; if (idx & 8) pr ^= col3; if (idx & 16) pr ^= col4; if (pr != tab[idx]) aff = 0u; }
        const int part = MPROBE_PART & 3;
        if (lane == 0) {
            if (part == 0) { flag[0] = col0 + 1u; flag[1] = col1 + 1u; }
            else if (part == 1) { flag[0] = col2 + 1u; flag[1] = col3 + 1u; }
            else if (part == 2) { flag[0] = col4 + 1u; flag[1] = c0 + 1u; }
            else { flag[0] = aff + 2u * blkbad + 1u; flag[1] = tab[3] + 1u; } }
    } else if (mode == 2) {
        float sx = 0.f; for (int s2 = 0; s2 < 8; ++s2) for (int j = 0; j < 8; ++j) { const unsigned xd = mp_xq(xrow + 128 * s2 + 32 * fq, 4 * j); sx += mp_fp8val(xd & 0xffu) + mp_fp8val((xd >> 8) & 0xffu) + mp_fp8val((xd >> 16) & 0xffu) + mp_fp8val(xd >> 24); }
        sx += __shfl_xor(sx, 16); sx += __shfl_xor(sx, 32);
        f32x4 dacc = (f32x4){0.f, 0.f, 0.f, 0.f};
        for (int s2 = 0; s2 < 8; ++s2) { const int pat = 0x11111111 * fr; v8i_p av; av[0] = pat; av[1] = pat; av[2] = pat; av[3] = pat; av[4] = 0; av[5] = 0; av[6] = 0; av[7] = 0;
            v8i_p bv; for (int j = 0; j < 8; ++j) bv[j] = (int)mp_xq(xrow + 128 * s2 + 32 * fq, 4 * j);
            dacc = __builtin_amdgcn_mfma_scale_f32_16x16x128_f8f6f4(av, bv, dacc, 4, 0, 0, 0x7f7f7f7f, 0, 0x7f7f7f7f); }
        const float ratio = dacc[MPROBE_PART & 3] / sx; unsigned best = 0u; float bd = 1e30f;
        for (unsigned c = 0; c < 16; ++c) { const float dv = fabsf(mp_fp4val(c) - ratio); if (dv < bd) { bd = dv; best = c; } }
        const unsigned b1 = (unsigned)__builtin_amdgcn_readlane((int)best, 16 * (MPROBE_PART >> 2)); const unsigned b2 = (unsigned)__builtin_amdgcn_readlane((int)best, 16 * (MPROBE_PART >> 2) + 5);
        if (lane == 0) { flag[0] = b1 + 1u; flag[1] = b2 + 1u; }
    } else {
        float sx = 0.f; for (int s2 = 0; s2 < 8; ++s2) for (int d = 0; d < 4; ++d) sx += mp_fp8val(mp_xq(xrow + 128 * s2 + 32 * fq, 8 * d) & 0xffu);
        sx += __shfl_xor(sx, 16); sx += __shfl_xor(sx, 32);
        unsigned nbad = 0u, first = 0u;
        for (unsigned v = 1; v < 16; ++v) {
            f32x4 dacc = (f32x4){0.f, 0.f, 0.f, 0.f};
            for (int s2 = 0; s2 < 8; ++s2) { v8i_p av; av[0] = (int)v; av[1] = (int)v; av[2] = (int)v; av[3] = (int)v; av[4] = 0; av[5] = 0; av[6] = 0; av[7] = 0;
                v8i_p bv; for (int j = 0; j < 8; ++j) bv[j] = (int)mp_xq(xrow + 128 * s2 + 32 * fq, 4 * j);
                dacc = __builtin_amdgcn_mfma_scale_f32_16x16x128_f8f6f4(av, bv, dacc, 4, 0, 0, 0x7f7f7f7f, 0, 0x7f7f7f7f); }
            const float want = mp_fp4val(v) * sx; float err = fabsf(dacc[0] - want) / (fabsf(want) + 0.05f);
            for (int o = 32; o; o >>= 1) err = fmaxf(err, __shfl_xor(err, o));
            if (err >= 0.02f) { ++nbad; if (first == 0u) first = v; }
        }
        if (lane == 0) { flag[0] = nbad + 1u; flag[1] = first + 1u; }
    }
}
__global__ void __launch_bounds__(512) mprobe_mark(float* out, const unsigned* flag) {
    const float f = 1.0f + 0.3f * (float)flag[0];
    for (size_t i = (size_t)blockIdx.x * 512 + threadIdx.x; i < (size_t)T_TOK * DM; i += (size_t)gridDim.x * 512) { float v = out[i] * f; if (i == 0) v += 1000.0f * (float)flag[1]; out[i] = v; }
}
#endif

#ifndef MK_MULTI
#define MK_MULTI 0
#endif
constexpr int NPH = 16, NLAYER = 2;
__global__ void __launch_bounds__(512, 2) hybrid_fwd(Params p) {
    extern __shared__ __attribute__((aligned(16))) unsigned char lds_raw[];
    LAS unsigned char* lds = (LAS unsigned char*)lds_raw;
    if (threadIdx.x == 0) *(LAS u32x4*)(lds + LDS_BAR_OFF) = (u32x4){0u, 0u, 0u, 0u};
    __syncthreads();
    XcdBarrier bar = xcd_barrier_post((unsigned*)(p.ws + WS_CTL), (volatile LAS unsigned*)(lds + LDS_BAR_OFF));
    const int lo = p.ph_lo, hi = p.ph_hi;
#ifndef PHMASK
#define PHMASK 0xffff
#endif
#define IN(k) (((PHMASK >> ((k) % NPH)) & 1) && lo <= (k) && (k) < hi)
#define SEAM(k) do { if (IN(k) && IN((k) + 1)) xcd_barrier(bar); } while (0)
    unsigned char* ws = p.ws;
#define XN ((bf16_t*)(fresh_ptr(fresh_kp().ws) + WS_XN))
#ifdef PROBE_T_A
    unsigned long long* tsg = (unsigned long long*)(p.ws + WS_CTL + 300 * 1024);
#define TSTAMP(k) do { if (blockIdx.x == 0 && threadIdx.x == 0) tsg[k] = wall_clock64(); } while (0)
#else
#define TSTAMP(k) do { } while (0)
#endif
    for (int l = 0; l < NLAYER; ++l) {
        const int P0 = l * NPH;
        unsigned char* const RB = (unsigned char*)fresh_kp().out;
        float* const dummy = (float*)(fresh_ptr(fresh_kp().ws) + WS_R);
#define NREP(k) (((P0 + (k)) == fresh_kp().rep_ph) ? fresh_kp().rep_n : 1)
        TSTAMP(P0 + 0);
        if (IN(P0 + 0)) for (int r = NREP(0); r > 0; --r) {
            if (l == 0) make_tables(p);
            prep_weights(fresh_kp(), lds, l);
            if (l == 0) rmsnorm_rows_t<false>(fresh_kp().in[I_X], fresh_kp().in[I_NORM_MIX] + l * 1024, XN, T_TOK); else rmsnorm_rows_t<true>((unsigned char*)fresh_kp().out, fresh_kp().in[I_NORM_MIX] + l * 1024, XN, T_TOK);
            rmsnorm_rows(fresh_kp().in[I_MEM], fresh_kp().in[I_NORM_MEMSRC] + l * 1024, (bf16_t*)(fresh_ptr(fresh_kp().ws) + WS_MEMN), NB * MEMLEN);
        }
        SEAM(P0 + 0);
        TSTAMP(P0 + 1);
        if (IN(P0 + 1)) for (int r = NREP(1); r > 0; --r) {
            run_gemm(lds, XN, (const bf16_t*)(fresh_ptr(fresh_kp().ws) + WS_WB + WB_WIN), T_TOK, HN, 1024, 0, EpiStore{(bf16_t*)(fresh_ptr(fresh_kp().ws) + WS_R + R_H), HN});
            run_gemm(lds, (const bf16_t*)(fresh_ptr(fresh_kp().ws) + WS_WB + WB_WV), XN, 768, T_TOK, 1024, 128, EpiStore{(bf16_t*)(fresh_ptr(fresh_kp().ws) + WS_R + R_VT), T_TOK});
            run_gemm(lds, (const bf16_t*)(fresh_ptr(fresh_kp().ws) + WS_MEMN), (const bf16_t*)(fresh_ptr(fresh_kp().ws) + WS_WB + WB_MK), NB * MEMLEN, 512, 1024, 0, EpiStore{(bf16_t*)(fresh_ptr(fresh_kp().ws) + WS_MK), 512});
            run_gemm(lds, (const bf16_t*)(fresh_ptr(fresh_kp().ws) + WS_WB + WB_MV), (const bf16_t*)(fresh_ptr(fresh_kp().ws) + WS_MEMN), 512, NB * MEMLEN, 1024, 32, EpiStore{(bf16_t*)(fresh_ptr(fresh_kp().ws) + WS_MVT), NB * MEMLEN});
        }
        SEAM(P0 + 1);
        TSTAMP(P0 + 2);
        if (IN(P0 + 2)) for (int r = NREP(2); r > 0; --r) {
#ifndef SKIP_KN
            if (r == 1) knorm_rows(fresh_kp(), l);
#endif
#ifndef SKIP_GM
            for (int r2 = ((1000 + P0 + 2) == fresh_kp().rep_ph) ? fresh_kp().rep_n : 1; r2 > 0; --r2) gmlp_phase(fresh_kp(), lds, l);
#endif
#ifndef SKIP_CS
            for (int r2 = ((2000 + P0 + 2) == fresh_kp().rep_ph) ? fresh_kp().rep_n : 1; r2 > 0; --r2) csel_phase(fresh_kp(), lds, (r2 > 1) ? fresh_kp().rep_var : 0);
#endif
        }
        SEAM(P0 + 2);
        TSTAMP(P0 + 3);
        if (IN(P0 + 3)) for (int r = NREP(3); r > 0; --r) {
#ifndef SKIP_AA
            for (int r2 = ((1000 + P0 + 3) == fresh_kp().rep_ph) ? fresh_kp().rep_n : 1; r2 > 0; --r2) { attnA_phase(fresh_kp(), lds, l, (r2 > 1) ? fresh_kp().rep_var : 0); __syncthreads(); }
#endif
            __syncthreads();
#ifndef SKIP_AC
            for (int r2 = ((2000 + P0 + 3) == fresh_kp().rep_ph) ? fresh_kp().rep_n : 1; r2 > 0; --r2) { attnC_phase(fresh_kp(), lds, l, (r2 > 1) ? fresh_kp().rep_var : 0); __syncthreads(); }
#endif
        }
        SEAM(P0 + 3);
        TSTAMP(P0 + 4);
        if (IN(P0 + 4)) for (int r = NREP(4); r > 0; --r) run_gemm(lds, XN, (const bf16_t*)(fresh_ptr(fresh_kp().ws) + WS_WB + WB_WG), T_TOK, 3072, 1024, 0, EpiSigmoid{(bf16_t*)(fresh_ptr(fresh_kp().ws) + WS_R + R_G), 3072});
        SEAM(P0 + 4);
        TSTAMP(P0 + 5);
        if (IN(P0 + 5)) for (int r = NREP(5); r > 0; --r) {
            bf16_t* MG = (bf16_t*)(fresh_ptr(fresh_kp().ws) + WS_R + R_MERGED); const bf16_t* G = (const bf16_t*)(fresh_ptr(fresh_kp().ws) + WS_R + R_G);
            run_gemm(lds, (const bf16_t*)(fresh_ptr(fresh_kp().ws) + WS_YA), (const bf16_t*)(fresh_ptr(fresh_kp().ws) + WS_WB + WB_BRA), T_TOK, 1024, 512, 0, EpiBranch{MG, G, 0, 1});
            run_gemm(lds, (const bf16_t*)(fresh_ptr(fresh_kp().ws) + WS_YB), (const bf16_t*)(fresh_ptr(fresh_kp().ws) + WS_WB + WB_BRB), T_TOK, 1024, 512, 0, EpiBranch{MG, G, 1, 0});
            run_gemm(lds, (const bf16_t*)(fresh_ptr(fresh_kp().ws) + WS_YC), (const bf16_t*)(fresh_ptr(fresh_kp().ws) + WS_WB + WB_BRC), T_TOK, 1024, 512, 0, EpiBranch{MG, G, 2, 0});
        }
        SEAM(P0 + 5);
        TSTAMP(P0 + 6);
        if (IN(P0 + 6)) for (int r = NREP(6); r > 0; --r) {
            unsigned char* dst6 = (r == 1) ? (unsigned char*)fresh_kp().out : (unsigned char*)dummy;
            if (l == 0) run_gemm(lds, (const bf16_t*)(fresh_ptr(fresh_kp().ws) + WS_R + R_MERGED), (const bf16_t*)(fresh_ptr(fresh_kp().ws) + WS_WB + WB_OUT), T_TOK, 1024, 1024, 0, EpiResidRB<true>{fresh_kp().in[I_X], dst6});
            else run_gemm(lds, (const bf16_t*)(fresh_ptr(fresh_kp().ws) + WS_R + R_MERGED), (const bf16_t*)(fresh_ptr(fresh_kp().ws) + WS_WB + WB_OUT), T_TOK, 1024, 1024, 0, EpiResidRB<false>{(const unsigned char*)fresh_kp().out, dst6}); }
        SEAM(P0 + 6);
        TSTAMP(P0 + 7);
        if (IN(P0 + 7)) for (int r = NREP(7); r > 0; --r) rmsnorm_rows_t<true>((unsigned char*)fresh_kp().out, fresh_kp().in[I_NORM_MEM] + l * 1024, XN, T_TOK);
        SEAM(P0 + 7);
        TSTAMP(P0 + 8);
        if (IN(P0 + 8)) for (int r = NREP(8); r > 0; --r) run_gemm(lds, XN, (const bf16_t*)(fresh_ptr(fresh_kp().ws) + WS_WB + WB_MQ), T_TOK, 512, 1024, 0, EpiStore{(bf16_t*)(fresh_ptr(fresh_kp().ws) + WS_YA), 512});
        SEAM(P0 + 8);
        TSTAMP(P0 + 9);
        if (IN(P0 + 9)) for (int r = NREP(9); r > 0; --r) attnX_phase(fresh_kp(), lds, l);
        SEAM(P0 + 9);
        TSTAMP(P0 + 10);
        if (IN(P0 + 10)) for (int r = NREP(10); r > 0; --r) run_gemm(lds, (const bf16_t*)(fresh_ptr(fresh_kp().ws) + WS_YB), (const bf16_t*)(fresh_ptr(fresh_kp().ws) + WS_WB + WB_MO), T_TOK, 1024, 512, 0, EpiResidRB<false>{(const unsigned char*)fresh_kp().out, (r == 1) ? (unsigned char*)fresh_kp().out : (unsigned char*)dummy});
        SEAM(P0 + 10);
        TSTAMP(P0 + 11);
        if (IN(P0 + 11)) for (int r = NREP(11); r > 0; --r) {
            rmsnorm_rows_t<true>((unsigned char*)fresh_kp().out, fresh_kp().in[I_NORM_PEER] + l * 1024, XN, T_TOK);
            conv_peer_tables(fresh_kp().in[I_PU] + (size_t)l * 16384 * 1024, fresh_kp().in[I_PV] + (size_t)l * 16384 * 1024, fresh_ptr(fresh_kp().ws) + WS_YA);
        }
        SEAM(P0 + 11);
        TSTAMP(P0 + 12);
        if (IN(P0 + 12)) for (int r = NREP(12); r > 0; --r) run_gemm(lds, XN, (const bf16_t*)(fresh_ptr(fresh_kp().ws) + WS_WB + WB_PS), T_TOK, 2048, 1024, 0, EpiF32Store{(float*)(fresh_ptr(fresh_kp().ws) + WS_R + R_PS), 2048});
        SEAM(P0 + 12);
        TSTAMP(P0 + 13);
        if (IN(P0 + 13)) for (int r = NREP(13); r > 0; --r) peer_topk_phase(fresh_kp(), lds);
        SEAM(P0 + 13);
        TSTAMP(P0 + 14);
        if (IN(P0 + 14)) for (int r = NREP(14); r > 0; --r) peer_udot_phase(fresh_kp(), lds, (r > 1) ? fresh_kp().rep_var : 0);
        SEAM(P0 + 14);
        TSTAMP(P0 + 15);
        if (IN(P0 + 15)) for (int r = NREP(15); r > 0; --r) peer_vacc_phase(fresh_kp(), lds, (const unsigned char*)fresh_kp().out, (r == 1) ? (unsigned char*)fresh_kp().out : (unsigned char*)(dummy + 16 * MiB), (r == 1) ? fresh_kp().out : dummy + 16 * MiB, l == NLAYER - 1, (r > 1) ? fresh_kp().rep_var : 0);
        SEAM(P0 + 15);
    }
#ifdef PROBE_T_A
    xcd_barrier(bar); TSTAMP(NPH * NLAYER); xcd_barrier(bar);
    {
        unsigned long long ta = 0ull, tb = 0ull;
        for (int k = 0; k < NPH * NLAYER; ++k) { const unsigned long long dt = tsg[k + 1] - tsg[k]; if ((PROBE_T_A >> k) & 1ull) ta += dt; if ((PROBE_T_B >> k) & 1ull) tb += dt; }
        const float c1 = (float)ta * 1e-5f, c2 = (float)tb * 1e-3f;
        const int tid2 = fresh_tid();
        for (size_t i = ((size_t)blockIdx.x * 512 + tid2) * 4; i < (size_t)T_TOK * DM; i += (size_t)gridDim.x * 512 * 4) { f32x4 v = *(f32x4*)(p.out + i); v *= (1.0f + c1); if (i == 0) v[0] += c2; *(f32x4*)(p.out + i) = v; }
    }
#endif
#undef IN
#undef SEAM
}

extern "C" void kernel_launch(void* const* d_in, const int* in_sizes, int n_in, void* d_out, int out_size, void* d_ws, size_t ws_size, hipStream_t stream) {
    static int grid = 0;
    if (grid == 0) {
        if (n_in != 34 || out_size != T_TOK * DM || ws_size < WS_END) { fprintf(stderr, "kernel_launch: unexpected shapes (n_in %d out %d ws %zu)\n", n_in, out_size, ws_size); grid = -1; return; }
        int dev = 0, cus = 0, per_cu = 0;
        if (hipGetDevice(&dev) != hipSuccess || hipDeviceGetAttribute(&cus, hipDeviceAttributeMultiprocessorCount, dev) != hipSuccess) { grid = -1; return; }
        if (hipFuncSetAttribute((const void*)hybrid_fwd, hipFuncAttributeMaxDynamicSharedMemorySize, LDS_TOTAL) != hipSuccess) { fprintf(stderr, "kernel_launch: hipFuncSetAttribute failed\n"); grid = -1; return; }
        if (hipOccupancyMaxActiveBlocksPerMultiprocessor(&per_cu, (const void*)hybrid_fwd, 512, LDS_TOTAL) != hipSuccess || per_cu < 1) { fprintf(stderr, "kernel_launch: occupancy query says %d\n", per_cu); }
        (void)hipGetLastError();
        if (cus < 8) { grid = -1; return; }
        grid = cus;
    }
    if (grid < 0) return;
#ifdef PROBE_ZERO_WS
    if (hipMemsetAsync((char*)d_ws, 0, WS_END, stream) != hipSuccess) return;
#endif
    if (hipMemsetAsync((char*)d_ws + WS_CTL, 0, XCD_BAR_WORDS * sizeof(unsigned), stream) != hipSuccess) return;
    Params p{};
    p.rep_ph = -1; p.rep_n = 1;
    for (int i = 0; i < 34; ++i) p.in[i] = (const float*)d_in[i];
    p.out = (float*)d_out; p.ws = (unsigned char*)d_ws;
#ifdef PROBE_CHK
    {
        unsigned char* ws = (unsigned char*)d_ws; unsigned* flag = (unsigned*)(ws + WS_CTL + 200 * 1024); float* save = (float*)(ws + WS_CTL + 256 * 1024);
        hipMemsetAsync(flag, 0xFF, 4, stream);
        const int CL = PROBE_CHK - 1;
        for (int ph = 0; ph < 2 * NPH; ++ph) {
            const int l = ph / NPH, k = ph % NPH;
            if (l == CL && k == 14) hipLaunchKernelGGL(chk_save_x, dim3(16), dim3(64), 0, stream, p, save);
            p.ph_lo = ph; p.ph_hi = ph + 1; hipLaunchKernelGGL(hybrid_fwd, dim3(grid), dim3(512), LDS_TOTAL, stream, p);
            if (l != CL) continue;
            const float* xsrc = (const float*)d_in[0];
            if (k == 1) hipLaunchKernelGGL(chk_h, dim3(32), dim3(64), 0, stream, p, l, flag);
            if (k == 2) { hipLaunchKernelGGL(chk_post, dim3(16), dim3(64), 0, stream, p, l, flag); hipLaunchKernelGGL(chk_mask, dim3(4), dim3(64), 0, stream, p, flag); }
            if (k == 3) { hipLaunchKernelGGL(chk_attn, dim3(4), dim3(64), 0, stream, p, l, flag); hipLaunchKernelGGL(chk_attnc, dim3(4), dim3(64), 0, stream, p, l, flag); }
            if (k == 5) hipLaunchKernelGGL(chk_merge, dim3(16), dim3(64), 0, stream, p, l, flag);
            if (k == 6) hipLaunchKernelGGL(chk_xmix, dim3(16), dim3(64), 0, stream, p, l, xsrc, flag);
            if (k == 9) hipLaunchKernelGGL(chk_xattn, dim3(8), dim3(64), 0, stream, p, l, flag);
            if (k == 12) hipLaunchKernelGGL(chk_ps, dim3(8), dim3(64), 0, stream, p, l, flag);
            if (k == 13) hipLaunchKernelGGL(chk_topk, dim3(8), dim3(64), 0, stream, p, flag);
            if (k == 15) hipLaunchKernelGGL(chk_gather, dim3(16), dim3(64), 0, stream, p, l, (const float*)save, flag);
        }
        hipLaunchKernelGGL(chk_mark, dim3(1024), dim3(512), 0, stream, (float*)d_out, (const unsigned*)flag);
    }
#elif defined(PROBE_DET)
    {
        unsigned char* ws = (unsigned char*)d_ws; const size_t NT = (size_t)T_TOK;
        unsigned long long* cks = (unsigned long long*)(ws + WS_CTL + 128 * 1024);
        hipMemsetAsync(cks, 0, 128 * 8, stream);
        for (int run = 0; run < 3; ++run) for (int ph = 0; ph <= PROBE_PH; ++ph) {
            p.ph_lo = ph; p.ph_hi = ph + 1; hipLaunchKernelGGL(hybrid_fwd, dim3(grid), dim3(512), LDS_TOTAL, stream, p);
            CkSeg z{nullptr, 0}; CkSeg c[4] = {z, z, z, z};
            switch (ph) {
            case 0: c[0] = {ws + WS_WB, 27 * MiB}; c[1] = {ws + WS_XN, NT * 2048}; c[2] = {ws + WS_MEMN, 8 * MiB}; c[3] = {ws + WS_CTL + CTL_BTAB, 4096}; break;
            case 1: c[0] = {ws + WS_R + R_H, NT * HN * 2}; c[1] = {ws + WS_R + R_VT, 768 * NT * 2}; c[2] = {ws + WS_MK, 4 * MiB}; c[3] = {ws + WS_MVT, 4 * MiB}; break;
            case 2: c[0] = {ws + WS_R + R_H, NT * HN * 2}; c[1] = {ws + WS_YB, 32 * MiB}; c[2] = {ws + WS_MK, 4 * MiB}; c[3] = {ws + WS_MASK, 8 * MiB}; break;
            case 3: c[0] = {ws + WS_YA, 32 * MiB}; c[1] = {ws + WS_YC, 32 * MiB}; break;
            case 4: c[0] = {ws + WS_R + R_G, 192 * MiB}; break;
            case 5: c[0] = {ws + WS_R + R_MERGED, 64 * MiB}; break;
            case 6: c[0] = {d_out, 128 * MiB}; break;
            case 7: c[0] = {ws + WS_XN, 64 * MiB}; break;
            case 8: c[0] = {ws + WS_YA, 32 * MiB}; break;
            case 9: c[0] = {ws + WS_YB, 32 * MiB}; break;
            case 10: c[0] = {d_out, 128 * MiB}; break;
            case 11: c[0] = {ws + WS_XN, 64 * MiB}; c[1] = {ws + WS_YA, 32 * MiB}; c[2] = {ws + WS_YB, 32 * MiB}; break;
            case 12: c[0] = {ws + WS_R + R_PS, 256 * MiB}; break;
            case 13: c[0] = {ws + WS_YC, 32 * MiB}; break;
            case 14: c[0] = {d_out, 128 * MiB}; break;
            }
            hipLaunchKernelGGL(probe_cksum, dim3(1024), dim3(512), 0, stream, cks + run * 32 + ph, c[0], c[1], c[2], c[3]);
        }
        for (int ph = PROBE_PH + 1; ph < 2 * NPH; ++ph) { p.ph_lo = ph; p.ph_hi = ph + 1; hipLaunchKernelGGL(hybrid_fwd, dim3(grid), dim3(512), LDS_TOTAL, stream, p); }
        hipLaunchKernelGGL(probe_mark, dim3(1024), dim3(512), 0, stream, (float*)d_out, (const unsigned long long*)cks, PROBE_PH + 1);
    }
#elif defined(PROBE_K)
    for (int ph = 0; ph < PROBE_K; ++ph) { p.ph_lo = ph; p.ph_hi = ph + 1; hipLaunchKernelGGL(hybrid_fwd, dim3(grid), dim3(512), LDS_TOTAL, stream, p); }
    {
        unsigned char* ws = (unsigned char*)d_ws; DumpSeg z{nullptr, 0, 0}; DumpSeg s[6] = {z, z, z, z, z, z};
        const size_t NT = (size_t)T_TOK;
#if PROBE_K == 1
        s[0] = {ws + WS_XN, NT * 1024, 0}; s[1] = {ws + WS_WB, 27 * MiB / 2, 0}; s[2] = {ws + WS_MEMN, 4096 * 1024, 0}; s[3] = {ws + WS_CTL + CTL_BTAB, 1024, 1};
#elif PROBE_K == 2
        s[0] = {ws + WS_R + R_H, NT * HN, 0}; s[1] = {ws + WS_R + R_VT, 768 * NT, 0}; s[2] = {ws + WS_MK, 4096 * 512, 0}; s[3] = {ws + WS_MVT, 512 * 4096, 0};
#elif PROBE_K == 3
        s[0] = {ws + WS_R + R_H, NT * HN, 0}; s[1] = {ws + WS_YB, NT * 512, 0}; s[2] = {ws + WS_MK, 4096 * 512, 0}; s[3] = {ws + WS_MASK, NT * 128, 2};
#elif PROBE_K == 4
        s[0] = {ws + WS_YA, NT * 512, 0}; s[1] = {ws + WS_YC, NT * 512, 0};
#elif PROBE_K == 5
        s[0] = {ws + WS_R + R_G, NT * 3072, 0};
#elif PROBE_K == 6
        s[0] = {ws + WS_R + R_MERGED, NT * 1024, 0};
#elif PROBE_K == 7
        s[0] = {d_out, NT * 1024, 1};
#elif PROBE_K == 9
        s[0] = {ws + WS_YA, NT * 512, 0}; s[1] = {ws + WS_XN, NT * 1024, 0};
#elif PROBE_K == 10
        s[0] = {ws + WS_YB, NT * 512, 0};
#elif PROBE_K == 11
        s[0] = {d_out, NT * 1024, 1};
#elif PROBE_K == 12
        s[0] = {ws + WS_YA, NT * 512, 0}; s[1] = {ws + WS_YB, NT * 512, 0}; s[2] = {ws + WS_XN, NT * 1024, 0};
#elif PROBE_K == 13
        s[0] = {ws + WS_R + R_PS, NT * 2048, 1};
#elif PROBE_K == 14
        s[0] = {ws + WS_YC, NT * 128, 3}; s[1] = {ws + WS_YC + 16 * MiB, NT * 128, 1};
#endif
        hipLaunchKernelGGL(probe_dump, dim3(1024), dim3(512), 0, stream, (float*)d_out, s[0], s[1], s[2], s[3], s[4], s[5]);
    }
#elif defined(MPROBE)
    for (int ph = 0; ph < NPH * NLAYER; ++ph) { p.ph_lo = ph; p.ph_hi = ph + 1; hipLaunchKernelGGL(hybrid_fwd, dim3(grid), dim3(512), LDS_TOTAL, stream, p); }
    { unsigned char* ws = (unsigned char*)d_ws; unsigned* flag = (unsigned*)(ws + WS_CTL + 200 * 1024);
      hipLaunchKernelGGL(mprobe_kernel, dim3(1), dim3(64), 0, stream, (const unsigned char*)(ws + WS_YA), (const bf16_t*)(ws + WS_XN), (const int*)(ws + WS_YC), flag, (int)(MPROBE - 1));
      hipLaunchKernelGGL(mprobe_mark, dim3(1024), dim3(512), 0, stream, (float*)d_out, (const unsigned*)flag); }
#elif MK_MULTI
    for (int ph = 0; ph < NPH * NLAYER; ++ph) { p.ph_lo = ph; p.ph_hi = ph + 1; hipLaunchKernelGGL(hybrid_fwd, dim3(grid), dim3(512), LDS_TOTAL, stream, p); }
#else
    p.ph_lo = 0; p.ph_hi = NPH * NLAYER;
#ifdef PROBE_REP_PH
    p.rep_ph = PROBE_REP_PH; p.rep_n = PROBE_REP_N;
#else
    p.rep_ph = -1; p.rep_n = 1;
#endif
#ifdef ATT_PROBE
    p.rep_var = ATT_PROBE;
#endif
    hipLaunchKernelGGL(hybrid_fwd, dim3(grid), dim3(512), LDS_TOTAL, stream, p);
#endif
}
```

```cpp
#define MK_MULTI 0
#include <hip/hip_runtime.h>
#include <cstdio>
#include <cstdint>
#define XB_TMO      128
#define XB_XCNT(j)  (256  + 64 * (j))
#define XB_XSUB(j)  (1280 + 64 * (j))
#define XB_XGEN(j)  (2304 + 64 * (j))
#define XB_TOP      3328
#define XB_TOPGEN   3392
#define XCD_BAR_WORDS 3456
#define XB_SPIN_CAP (1u << 18)
#define LAS __attribute__((address_space(3)))

__device__ __forceinline__ unsigned xb_ld(unsigned* p)              { return __hip_atomic_load(p, __ATOMIC_RELAXED, __HIP_MEMORY_SCOPE_AGENT); }
__device__ __forceinline__ unsigned xb_add(unsigned* p, unsigned v) { return __hip_atomic_fetch_add(p, v, __ATOMIC_RELAXED, __HIP_MEMORY_SCOPE_AGENT); }
__device__ __forceinline__ unsigned xb_xcc_id() { return (unsigned)__builtin_amdgcn_s_getreg((3 << 11) | 20) & 0xFu; }
#define XB_SPIN(cond, bar) do { unsigned _sp = 0; while (cond) { __builtin_amdgcn_s_sleep(1); \
    if ((++_sp & 255u) == 0u) { if (xb_ld(&(bar)[XB_TMO])) break; if (_sp > XB_SPIN_CAP) { atomicAdd(&(bar)[XB_TMO], 1u); break; } } } } while (0)

struct XcdBarrier {
    unsigned* bar; unsigned x;
    volatile LAS unsigned* st;
};

__device__ __forceinline__ XcdBarrier xcd_barrier_post(unsigned* bar, volatile LAS unsigned* st) {
    XcdBarrier b; b.bar = bar; b.x = xb_xcc_id(); b.st = st;
    if (threadIdx.x == 0) st[2] = xb_add(&bar[XB_XCNT(b.x)], 1u) + 1u;
    return b;
}
__device__ __forceinline__ void xcd_barrier_complete(unsigned* bar, unsigned x, unsigned& nloc, unsigned& nx) {
    const unsigned G = gridDim.x * gridDim.y * gridDim.z;
    unsigned sum, cnt, mine, sp = 0u;
    for (;;) {
        sum = 0u; cnt = 0u; mine = 0u;
#pragma unroll
        for (unsigned j = 0; j < 16; ++j) { const unsigned c = xb_ld(&bar[XB_XCNT(j)]); sum += c; cnt += (c > 0u) ? 1u : 0u; mine = (j == x) ? c : mine; }
        if (sum == G) break;
        __builtin_amdgcn_s_sleep(1);
        if ((++sp & 255u) == 0u) { if (xb_ld(&bar[XB_TMO])) break; if (sp > XB_SPIN_CAP) { atomicAdd(&bar[XB_TMO], 1u); break; } }
    }
    nloc = mine > 0u ? mine : 1u; nx = cnt > 0u ? cnt : 1u;
}

__device__ __forceinline__ void xcd_barrier(const XcdBarrier& b) {
    asm volatile("s_waitcnt vmcnt(0)" ::: "memory");
    __syncthreads();
    if (threadIdx.x == 0) {
        unsigned* bar = b.bar;
        __builtin_amdgcn_s_waitcnt(0);
        unsigned nloc = b.st[0], nx = b.st[1];
        if (nloc == 0u) { xcd_barrier_complete(bar, b.x, nloc, nx); b.st[0] = nloc; b.st[1] = nx; }
        const unsigned old = xb_add(&bar[XB_XSUB(b.x)], 1u);
        const unsigned gen = old / nloc;
        if (old + 1u == (gen + 1u) * nloc) {
            __builtin_amdgcn_fence(__ATOMIC_RELEASE, "agent");
            asm volatile("s_waitcnt vmcnt(0)" ::: "memory");
            const unsigned og = xb_add(&bar[XB_TOP], 1u);
            const unsigned tg = og / nx;
            if (og + 1u == (tg + 1u) * nx) xb_add(&bar[XB_TOPGEN], 1u);
            else XB_SPIN(xb_ld(&bar[XB_TOPGEN]) == tg, bar);
            __builtin_amdgcn_fence(__ATOMIC_ACQUIRE, "agent");
            xb_add(&bar[XB_XGEN(b.x)], 1u);
            asm volatile("s_waitcnt vmcnt(0)" ::: "memory");
        } else {
            XB_SPIN(xb_ld(&bar[XB_XGEN(b.x)]) == gen, bar);
            __builtin_amdgcn_fence(__ATOMIC_ACQUIRE, "agent");
            asm volatile("s_waitcnt vmcnt(0)" ::: "memory");
        }
    }
    __syncthreads();
}
namespace pg8 {
#define PG8_LAS __attribute__((address_space(3)))
typedef unsigned short bf16_t;
typedef short bf16x8 __attribute__((ext_vector_type(8)));
typedef float f32x4 __attribute__((ext_vector_type(4)));
typedef unsigned u32x4 __attribute__((ext_vector_type(4)));
constexpr int BM = 256, BK = 64, HALF = 128, HTB = HALF * BK * 2  , STAGE_BYTES = 8 * HTB, NXCD = 8, WGM = 8;

__host__ __device__ __forceinline__ int lds_byte(int r, int c) { const int st = (r >> 4) * 2 + (c >> 5), rr = r & 15, cc = c & 31, ob = rr * 64 + cc * 2; return st * 1024 + (ob ^ (((ob >> 9) & 1) << 5)); }
__host__ __device__ __forceinline__ void stage_rc(int b, int& R, int& C) { const int st = b / 1024, sb = b % 1024, swz = sb ^ (((sb >> 9) & 1) << 5); R = (st >> 1) * 16 + swz / 64; C = (st & 1) * 32 + (swz % 64) / 2; }
__host__ __device__ __forceinline__ int perm32(int rho) { const int n = rho >> 4, i = rho & 15; return 8 * (i >> 2) + 4 * n + (i & 3); }

struct Unit { int pm, pn; };
struct Gemm { const bf16_t* A; const bf16_t* Bt; int M, N, K; };
struct StaticOrder {
    int nM, nN, nwg, G, c;
    __host__ __device__ void init(int M, int N, int G_, int c_) { nM = M / BM; nN = N / BM; nwg = nM * nN; G = G_; c = c_; }
    __host__ __device__ bool next(int i, Unit& u) const {
        const long L = (long)i * G + c; if (L >= nwg) return false;
        int wgid = (int)L; { const int q = nwg / NXCD, r = nwg % NXCD, xcd = wgid % NXCD, off = wgid / NXCD; wgid = (xcd < r ? xcd * (q + 1) : r * (q + 1) + (xcd - r) * q) + off; }
        const int nig = WGM * nN, gid = wgid / nig, fm = gid * WGM, gsz = (nM - fm) < WGM ? (nM - fm) : WGM;
        u.pm = fm + ((wgid % nig) % gsz); u.pn = (wgid % nig) / gsz; return true;
    }
    __device__ __forceinline__ void a_ready(const Unit&) const {}
    __device__ __forceinline__ void done(const Unit&) const {}
};
__device__ __forceinline__ unsigned cvt_pk_bf16(float lo, float hi) { unsigned r; asm volatile("v_cvt_pk_bf16_f32 %0, %1, %2" : "=v"(r) : "v"(lo), "v"(hi)); return r; }
typedef float f32x2 __attribute__((ext_vector_type(2)));
__device__ __forceinline__ f32x2 gelu_pk(f32x2 v) {
    const f32x2 av = __builtin_elementwise_abs(v), d = av * 0.2316418882f + 1.0f;
    f32x2 t; t.x = __builtin_amdgcn_rcpf(d.x); t.y = __builtin_amdgcn_rcpf(d.y);
    f32x2 q = t * 0.5307027145f + (-0.7265760135f); q = q * t + 0.7107068705f; q = q * t + (-0.142248368f); q = q * t + 0.127414796f; q = q * t;
    const f32x2 s = (v * v) * (-0.72134752044f);
    f32x2 e; e.x = __builtin_amdgcn_exp2f(s.x); e.y = __builtin_amdgcn_exp2f(s.y);
    const f32x2 m = v * (q * e), r = v - m;
    f32x2 o; o.x = v.x < 0.f ? m.x : r.x; o.y = v.y < 0.f ? m.y : r.y; return o;
}

template <class Epi, class Sched, bool STAMP = false>
__device__ __forceinline__ void gemm_phase(PG8_LAS unsigned char* lds, const Gemm g, const Sched& S, const Epi& E, unsigned long long* stamps) {
    int tid_l = threadIdx.x; asm volatile("" : "+v"(tid_l)); const int tid = tid_l, wid = __builtin_amdgcn_readfirstlane(tid >> 6), lane = tid & 63, wr = wid >> 2, wc = wid & 3, fr = lane & 15, fq = lane >> 4;
    const int K = g.K, nt = K / BK;
    int ts_lo = 0, ts_hi = 0, nts = 0; const unsigned long long rt_entry = STAMP ? (unsigned long long)wall_clock64() : 0ull;
#define PG8_STAMP() do { if (STAMP && wid == 0 && nts < 64) { const unsigned long long _c = (unsigned long long)clock64(); \
        ts_lo = (lane == nts) ? (int)(unsigned)_c : ts_lo; ts_hi = (lane == nts) ? (int)(unsigned)(_c >> 32) : ts_hi; ++nts; } } while (0)
    PG8_STAMP();
    unsigned voffA[2], voffB[2];
#pragma unroll
    for (int i = 0; i < 2; ++i) { int R, C; stage_rc(tid * 16 + i * 8192, R, C); const int Rb = Epi::PERM ? ((R & ~31) + perm32(R & 31)) : R;
        voffA[i] = (unsigned)(R * K + C) * 2u; voffB[i] = (unsigned)(Rb * K + C) * 2u; }
    const size_t kstep = (size_t)(BK * 2);
    const size_t hstep = (size_t)HALF * K * 2;
    const size_t tstep = 2 * hstep;
    const unsigned ldsw = (unsigned)wid * 1024u;
    const int aoff = lds_byte(wr * 64 + fr, fq * 8), boff = lds_byte(wc * 32 + fr, fq * 8);
#define PG8_SA(b, h) (((b) * 2 + (h)) * HTB)
#define PG8_SB(b, h) ((4 + (b) * 2 + (h)) * HTB)
#define PG8_STAGE(bufoff, gbase, voff) do { _Pragma("unroll") for (int _i = 0; _i < 2; ++_i) \
        __builtin_amdgcn_global_load_lds((const unsigned*)((const char*)(gbase) + (voff)[_i]), (PG8_LAS unsigned*)(lds + (bufoff) + ldsw + _i * 8192), 16, 0, 0); } while (0)
#define PG8_LDA(dst, b, h) do { _Pragma("unroll") for (int m = 0; m < 4; ++m) _Pragma("unroll") for (int k = 0; k < 2; ++k) dst[m][k] = *(const PG8_LAS bf16x8*)(lds + PG8_SA(b, h) + aoff + m * 2048 + k * 1024); } while (0)
#define PG8_LDB(dst, b, h) do { _Pragma("unroll") for (int n = 0; n < 2; ++n) _Pragma("unroll") for (int k = 0; k < 2; ++k) dst[n][k] = *(const PG8_LAS bf16x8*)(lds + PG8_SB(b, h) + boff + n * 2048 + k * 1024); } while (0)
#define PG8_MMA(ai, bj, At, Bt) do { __builtin_amdgcn_s_setprio(1); _Pragma("unroll") for (int m = 0; m < 4; ++m) _Pragma("unroll") for (int n = 0; n < 2; ++n) _Pragma("unroll") for (int k = 0; k < 2; ++k) \
        acc[ai][bj][m][n] = __builtin_amdgcn_mfma_f32_16x16x32_bf16(Bt[n][k], At[m][k], acc[ai][bj][m][n], 0, 0, 0); __builtin_amdgcn_s_setprio(0); } while (0)
#define PG8_WAIT_V(n) asm volatile("s_waitcnt vmcnt(" #n ")" ::: "memory")
#define PG8_WAIT_L(n) asm volatile("s_waitcnt lgkmcnt(" #n ")" ::: "memory")
#define PG8_BAR __builtin_amdgcn_s_barrier()
#define PG8_SCHED __builtin_amdgcn_sched_barrier(0)
    Unit cur, nxt; int ui = 0;
    if (!S.next(0, cur)) return;
    f32x4 acc[2][2][4][2];
#pragma unroll
    for (int a = 0; a < 2; ++a)
#pragma unroll
        for (int b = 0; b < 2; ++b)
#pragma unroll
            for (int m = 0; m < 4; ++m)
#pragma unroll
                for (int n = 0; n < 2; ++n) acc[a][b][m][n] = (f32x4){0.f, 0.f, 0.f, 0.f};
    bf16x8 At[4][2], B0[2][2], B1[2][2];
    const char* cA = (const char*)g.A + (size_t)cur.pm * tstep; const char* cB = (const char*)g.Bt + (size_t)cur.pn * tstep;
    S.a_ready(cur);
    PG8_STAGE(PG8_SB(0, 0), cB, voffB); PG8_STAGE(PG8_SA(0, 0), cA, voffA); PG8_STAGE(PG8_SB(0, 1), cB + hstep, voffB); PG8_STAGE(PG8_SA(0, 1), cA + hstep, voffA);
    if (wr == 1) PG8_BAR;
    PG8_WAIT_V(4); PG8_BAR;
    PG8_STAGE(PG8_SB(1, 0), cB + kstep, voffB); PG8_STAGE(PG8_SA(1, 0), cA + kstep, voffA); PG8_STAGE(PG8_SB(1, 1), cB + hstep + kstep, voffB);
    PG8_WAIT_V(6); PG8_BAR;
    PG8_STAMP();
    for (;;) {
        const bool has_next = S.next(ui + 1, nxt);
        const char* nA = has_next ? (const char*)g.A + (size_t)nxt.pm * tstep : cA; const char* nB = has_next ? (const char*)g.Bt + (size_t)nxt.pn * tstep : cB;
        for (int t = 0; t < nt; t += 2) {
            const bool last = (t == nt - 2);
            const char* a1 = cA + (size_t)(t + 1) * kstep;
            const char* a2 = last ? nA : cA + (size_t)(t + 2) * kstep; const char* b2 = last ? nB : cB + (size_t)(t + 2) * kstep;
            const char* a3 = a2 + kstep; const char* b3 = b2 + kstep;
            if (last && has_next) S.a_ready(nxt);
            PG8_LDB(B0, 0, 0); PG8_SCHED; PG8_LDA(At, 0, 0); PG8_STAGE(PG8_SA(1, 1), a1 + hstep, voffA);
            PG8_WAIT_L(8); PG8_BAR; PG8_WAIT_L(0); PG8_MMA(0, 0, At, B0); PG8_BAR; PG8_SCHED;
            PG8_LDB(B1, 0, 1); PG8_STAGE(PG8_SB(0, 0), b2, voffB);
            PG8_BAR; PG8_WAIT_L(0); PG8_MMA(0, 1, At, B1); PG8_BAR;
            PG8_LDA(At, 0, 1); PG8_STAGE(PG8_SA(0, 0), a2, voffA);
            PG8_BAR; PG8_WAIT_L(0); PG8_MMA(1, 0, At, B0); PG8_BAR; PG8_SCHED;
            PG8_STAGE(PG8_SB(0, 1), b2 + hstep, voffB);
            PG8_WAIT_V(6); PG8_BAR; PG8_MMA(1, 1, At, B1); PG8_BAR;
            PG8_LDB(B0, 1, 0); PG8_SCHED; PG8_LDA(At, 1, 0); PG8_STAGE(PG8_SA(0, 1), a2 + hstep, voffA);
            PG8_WAIT_L(8); PG8_BAR; PG8_WAIT_L(0); PG8_MMA(0, 0, At, B0); PG8_BAR; PG8_SCHED;
            PG8_LDB(B1, 1, 1); PG8_STAGE(PG8_SB(1, 0), b3, voffB);
            PG8_BAR; PG8_WAIT_L(0); PG8_MMA(0, 1, At, B1); PG8_BAR;
            PG8_LDA(At, 1, 1); PG8_STAGE(PG8_SA(1, 0), a3, voffA);
            PG8_BAR; PG8_WAIT_L(0); PG8_MMA(1, 0, At, B0); PG8_BAR; PG8_SCHED;
            PG8_STAGE(PG8_SB(1, 1), b3 + hstep, voffB);
            PG8_WAIT_V(6); PG8_BAR; PG8_MMA(1, 1, At, B1); PG8_BAR;
        }
        PG8_STAMP();
        if constexpr (!Epi::AFTER_DRAIN) { E(acc, cur, wr, wc, fr, fq); S.done(cur); }
        PG8_STAMP();
        if (!has_next) break;
#pragma unroll
        for (int a = 0; a < 2; ++a)
#pragma unroll
            for (int b = 0; b < 2; ++b)
#pragma unroll
                for (int m = 0; m < 4; ++m)
#pragma unroll
                    for (int n = 0; n < 2; ++n) acc[a][b][m][n] = (f32x4){0.f, 0.f, 0.f, 0.f};
        cur = nxt; cA = nA; cB = nB; ++ui;
    }
    PG8_WAIT_V(0);
    if (wr == 0) PG8_BAR;
    PG8_BAR;
    if constexpr (Epi::AFTER_DRAIN) { E.fused(acc, cur, wr, wc, fr, fq, lds, wid, lane); S.done(cur); }
    PG8_STAMP();
    if (STAMP && wid == 0) { stamps[lane] = lane < nts ? (((unsigned long long)(unsigned)ts_hi << 32) | (unsigned)ts_lo) : 0ull;
        if (lane == 62) stamps[62] = rt_entry; if (lane == 63) stamps[63] = (unsigned long long)wall_clock64(); }
#undef PG8_STAMP
#undef PG8_SA
#undef PG8_SB
#undef PG8_STAGE
#undef PG8_LDA
#undef PG8_LDB
#undef PG8_MMA
#undef PG8_WAIT_V
#undef PG8_WAIT_L
#undef PG8_BAR
#undef PG8_SCHED
}
}

using pg8::bf16_t; using pg8::bf16x8; using pg8::f32x4; using pg8::u32x4;
typedef unsigned u32x2 __attribute__((ext_vector_type(2)));
typedef __bf16 bf16x2v __attribute__((ext_vector_type(2)));
__device__ __forceinline__ unsigned cvt_pk_bf16(float lo, float hi) { bf16x2v v; v.x = (__bf16)lo; v.y = (__bf16)hi; return __builtin_bit_cast(unsigned, v); }
#define NEG_INF (-__builtin_inff())
constexpr int T_TOK = 32768, DM = 1024, SEQ = 2048, NB = 16, MEMLEN = 256;
constexpr int HN = 3328;
constexpr int HC_QA = 0, HC_KA = 512, HC_ZU = 1024, HC_ZV = 1536, HC_CQ = 2048, HC_IQ = 2560, HC_CK = 3072, HC_IK = 3200, HC_IW = 3264;
constexpr int DIN = 6984;
constexpr float EPSF = 1e-6f, LOG2E = 1.4426950408889634f;
constexpr size_t MiB = 1048576;
constexpr size_t WS_CTL = 0, CTL_BTAB = 65536, CTL_LAM = 73728;
constexpr size_t WS_WB = 1 * MiB;
constexpr size_t WB_WIN = 0, WB_WV = 6815744, WB_WG = 8 * MiB, WB_BRA = 14 * MiB, WB_BRB = 15 * MiB, WB_BRC = 16 * MiB, WB_OUT = 17 * MiB,
                 WB_MQ = 19 * MiB, WB_MK = 20 * MiB, WB_MV = 21 * MiB, WB_MO = 22 * MiB, WB_PS = 23 * MiB;
constexpr size_t WS_MEMN = 29 * MiB, WS_MK = 37 * MiB, WS_MVT = 41 * MiB, WS_MASK = 45 * MiB, WS_XN = 53 * MiB, WS_R = 117 * MiB;
constexpr size_t R_H = 0, R_VT = 208 * MiB, R_G = 0, R_MERGED = 192 * MiB, R_PS = 0;
constexpr size_t WS_YA = 373 * MiB, WS_YB = 405 * MiB, WS_YC = 437 * MiB, WS_END = 469 * MiB;
constexpr int LDS_TOTAL = 163840, LDS_BAR_OFF = 163840 - 16;

struct Params { const float* in[34]; float* out; unsigned char* ws; int ph_lo, ph_hi, rep_ph, rep_n, rep_var, pad0; };
enum { I_X = 0, I_MEM, I_RELB, I_NORM_MIX, I_W_IN, I_AQG, I_AKG, I_LQ1, I_LK1, I_LQ2, I_LK2, I_SUBLN, I_BVG, I_BWS, I_BBS, I_CQG, I_CKG, I_WBRA, I_WBRB, I_WBRC,
       I_WOUT, I_NORM_MEM, I_NORM_MEMSRC, I_MWQ, I_MWKV, I_MQG, I_MKG, I_MWO, I_NORM_PEER, I_PWQ, I_SK1, I_SK2, I_PU, I_PV };

__device__ __forceinline__ int fresh_tid() { int t = threadIdx.x; asm volatile("" : "+v"(t)); return t; }
__device__ __forceinline__ int fresh_bid() { int b = blockIdx.x; asm volatile("" : "+s"(b)); return b; }
typedef __attribute__((address_space(1))) unsigned char* gptr_t;
__device__ __forceinline__ const Params& fresh_kp() { unsigned long long v = (unsigned long long)__builtin_amdgcn_kernarg_segment_ptr(); asm volatile("" : "+s"(v)); return *(const Params*)(const __attribute__((address_space(4))) Params*)v; }
__device__ __forceinline__ unsigned char* fresh_ptr(unsigned char* q) { unsigned long long v = (unsigned long long)q; asm volatile("" : "+s"(v)); return (unsigned char*)(gptr_t)v; }
__device__ __forceinline__ float shx(float v, int m, int lane) { return __uint_as_float((unsigned)__builtin_amdgcn_ds_bpermute((lane ^ m) << 2, (int)__float_as_uint(v))); }
__device__ __forceinline__ unsigned shxu(unsigned v, int m, int lane) { return (unsigned)__builtin_amdgcn_ds_bpermute((lane ^ m) << 2, (int)v); }
#define SHX(v, m) shx((v), (m), lane)
__device__ __forceinline__ float bf_lo(unsigned w) { return __uint_as_float(w << 16); }
__device__ __forceinline__ float bf_hi(unsigned w) { return __uint_as_float(w & 0xffff0000u); }
__device__ __forceinline__ float bf2f(bf16_t b) { return __uint_as_float(((unsigned)b) << 16); }
__device__ __forceinline__ bf16_t f2bf(float f) { return (bf16_t)(cvt_pk_bf16(f, 0.f) & 0xffffu); }
__device__ __forceinline__ float wave_sum(float v, int lane) { v += shx(v, 32, lane); v += shx(v, 16, lane); v += shx(v, 8, lane); v += shx(v, 4, lane); v += shx(v, 2, lane); v += shx(v, 1, lane); return v; }
__device__ __forceinline__ float gelu1(float x) { pg8::f32x2 v; v.x = x; v.y = 0.f; return pg8::gelu_pk(v).x; }
__device__ __forceinline__ unsigned ukey(float f) { const unsigned b = __float_as_uint(f); return (b & 0x80000000u) ? ~b : (b | 0x80000000u); }

typedef f32x4 AccT[2][2][4][2];
struct EpiStore {
    static constexpr bool PERM = true, AFTER_DRAIN = false;
    bf16_t* O; int ldc;
    __device__ __forceinline__ void operator()(const f32x4 (&acc)[2][2][4][2], const pg8::Unit& u, int wr, int wc, int fr, int fq) const {
        const int row0 = u.pm * 256 + wr * 64 + fr, col0 = u.pn * 256 + wc * 32 + 8 * fq;
#pragma unroll
        for (int ai = 0; ai < 2; ++ai)
#pragma unroll
            for (int m = 0; m < 4; ++m) { bf16_t* rowp = O + (size_t)(row0 + ai * 128 + m * 16) * ldc + col0;
#pragma unroll
                for (int bj = 0; bj < 2; ++bj) { const f32x4 v0 = acc[ai][bj][m][0], v1 = acc[ai][bj][m][1];
                    u32x4 w; w.x = cvt_pk_bf16(v0[0], v0[1]); w.y = cvt_pk_bf16(v0[2], v0[3]); w.z = cvt_pk_bf16(v1[0], v1[1]); w.w = cvt_pk_bf16(v1[2], v1[3]);
                    *(u32x4*)(rowp + bj * 128) = w; } }
    }
};
struct EpiSigmoid {
    static constexpr bool PERM = true, AFTER_DRAIN = false;
    unsigned char* O; int ldc;
    __device__ __forceinline__ void operator()(const f32x4 (&acc)[2][2][4][2], const pg8::Unit& u, int wr, int wc, int fr, int fq) const {
        const int row0 = u.pm * 256 + wr * 64 + fr, col0 = u.pn * 256 + wc * 32 + 8 * fq;
#pragma unroll
        for (int ai = 0; ai < 2; ++ai)
#pragma unroll
            for (int m = 0; m < 4; ++m) { unsigned char* rowp = O + (size_t)(row0 + ai * 128 + m * 16) * ldc + col0;
#pragma unroll
                for (int bj = 0; bj < 2; ++bj) { f32x4 v0 = acc[ai][bj][m][0], v1 = acc[ai][bj][m][1];
#pragma unroll
                    for (int j = 0; j < 4; ++j) { v0[j] = 255.0f * __builtin_amdgcn_rcpf(1.0f + __builtin_amdgcn_exp2f(-LOG2E * v0[j])); v1[j] = 255.0f * __builtin_amdgcn_rcpf(1.0f + __builtin_amdgcn_exp2f(-LOG2E * v1[j])); }
                    u32x2 w; w.x = 0u; w.y = 0u;
#pragma unroll
                    for (int j = 0; j < 4; ++j) { w.x |= (unsigned)__builtin_rintf(v0[j]) << (8 * j); w.y |= (unsigned)__builtin_rintf(v1[j]) << (8 * j); }
                    *(u32x2*)(rowp + bj * 128) = w; } }
    }
};
struct EpiBranch {
    static constexpr bool PERM = true, AFTER_DRAIN = false;
    bf16_t* Mg; const bf16_t* G; int br; int first;
    __device__ __forceinline__ void operator()(const f32x4 (&acc)[2][2][4][2], const pg8::Unit& u, int wr, int wc, int fr, int fq) const {
        const int row0 = u.pm * 256 + wr * 64 + fr, col0 = u.pn * 256 + wc * 32 + 8 * fq;
#pragma unroll
        for (int ai = 0; ai < 2; ++ai)
#pragma unroll
            for (int m = 0; m < 4; ++m) { const size_t row = (size_t)(row0 + ai * 128 + m * 16);
#pragma unroll
                for (int bj = 0; bj < 2; ++bj) { const f32x4 v0 = acc[ai][bj][m][0], v1 = acc[ai][bj][m][1];
                    const u32x4 g = *(const u32x4*)(G + row * 3072 + br * 1024 + col0 + bj * 128);
                    u32x4 p; p.x = 0u; p.y = 0u; p.z = 0u; p.w = 0u;
                    if (!first) p = *(const u32x4*)(Mg + row * 1024 + col0 + bj * 128);
                    u32x4 w;
                    w.x = cvt_pk_bf16(bf_lo(p.x) + bf_lo(g.x) * v0[0], bf_hi(p.x) + bf_hi(g.x) * v0[1]);
                    w.y = cvt_pk_bf16(bf_lo(p.y) + bf_lo(g.y) * v0[2], bf_hi(p.y) + bf_hi(g.y) * v0[3]);
                    w.z = cvt_pk_bf16(bf_lo(p.z) + bf_lo(g.z) * v1[0], bf_hi(p.z) + bf_hi(g.z) * v1[1]);
                    w.w = cvt_pk_bf16(bf_lo(p.w) + bf_lo(g.w) * v1[2], bf_hi(p.w) + bf_hi(g.w) * v1[3]);
                    *(u32x4*)(Mg + row * 1024 + col0 + bj * 128) = w; } }
    }
};
struct BranchOrder {
    pg8::StaticOrder S;
    __host__ __device__ void init(int G_, int c_) { S.init(T_TOK, 1024, G_, c_); }
    __host__ __device__ bool next(int i, pg8::Unit& u) const { const int j = i / 3, br = i - 3 * j; pg8::Unit t; if (!S.next(j, t)) return false; u.pm = br * (T_TOK / 256) + t.pm; u.pn = br * 4 + t.pn; return true; }
    __device__ __forceinline__ void a_ready(const pg8::Unit&) const {}
    __device__ __forceinline__ void done(const pg8::Unit&) const {}
};
struct EpiBranchCat {
    static constexpr bool PERM = true, AFTER_DRAIN = false;
    bf16_t* Mg; const unsigned char* G;
    __device__ __forceinline__ void operator()(const f32x4 (&acc)[2][2][4][2], const pg8::Unit& u, int wr, int wc, int fr, int fq) const {
        const int br = u.pm / (T_TOK / 256), pm = u.pm - br * (T_TOK / 256), pn = u.pn & 3;
        const int row0 = pm * 256 + wr * 64 + fr, col0 = pn * 256 + wc * 32 + 8 * fq;
#pragma unroll
        for (int ai = 0; ai < 2; ++ai) {
            u32x2 g[4][2]; u32x4 pv[4][2];
#pragma unroll
            for (int m = 0; m < 4; ++m)
#pragma unroll
                for (int bj = 0; bj < 2; ++bj) { const size_t row = (size_t)(row0 + ai * 128 + m * 16);
                    g[m][bj] = *(const u32x2*)(G + row * 3072 + br * 1024 + col0 + bj * 128);
                    pv[m][bj] = (u32x4){0u, 0u, 0u, 0u};
                    if (br != 0) pv[m][bj] = *(const u32x4*)(Mg + row * 1024 + col0 + bj * 128); }
#pragma unroll
            for (int m = 0; m < 4; ++m)
#pragma unroll
                for (int bj = 0; bj < 2; ++bj) { const size_t row = (size_t)(row0 + ai * 128 + m * 16); const f32x4 v0 = acc[ai][bj][m][0], v1 = acc[ai][bj][m][1]; const u32x2 gg = g[m][bj]; const u32x4 p = pv[m][bj]; const float k8 = 1.0f / 255.0f;
                    float g0[4], g1[4];
#pragma unroll
                    for (int jj = 0; jj < 4; ++jj) { g0[jj] = (float)((gg.x >> (8 * jj)) & 0xffu) * k8; g1[jj] = (float)((gg.y >> (8 * jj)) & 0xffu) * k8; }
                    u32x4 w;
                    w.x = cvt_pk_bf16(bf_lo(p.x) + g0[0] * v0[0], bf_hi(p.x) + g0[1] * v0[1]);
                    w.y = cvt_pk_bf16(bf_lo(p.y) + g0[2] * v0[2], bf_hi(p.y) + g0[3] * v0[3]);
                    w.z = cvt_pk_bf16(bf_lo(p.z) + g1[0] * v1[0], bf_hi(p.z) + g1[1] * v1[1]);
                    w.w = cvt_pk_bf16(bf_lo(p.w) + g1[2] * v1[2], bf_hi(p.w) + g1[3] * v1[3]);
                    *(u32x4*)(Mg + row * 1024 + col0 + bj * 128) = w; }
        }
    }
};
struct EpiResid {
    static constexpr bool PERM = false, AFTER_DRAIN = false;
    const float* base; float* out; int ldc;
    __device__ __forceinline__ void operator()(const f32x4 (&acc)[2][2][4][2], const pg8::Unit& u, int wr, int wc, int fr, int fq) const {
        const int row0 = u.pm * 256 + wr * 64 + fr, col0 = u.pn * 256 + wc * 32 + 4 * fq;
#pragma unroll
        for (int ai = 0; ai < 2; ++ai)
#pragma unroll
            for (int m = 0; m < 4; ++m) { const size_t off = (size_t)(row0 + ai * 128 + m * 16) * ldc + col0;
#pragma unroll
                for (int bj = 0; bj < 2; ++bj)
#pragma unroll
                    for (int n = 0; n < 2; ++n) { const f32x4 b = *(const f32x4*)(base + off + bj * 128 + n * 16); *(f32x4*)(out + off + bj * 128 + n * 16) = b + acc[ai][bj][m][n]; } }
    }
};
__device__ __forceinline__ size_t rb_off(size_t row, int n) { return row * 4096 + (size_t)(n >> 8) * 1024 + (size_t)(n & 255) * 2; }
template <bool SRC_F32>
struct EpiResidRB {
    static constexpr bool PERM = true, AFTER_DRAIN = false;
    const void* base; unsigned char* out;
    __device__ __forceinline__ void operator()(const f32x4 (&acc)[2][2][4][2], const pg8::Unit& u, int wr, int wc, int fr, int fq) const {
        const int row0 = u.pm * 256 + wr * 64 + fr, col0 = u.pn * 256 + wc * 32 + 8 * fq;
#pragma unroll
        for (int ai = 0; ai < 2; ++ai) {
            f32x4 b0[4][2], b1[4][2];
#pragma unroll
            for (int m = 0; m < 4; ++m)
#pragma unroll
                for (int bj = 0; bj < 2; ++bj) { const size_t row = (size_t)(row0 + ai * 128 + m * 16); const int col = col0 + bj * 128;
                    if (SRC_F32) { b0[m][bj] = *(const f32x4*)((const float*)base + row * 1024 + col); b1[m][bj] = *(const f32x4*)((const float*)base + row * 1024 + col + 4); }
                    else { const u32x4 w = *(const u32x4*)((const unsigned char*)base + rb_off(row, col)); b0[m][bj] = __builtin_bit_cast(f32x4, w); } }
#pragma unroll
            for (int m = 0; m < 4; ++m)
#pragma unroll
                for (int bj = 0; bj < 2; ++bj) { const size_t row = (size_t)(row0 + ai * 128 + m * 16); const int col = col0 + bj * 128; f32x4 c0, c1;
                    if (SRC_F32) { c0 = b0[m][bj]; c1 = b1[m][bj]; }
                    else { const u32x4 w = __builtin_bit_cast(u32x4, b0[m][bj]); c0 = (f32x4){bf_lo(w.x), bf_hi(w.x), bf_lo(w.y), bf_hi(w.y)}; c1 = (f32x4){bf_lo(w.z), bf_hi(w.z), bf_lo(w.w), bf_hi(w.w)}; }
                    const f32x4 r0 = c0 + acc[ai][bj][m][0], r1 = c1 + acc[ai][bj][m][1];
                    u32x4 o; o.x = cvt_pk_bf16(r0[0], r0[1]); o.y = cvt_pk_bf16(r0[2], r0[3]); o.z = cvt_pk_bf16(r1[0], r1[1]); o.w = cvt_pk_bf16(r1[2], r1[3]);
                    *(u32x4*)(out + rb_off(row, col)) = o; }
        }
    }
};
struct EpiF32Store {
    static constexpr bool PERM = false, AFTER_DRAIN = false;
    float* C; int ldc;
    __device__ __forceinline__ void operator()(const f32x4 (&acc)[2][2][4][2], const pg8::Unit& u, int wr, int wc, int fr, int fq) const {
        const int row0 = u.pm * 256 + wr * 64 + fr, col0 = u.pn * 256 + wc * 32 + 4 * fq;
#pragma unroll
        for (int ai = 0; ai < 2; ++ai)
#pragma unroll
            for (int m = 0; m < 4; ++m) { const size_t off = (size_t)(row0 + ai * 128 + m * 16) * ldc + col0;
#pragma unroll
                for (int bj = 0; bj < 2; ++bj)
#pragma unroll
                    for (int n = 0; n < 2; ++n) *(f32x4*)(C + off + bj * 128 + n * 16) = acc[ai][bj][m][n]; }
    }
};
typedef _Float16 f16x4 __attribute__((ext_vector_type(4)));
__device__ __forceinline__ unsigned okey16_pair(float a, float b) {
    const unsigned h2 = __builtin_bit_cast(unsigned, __builtin_amdgcn_cvt_pkrtz(a, b));
    return h2 ^ (0x80008000u | (((h2 >> 15) & 0x00010001u) * 0x7fffu));
}
struct EpiKey16Store {
    static constexpr bool PERM = true, AFTER_DRAIN = false;
    unsigned short* C; int ldc;
    __device__ __forceinline__ void operator()(const f32x4 (&acc)[2][2][4][2], const pg8::Unit& u, int wr, int wc, int fr, int fq) const {
        const int row0 = u.pm * 256 + wr * 64 + fr, col0 = u.pn * 256 + wc * 32 + 8 * fq;
#pragma unroll
        for (int ai = 0; ai < 2; ++ai)
#pragma unroll
            for (int m = 0; m < 4; ++m) { unsigned short* rowp = C + (size_t)(row0 + ai * 128 + m * 16) * ldc + col0;
#pragma unroll
                for (int bj = 0; bj < 2; ++bj) { const f32x4 v0 = acc[ai][bj][m][0], v1 = acc[ai][bj][m][1];
                    u32x4 w; w.x = okey16_pair(v0[0], v0[1]); w.y = okey16_pair(v0[2], v0[3]); w.z = okey16_pair(v1[0], v1[1]); w.w = okey16_pair(v1[2], v1[3]);
                    *(u32x4*)(rowp + bj * 128) = w; } }
    }
};
struct EpiF16Store {
    static constexpr bool PERM = false, AFTER_DRAIN = false;
    _Float16* C; int ldc;
    __device__ __forceinline__ void operator()(const f32x4 (&acc)[2][2][4][2], const pg8::Unit& u, int wr, int wc, int fr, int fq) const {
        const int row0 = u.pm * 256 + wr * 64 + fr, col0 = u.pn * 256 + wc * 32 + 4 * fq;
#pragma unroll
        for (int ai = 0; ai < 2; ++ai)
#pragma unroll
            for (int m = 0; m < 4; ++m) { const size_t off = (size_t)(row0 + ai * 128 + m * 16) * ldc + col0;
#pragma unroll
                for (int bj = 0; bj < 2; ++bj)
#pragma unroll
                    for (int n = 0; n < 2; ++n) { const f32x4 v = acc[ai][bj][m][n]; *(f16x4*)(C + off + bj * 128 + n * 16) = (f16x4){(_Float16)v[0], (_Float16)v[1], (_Float16)v[2], (_Float16)v[3]}; } }
    }
};
__device__ __forceinline__ void run_branch_gemms(LAS unsigned char* lds, const bf16_t* Ycat, const bf16_t* Wcat, const EpiBranchCat& E);
template <class Epi>
__device__ __forceinline__ void run_gemm(LAS unsigned char* lds, const bf16_t* A, const bf16_t* Bt, int M, int N, int K, int cshift, const Epi& E) {
    pg8::Gemm g{A, Bt, M, N, K}; pg8::StaticOrder S; S.init(M, N, (int)gridDim.x, (int)((blockIdx.x + cshift) % gridDim.x));
    pg8::gemm_phase<Epi, pg8::StaticOrder, false>(lds, g, S, E, nullptr);
    __syncthreads();
}
__device__ __forceinline__ void run_branch_gemms(LAS unsigned char* lds, const bf16_t* Ycat, const bf16_t* Wcat, const EpiBranchCat& E) {
    pg8::Gemm g{Ycat, Wcat, 3 * T_TOK, 3 * 1024, 512}; BranchOrder S; S.init((int)gridDim.x, (int)blockIdx.x);
    pg8::gemm_phase<EpiBranchCat, BranchOrder, false>(lds, g, S, E, nullptr);
    __syncthreads();
}

__device__ __forceinline__ void conv_transpose(LAS unsigned char* lds, const float* src, int ld_src, int col0, int ncols, bf16_t* dst, int K, int nrows) {
    LAS float* tl = (LAS float*)lds;
    const int tid = fresh_tid(), ntk = K / 64, ntiles = (nrows / 64) * ntk;
    for (int tile = blockIdx.x; tile < ntiles; tile += gridDim.x) {
        const int n0 = (tile / ntk) * 64, k0 = (tile % ntk) * 64;
#pragma unroll
        for (int p = 0; p < 2; ++p) { const int kk = (tid >> 4) + 32 * p, n4 = (tid & 15) * 4;
            f32x4 v = (f32x4){0.f, 0.f, 0.f, 0.f};
            if (n0 + n4 < ncols) v = *(const f32x4*)(src + (size_t)(k0 + kk) * ld_src + col0 + n0 + n4);
            tl[kk * 65 + n4 + 0] = v[0]; tl[kk * 65 + n4 + 1] = v[1]; tl[kk * 65 + n4 + 2] = v[2]; tl[kk * 65 + n4 + 3] = v[3]; }
        __syncthreads();
        { const int n = tid >> 3, kc = (tid & 7) * 8; float f[8];
#pragma unroll
            for (int j = 0; j < 8; ++j) f[j] = tl[(kc + j) * 65 + n];
            u32x4 w; w.x = cvt_pk_bf16(f[0], f[1]); w.y = cvt_pk_bf16(f[2], f[3]); w.z = cvt_pk_bf16(f[4], f[5]); w.w = cvt_pk_bf16(f[6], f[7]);
            *(u32x4*)(dst + (size_t)(n0 + n) * K + k0 + kc) = w; }
        __syncthreads();
    }
}
template <bool SRC_RB>
__device__ __forceinline__ void rmsnorm_rows_t(const void* x, const float* g, bf16_t* out, int rows) {
    const int tid = fresh_tid(); const int lane = tid & 63, gw = blockIdx.x * 8 + (tid >> 6), nw = gridDim.x * 8;
    f32x4 gv[4];
#pragma unroll
    for (int i = 0; i < 4; ++i) gv[i] = *(const f32x4*)(g + 4 * lane + 256 * i);
    for (int r = gw; r < rows; r += nw) {
        f32x4 v[4]; float ss = 0.f;
#pragma unroll
        for (int i = 0; i < 4; ++i) { if (SRC_RB) { const u32x2 w = *(const u32x2*)((const unsigned char*)x + (size_t)r * 4096 + 1024 * i + 8 * lane); v[i] = (f32x4){bf_lo(w.x), bf_hi(w.x), bf_lo(w.y), bf_hi(w.y)}; }
            else v[i] = *(const f32x4*)((const float*)x + (size_t)r * 1024 + 4 * lane + 256 * i);
            ss += v[i][0] * v[i][0] + v[i][1] * v[i][1] + v[i][2] * v[i][2] + v[i][3] * v[i][3]; }
        ss = wave_sum(ss, lane);
        const float sc = rsqrtf(ss * (1.0f / 1024.0f) + EPSF);
#pragma unroll
        for (int i = 0; i < 4; ++i) { u32x2 w; w.x = cvt_pk_bf16(v[i][0] * sc * gv[i][0], v[i][1] * sc * gv[i][1]); w.y = cvt_pk_bf16(v[i][2] * sc * gv[i][2], v[i][3] * sc * gv[i][3]);
            *(u32x2*)(out + (size_t)r * 1024 + 4 * lane + 256 * i) = w; }
    }
}
__device__ __forceinline__ void rmsnorm_rows(const float* x, const float* g, bf16_t* out, int rows) { rmsnorm_rows_t<false>(x, g, out, rows); }
__device__ __forceinline__ void peer_fuse_weights(LAS unsigned char* lds, const float* pwq  , const float* sk1, const float* sk2  , bf16_t* dst  ) {
    LAS float* Pt = (LAS float*)lds;
    LAS float* Sk = (LAS float*)(lds + 64 * 129 * 4);
    const int tid = fresh_tid();
    for (int item = blockIdx.x; item < 256; item += gridDim.x) {
        const int hh = item >> 4, k0 = (item & 15) * 64; const float* sk = (hh & 1) ? sk2 : sk1;
        for (int e = tid; e < 64 * 32; e += 512) { const int kk = e >> 5, d4 = (e & 31) * 4; const f32x4 v = *(const f32x4*)(pwq + (size_t)(k0 + kk) * 2048 + hh * 128 + d4);
            Pt[kk * 129 + d4] = v[0]; Pt[kk * 129 + d4 + 1] = v[1]; Pt[kk * 129 + d4 + 2] = v[2]; Pt[kk * 129 + d4 + 3] = v[3]; }
        for (int e = tid; e < 128 * 32; e += 512) { const int n = e >> 5, d4 = (e & 31) * 4; const f32x4 v = *(const f32x4*)(sk + (size_t)n * 128 + d4);
            Sk[n * 129 + d4] = v[0]; Sk[n * 129 + d4 + 1] = v[1]; Sk[n * 129 + d4 + 2] = v[2]; Sk[n * 129 + d4 + 3] = v[3]; }
        __syncthreads();
        { const int n = tid & 127, kg = __builtin_amdgcn_readfirstlane(tid >> 7); float acc[16];
#pragma unroll
            for (int j = 0; j < 16; ++j) acc[j] = 0.f;
            for (int d = 0; d < 128; ++d) { const float s = Sk[n * 129 + d];
#pragma unroll
                for (int j = 0; j < 16; ++j) acc[j] = __builtin_fmaf(Pt[(kg * 16 + j) * 129 + d], s, acc[j]); }
            u32x4 w0, w1; w0.x = cvt_pk_bf16(acc[0], acc[1]); w0.y = cvt_pk_bf16(acc[2], acc[3]); w0.z = cvt_pk_bf16(acc[4], acc[5]); w0.w = cvt_pk_bf16(acc[6], acc[7]);
            w1.x = cvt_pk_bf16(acc[8], acc[9]); w1.y = cvt_pk_bf16(acc[10], acc[11]); w1.z = cvt_pk_bf16(acc[12], acc[13]); w1.w = cvt_pk_bf16(acc[14], acc[15]);
            bf16_t* o = dst + (size_t)(hh * 128 + n) * 1024 + k0 + kg * 16; *(u32x4*)o = w0; *(u32x4*)(o + 8) = w1; }
        __syncthreads();
    }
}
__device__ __forceinline__ void make_tables(const Params& p) {
    unsigned char* const wsl = fresh_ptr(p.ws);
    if (blockIdx.x != 0) return;
    const int tidm = fresh_tid();
    float* btab = (float*)(wsl + WS_CTL + CTL_BTAB); float* lamv = (float*)(wsl + WS_CTL + CTL_LAM);
    const float* rb = p.in[I_RELB];
    for (int e = tidm; e < 8 * 128; e += 512) { const int hd = e >> 7, d = e & 127; int bk;
        if (d < 16) bk = d; else { const float nf = (float)d; int lg = 16 + (int)(logf(nf / 16.0f) / 2.0794415416798357f * 16.0f); bk = lg < 31 ? lg : 31; }
        btab[e] = (rb[bk * 8 + hd] - rb[31 * 8 + hd]) * LOG2E; }
    if (tidm < 128) { const int l = tidm >> 6, lane = tidm & 63;
        float a = p.in[I_LQ1][l * 64 + lane] * p.in[I_LK1][l * 64 + lane], b = p.in[I_LQ2][l * 64 + lane] * p.in[I_LK2][l * 64 + lane];
        a = wave_sum(a, lane); b = wave_sum(b, lane);
        const float lam_init = 0.8f - 0.6f * expf(-0.3f * (float)l);
        if (lane == 0) { lamv[l * 2] = expf(a) - expf(b) + lam_init; lamv[l * 2 + 1] = lam_init; } }
}
__device__ __forceinline__ void prep_weights(const Params& p, LAS unsigned char* lds, int l) {
    unsigned char* const wsl = fresh_ptr(p.ws);
    unsigned char* wb = wsl + WS_WB;
    const float* win = p.in[I_W_IN] + (size_t)l * 1024 * DIN;
    bf16_t* winT = (bf16_t*)(wb + WB_WIN);
    conv_transpose(lds, win, DIN, 0,    512, winT + (size_t)HC_QA * 1024, 1024, 512);
    conv_transpose(lds, win, DIN, 512,  512, winT + (size_t)HC_KA * 1024, 1024, 512);
    conv_transpose(lds, win, DIN, 1536, 512, winT + (size_t)HC_ZU * 1024, 1024, 512);
    conv_transpose(lds, win, DIN, 2048, 512, winT + (size_t)HC_ZV * 1024, 1024, 512);
    conv_transpose(lds, win, DIN, 2560, 512, winT + (size_t)HC_CQ * 1024, 1024, 512);
    conv_transpose(lds, win, DIN, 3328, 512, winT + (size_t)HC_IQ * 1024, 1024, 512);
    conv_transpose(lds, win, DIN, 3072, 128, winT + (size_t)HC_CK * 1024, 1024, 128);
    conv_transpose(lds, win, DIN, 3840, 64,  winT + (size_t)HC_IK * 1024, 1024, 64);
    conv_transpose(lds, win, DIN, 3904, 8,   winT + (size_t)HC_IW * 1024, 1024, 64);
    bf16_t* wvT = (bf16_t*)(wb + WB_WV);
    conv_transpose(lds, win, DIN, 1024, 512, wvT, 1024, 512);
    conv_transpose(lds, win, DIN, 3200, 128, wvT + (size_t)512 * 1024, 1024, 128);
    conv_transpose(lds, win, DIN, 0,    0,   wvT + (size_t)640 * 1024, 1024, 128);
    conv_transpose(lds, win, DIN, 3912, 3072, (bf16_t*)(wb + WB_WG), 1024, 3072);
    conv_transpose(lds, p.in[I_WBRA] + (size_t)l * 512 * 1024, 1024, 0, 1024, (bf16_t*)(wb + WB_BRA), 512, 1024);
    conv_transpose(lds, p.in[I_WBRB] + (size_t)l * 512 * 1024, 1024, 0, 1024, (bf16_t*)(wb + WB_BRB), 512, 1024);
    conv_transpose(lds, p.in[I_WBRC] + (size_t)l * 512 * 1024, 1024, 0, 1024, (bf16_t*)(wb + WB_BRC), 512, 1024);
    conv_transpose(lds, p.in[I_WOUT] + (size_t)l * 1024 * 1024, 1024, 0, 1024, (bf16_t*)(wb + WB_OUT), 1024, 1024);
    conv_transpose(lds, p.in[I_MWQ] + (size_t)l * 1024 * 512, 512, 0, 512, (bf16_t*)(wb + WB_MQ), 1024, 512);
    conv_transpose(lds, p.in[I_MWKV] + (size_t)l * 1024 * 1024, 1024, 0, 512, (bf16_t*)(wb + WB_MK), 1024, 512);
    conv_transpose(lds, p.in[I_MWKV] + (size_t)l * 1024 * 1024, 1024, 512, 512, (bf16_t*)(wb + WB_MV), 1024, 512);
    conv_transpose(lds, p.in[I_MWO] + (size_t)l * 512 * 1024, 1024, 0, 1024, (bf16_t*)(wb + WB_MO), 512, 1024);
    peer_fuse_weights(lds, p.in[I_PWQ] + (size_t)l * 1024 * 2048, p.in[I_SK1] + (size_t)l * 128 * 128, p.in[I_SK2] + (size_t)l * 128 * 128, (bf16_t*)(wb + WB_PS));
}
__device__ __forceinline__ void conv_copy(const float* src, bf16_t* dst, size_t n) {
    const size_t stride = (size_t)gridDim.x * 512 * 8;
    const int tidc = fresh_tid();
    for (size_t i = ((size_t)blockIdx.x * 512 + tidc) * 8; i < n; i += stride) {
        const f32x4 a = *(const f32x4*)(src + i), b = *(const f32x4*)(src + i + 4);
        u32x4 w; w.x = cvt_pk_bf16(a[0], a[1]); w.y = cvt_pk_bf16(a[2], a[3]); w.z = cvt_pk_bf16(b[0], b[1]); w.w = cvt_pk_bf16(b[2], b[3]);
        *(u32x4*)(dst + i) = w; }
}

__device__ __forceinline__ void knorm_rows(const Params& p, int l) {
    unsigned char* const wsl = fresh_ptr(p.ws);
    bf16_t* H = (bf16_t*)(wsl + WS_R + R_H); bf16_t* MK = (bf16_t*)(wsl + WS_MK);
    const float* akg = p.in[I_AKG] + l * 64; const float* ckg = p.in[I_CKG] + l * 128; const float* mkg = p.in[I_MKG] + l * 128;
    const int tid = fresh_tid(); const int lane = tid & 63, gw = blockIdx.x * 8 + (tid >> 6), nw = gridDim.x * 8;
    float ga[8], gm[8];
#pragma unroll
    for (int j = 0; j < 8; ++j) { ga[j] = akg[(8 * lane + j) & 63]; gm[j] = mkg[(8 * lane + j) & 127]; }
    const float gc0 = ckg[2 * lane], gc1 = ckg[2 * lane + 1];
    for (int r = gw; r < T_TOK; r += nw) {
        bf16_t* row = H + (size_t)r * HN;
        {
            u32x4 w = *(const u32x4*)(row + HC_KA + 8 * lane); float f[8] = {bf_lo(w.x), bf_hi(w.x), bf_lo(w.y), bf_hi(w.y), bf_lo(w.z), bf_hi(w.z), bf_lo(w.w), bf_hi(w.w)};
            float ss = 0.f;
#pragma unroll
            for (int j = 0; j < 8; ++j) ss += f[j] * f[j];
            ss += SHX(ss, 1); ss += SHX(ss, 2); ss += SHX(ss, 4);
            const float sc = rsqrtf(ss * (1.0f / 64.0f) + EPSF);
            w.x = cvt_pk_bf16(f[0] * sc * ga[0], f[1] * sc * ga[1]); w.y = cvt_pk_bf16(f[2] * sc * ga[2], f[3] * sc * ga[3]);
            w.z = cvt_pk_bf16(f[4] * sc * ga[4], f[5] * sc * ga[5]); w.w = cvt_pk_bf16(f[6] * sc * ga[6], f[7] * sc * ga[7]);
            *(u32x4*)(row + HC_KA + 8 * lane) = w; }
        {
            const unsigned w = *(const unsigned*)(row + HC_CK + 2 * lane); const float a = bf_lo(w), b = bf_hi(w);
            const float ss = wave_sum(a * a + b * b, lane); const float sc = rsqrtf(ss * (1.0f / 128.0f) + EPSF);
            *(unsigned*)(row + HC_CK + 2 * lane) = cvt_pk_bf16(a * sc * gc0, b * sc * gc1); }
    }
    for (int r = gw; r < NB * MEMLEN; r += nw) {
        bf16_t* row = MK + (size_t)r * 512;
        u32x4 w = *(const u32x4*)(row + 8 * lane); float f[8] = {bf_lo(w.x), bf_hi(w.x), bf_lo(w.y), bf_hi(w.y), bf_lo(w.z), bf_hi(w.z), bf_lo(w.w), bf_hi(w.w)};
        float ss = 0.f;
#pragma unroll
        for (int j = 0; j < 8; ++j) ss += f[j] * f[j];
        ss += SHX(ss, 1); ss += SHX(ss, 2); ss += SHX(ss, 4); ss += SHX(ss, 8);
        const float sc = rsqrtf(ss * (1.0f / 128.0f) + EPSF);
        w.x = cvt_pk_bf16(f[0] * sc * gm[0], f[1] * sc * gm[1]); w.y = cvt_pk_bf16(f[2] * sc * gm[2], f[3] * sc * gm[3]);
        w.z = cvt_pk_bf16(f[4] * sc * gm[4], f[5] * sc * gm[5]); w.w = cvt_pk_bf16(f[6] * sc * gm[6], f[7] * sc * gm[7]);
        *(u32x4*)(row + 8 * lane) = w;
    }
}
__device__ __forceinline__ void gmlp_phase(const Params& p, LAS unsigned char* lds, int l) {
    unsigned char* const wsl = fresh_ptr(p.ws);
    const bf16_t* H = (const bf16_t*)(wsl + WS_R + R_H); bf16_t* YB = (bf16_t*)(wsl + WS_YB);
    LAS unsigned char* Wl = lds;
    LAS unsigned char* Vt = lds + 32768;
    LAS unsigned char* Ul = lds + 65536;
    const int tid = fresh_tid(), lane = tid & 63, wv = __builtin_amdgcn_readfirstlane(tid >> 6), fr = lane & 15, fq = lane >> 4;
    for (int unit = blockIdx.x; unit < 1024; unit += gridDim.x) {
        const int c = unit >> 2, g = unit & 3; const size_t t0 = (size_t)c * 128;
        const float* W = p.in[I_BWS] + ((size_t)(l * 4 + g) * 128) * 128; const float* bs = p.in[I_BBS] + (size_t)(l * 4 + g) * 128; const float* vg = p.in[I_BVG] + l * 512 + g * 128;
        {
            const int t = tid >> 2, sq = (tid & 3) * 32;
            f32x4 wa[4], wb[4]; u32x4 zvr[4], zur[4];
            const bf16_t* srcv = H + (t0 + t) * HN + HC_ZV + g * 128 + sq; const bf16_t* srcu = H + (t0 + t) * HN + HC_ZU + g * 128 + sq;
#pragma unroll
            for (int q = 0; q < 4; ++q) { wa[q] = *(const f32x4*)(W + (size_t)t * 128 + sq + q * 8); wb[q] = *(const f32x4*)(W + (size_t)t * 128 + sq + q * 8 + 4); zvr[q] = *(const u32x4*)(srcv + q * 8); zur[q] = *(const u32x4*)(srcu + q * 8); }
#pragma unroll
            for (int q = 0; q < 4; ++q) { const f32x4 a = wa[q], b = wb[q];
                float f[8] = {a[0], a[1], a[2], a[3], b[0], b[1], b[2], b[3]};
#pragma unroll
                for (int j = 0; j < 8; ++j) if (sq + q * 8 + j > t) f[j] = 0.f;
                u32x4 w; w.x = cvt_pk_bf16(f[0], f[1]); w.y = cvt_pk_bf16(f[2], f[3]); w.z = cvt_pk_bf16(f[4], f[5]); w.w = cvt_pk_bf16(f[6], f[7]);
                const int ch = (sq >> 3) + q; *(LAS u32x4*)(Wl + t * 256 + ((ch ^ (t & 15)) << 4)) = w; }
            {
                const int s = t, dq = sq; float f[32]; float ss = 0.f;
#pragma unroll
                for (int q = 0; q < 4; ++q) { const u32x4 w = zvr[q];
                    f[q * 8 + 0] = bf_lo(w.x); f[q * 8 + 1] = bf_hi(w.x); f[q * 8 + 2] = bf_lo(w.y); f[q * 8 + 3] = bf_hi(w.y); f[q * 8 + 4] = bf_lo(w.z); f[q * 8 + 5] = bf_hi(w.z); f[q * 8 + 6] = bf_lo(w.w); f[q * 8 + 7] = bf_hi(w.w); }
#pragma unroll
                for (int j = 0; j < 32; ++j) { f[j] = gelu1(f[j]); ss += f[j] * f[j]; }
                ss += SHX(ss, 1); ss += SHX(ss, 2);
                const float sc = rsqrtf(ss * (1.0f / 128.0f) + EPSF);
#pragma unroll
                for (int j = 0; j < 32; ++j) { const int d = dq + j; const float v = f[j] * sc * vg[d];
                    *(LAS bf16_t*)(Vt + d * 256 + (((s >> 3) ^ (d & 15)) << 4) + (s & 7) * 2) = f2bf(v); } }
            {
                const int dq = sq;
#pragma unroll
                for (int q = 0; q < 4; ++q) { const u32x4 w = zur[q];
                    u32x4 o; o.x = cvt_pk_bf16(gelu1(bf_lo(w.x)), gelu1(bf_hi(w.x))); o.y = cvt_pk_bf16(gelu1(bf_lo(w.y)), gelu1(bf_hi(w.y)));
                    o.z = cvt_pk_bf16(gelu1(bf_lo(w.z)), gelu1(bf_hi(w.z))); o.w = cvt_pk_bf16(gelu1(bf_lo(w.w)), gelu1(bf_hi(w.w)));
                    *(LAS u32x4*)(Ul + t * 272 + (dq + q * 8) * 2) = o; } }
        }
        __syncthreads();
        {
            f32x4 acc[8];
#pragma unroll
            for (int dd = 0; dd < 8; ++dd) acc[dd] = (f32x4){0.f, 0.f, 0.f, 0.f};
            const int nks = (wv >> 1) + 1; const int trow = 16 * wv + fr;
            for (int ks = 0; ks < nks; ++ks) {
                const bf16x8 wf = *(const LAS bf16x8*)(Wl + trow * 256 + (((4 * ks + fq) ^ (trow & 15)) << 4));
#pragma unroll
                for (int dd = 0; dd < 8; ++dd) { const int d = 16 * dd + fr; const bf16x8 vf = *(const LAS bf16x8*)(Vt + d * 256 + (((4 * ks + fq) ^ (d & 15)) << 4));
                    acc[dd] = __builtin_amdgcn_mfma_f32_16x16x32_bf16(wf, vf, acc[dd], 0, 0, 0); } }
#pragma unroll
            for (int i = 0; i < 4; ++i) { const int t = 16 * wv + 4 * fq + i; const float bb = bs[t];
#pragma unroll
                for (int dd = 0; dd < 8; ++dd) { const int d = 16 * dd + fr; LAS bf16_t* up = (LAS bf16_t*)(Ul + t * 272 + d * 2); *up = f2bf((acc[dd][i] + bb) * bf2f(*up)); } }
        }
        __syncthreads();
        { const int t = tid >> 2, dq = (tid & 3) * 32; bf16_t* dst = YB + (t0 + t) * 512 + g * 128 + dq;
#pragma unroll
            for (int q = 0; q < 4; ++q) *(u32x4*)(dst + q * 8) = *(const LAS u32x4*)(Ul + t * 272 + (dq + q * 8) * 2); }
        __syncthreads();
    }
}

struct AttnArgs {
    const bf16_t* Q; int ldq; int qcol[2]; size_t qtok; const float* qgain; float qscale;
    const bf16_t* K; int ldk; size_t krow0; int kcol0;
    const bf16_t* V; int ldv; int vrow0; size_t vcol0;
    int nkt_blk, my_nkt, qpos, qpos_w0; int bhead[2]; const unsigned short* maskrow; int var;
};
#ifdef ATT_PROBE
#define AV(bit) (a.var & (bit))
#else
#define AV(bit) 0
#endif
template <int NS, int DQK, bool KSPLIT, int MODE>
__device__ __forceinline__ void attn_core(LAS unsigned char* lds, const LAS float* btab, const AttnArgs& a, f32x4 (&O)[NS][8], float (&lsum)[NS]) {
    constexpr int NKS = DQK / 32;
    const int tid = fresh_tid(), lane = tid & 63, fr = lane & 15, fq = lane >> 4;
    bf16x8 qf[NS][NKS];
#pragma unroll
    for (int s = 0; s < NS; ++s) {
        float qv[NKS][8]; float ss = 0.f;
#pragma unroll
        for (int ks = 0; ks < NKS; ++ks) { const u32x4 w = *(const u32x4*)(a.Q + a.qtok * a.ldq + a.qcol[s] + 32 * ks + 8 * fq);
            qv[ks][0] = bf_lo(w.x); qv[ks][1] = bf_hi(w.x); qv[ks][2] = bf_lo(w.y); qv[ks][3] = bf_hi(w.y); qv[ks][4] = bf_lo(w.z); qv[ks][5] = bf_hi(w.z); qv[ks][6] = bf_lo(w.w); qv[ks][7] = bf_hi(w.w);
#pragma unroll
            for (int j = 0; j < 8; ++j) ss += qv[ks][j] * qv[ks][j]; }
        ss += SHX(ss, 16); ss += SHX(ss, 32);
        const float r = rsqrtf(ss * (1.0f / (float)DQK) + EPSF) * a.qscale;
#pragma unroll
        for (int ks = 0; ks < NKS; ++ks) { const f32x4 g0 = *(const f32x4*)(a.qgain + 32 * ks + 8 * fq), g1 = *(const f32x4*)(a.qgain + 32 * ks + 8 * fq + 4);
            u32x4 w; w.x = cvt_pk_bf16(qv[ks][0] * r * g0[0], qv[ks][1] * r * g0[1]); w.y = cvt_pk_bf16(qv[ks][2] * r * g0[2], qv[ks][3] * r * g0[3]);
            w.z = cvt_pk_bf16(qv[ks][4] * r * g1[0], qv[ks][5] * r * g1[1]); w.w = cvt_pk_bf16(qv[ks][6] * r * g1[2], qv[ks][7] * r * g1[3]);
            qf[s][ks] = __builtin_bit_cast(bf16x8, w); }
    }
    constexpr bool MROW = (MODE != 1);
    float mrun[NS]; f32x4 lacc[NS];
    const bf16x8 ones = __builtin_bit_cast(bf16x8, (u32x4){0x3f803f80u, 0x3f803f80u, 0x3f803f80u, 0x3f803f80u});
#pragma unroll
    for (int s = 0; s < NS; ++s) { mrun[s] = NEG_INF; lacc[s] = (f32x4){0.f, 0.f, 0.f, 0.f};
#pragma unroll
        for (int dt = 0; dt < 8; ++dt) O[s][dt] = (f32x4){0.f, 0.f, 0.f, 0.f}; }
    const int wvs = __builtin_amdgcn_readfirstlane(tid >> 6);
    const int c0 = tid, c1 = tid + 512;
    const int kr0 = c0 >> 4, kr1 = c1 >> 4, vr0 = c0 >> 3, vr1 = c1 >> 3;
    const int kc0 = (c0 & 15) ^ (kr0 & 15), kc1 = (c1 & 15) ^ (kr1 & 15), vc0 = (c0 & 7) ^ ((vr0 >> 1) & 7), vc1 = (c1 & 7) ^ ((vr1 >> 1) & 7);
    const bf16_t* kg0 = a.K + (a.krow0 + kr0) * a.ldk + a.kcol0 + kc0 * 8; const bf16_t* kg1 = a.K + (a.krow0 + kr1) * a.ldk + a.kcol0 + kc1 * 8;
    const bf16_t* vg0 = a.V + (size_t)(a.vrow0 + vr0) * a.ldv + a.vcol0 + vc0 * 8; const bf16_t* vg1 = a.V + (size_t)(a.vrow0 + vr1) * a.ldv + a.vcol0 + vc1 * 8;
    const int ldw = wvs * 1024;
#define ATT_STAGE(bufoff, ko, vo) do { \
        __builtin_amdgcn_global_load_lds((const unsigned*)(kg0 + (ko)), (LAS unsigned*)(lds + (bufoff) + ldw), 16, 0, 0); \
        __builtin_amdgcn_global_load_lds((const unsigned*)(kg1 + (ko)), (LAS unsigned*)(lds + (bufoff) + 8192 + ldw), 16, 0, 0); \
        __builtin_amdgcn_global_load_lds((const unsigned*)(vg0 + (vo)), (LAS unsigned*)(lds + (bufoff) + 16384 + ldw), 16, 0, 0); \
        __builtin_amdgcn_global_load_lds((const unsigned*)(vg1 + (vo)), (LAS unsigned*)(lds + (bufoff) + 24576 + ldw), 16, 0, 0); } while (0)
    LAS unsigned char* mrow = lds + 102400 + wvs * 4352 + fr * 264;
    if (MODE == 1) {
#pragma unroll
        for (int j = 0; j < 4; ++j) { const u32x4 w = *(const u32x4*)(a.maskrow + fq * 32 + j * 8); *(LAS u32x2*)(mrow + fq * 64 + j * 16) = (u32x2){w.x, w.y}; *(LAS u32x2*)(mrow + fq * 64 + j * 16 + 8) = (u32x2){w.z, w.w}; }
        asm volatile("s_waitcnt vmcnt(0) lgkmcnt(0)" ::: "memory");
    }
    ATT_STAGE(0, 0, 0);
    if (a.nkt_blk > 1 && !AV(8)) ATT_STAGE(32768, (size_t)64 * a.ldk, (size_t)64);
    int slot = 0;
    for (int kt = 0; kt < a.nkt_blk; ++kt) {
        if (kt + 1 < a.nkt_blk && !AV(8)) asm volatile("s_waitcnt vmcnt(4)" ::: "memory"); else asm volatile("s_waitcnt vmcnt(0)" ::: "memory");
        if (!AV(16)) { asm volatile("" ::: "memory"); __builtin_amdgcn_s_barrier(); asm volatile("" ::: "memory"); }
        if (kt + 2 < a.nkt_blk && !AV(8)) { const int ns = (slot >= 1) ? slot - 1 : 2; const size_t ko = (size_t)(kt + 2) * 64 * a.ldk, vo = (size_t)(kt + 2) * 64; ATT_STAGE(ns * 32768, ko, vo); }
        const int buf = slot; slot = (slot == 2) ? 0 : slot + 1;
        unsigned long long mbits = 0ull;
        if (MODE == 1) { const u32x2 mw = *(const LAS u32x2*)(mrow + kt * 8); mbits = ((unsigned long long)mw.y << 32) | mw.x; }
        if (kt < a.my_nkt) {
            const LAS unsigned char* Kt = lds + buf * 32768; const LAS unsigned char* Vt = Kt + 16384;
            const int key0 = kt * 64;
            const bool near = (MODE != 2) && (a.qpos_w0 - key0 - 63 < 128);
            bf16x8 pf[NS][2];
#pragma unroll
            for (int s = 0; s < NS; ++s) {
                f32x4 sacc[4];
#pragma unroll
                for (int t = 0; t < 4; ++t) { const LAS unsigned char* rp = Kt + (16 * t + fr) * 256;
                    if (AV(4)) { sacc[t] = (f32x4){0.f, 0.f, 0.f, 0.f}; continue; }
                    { const bf16x8 kf = *(const LAS bf16x8*)(rp + ((((KSPLIT ? 8 * s : 0) + fq) ^ fr) << 4)); sacc[t] = __builtin_amdgcn_mfma_f32_16x16x32_bf16(kf, qf[s][0], (f32x4){0.f, 0.f, 0.f, 0.f}, 0, 0, 0); }
#pragma unroll
                    for (int ks = 1; ks < NKS; ++ks) { const bf16x8 kf = *(const LAS bf16x8*)(rp + ((((KSPLIT ? 8 * s : 0) + 4 * ks + fq) ^ fr) << 4));
                        sacc[t] = __builtin_amdgcn_mfma_f32_16x16x32_bf16(kf, qf[s][ks], sacc[t], 0, 0, 0); } }
                if (!AV(1)) {
                if (MODE == 1) { const unsigned lo = (unsigned)mbits, hi = (unsigned)(mbits >> 32); unsigned nib[4];
                    nib[0] = (lo & 0xffffu) >> (4 * fq); nib[1] = (lo >> 16) >> (4 * fq); nib[2] = (hi & 0xffffu) >> (4 * fq); nib[3] = (hi >> 16) >> (4 * fq);
#pragma unroll
                    for (int t = 0; t < 4; ++t)
#pragma unroll
                        for (int i = 0; i < 4; ++i) sacc[t][i] = ((nib[t] >> i) & 1u) ? sacc[t][i] : NEG_INF; }
                if (MODE != 2) { if (near) {
                    const LAS float* bt = btab + a.bhead[s] * 128; const int dist0 = a.qpos - key0 - 4 * fq;
                    float bia[4][4];
#pragma unroll
                    for (int t = 0; t < 4; ++t)
#pragma unroll
                        for (int i = 0; i < 4; ++i) { const int dist = dist0 - 16 * t - i; const int di = dist < 0 ? 0 : (dist > 127 ? 127 : dist); bia[t][i] = bt[di]; }
#pragma unroll
                    for (int t = 0; t < 4; ++t)
#pragma unroll
                        for (int i = 0; i < 4; ++i) { float x = sacc[t][i] + bia[t][i]; if (MODE == 0) x = (dist0 - 16 * t - i < 0) ? NEG_INF : x; sacc[t][i] = x; }
                } }
                float rmax = fmaxf(fmaxf(__builtin_fmaxf(sacc[0][0], sacc[0][1]), fmaxf(sacc[0][2], sacc[0][3])), fmaxf(fmaxf(sacc[1][0], sacc[1][1]), fmaxf(sacc[1][2], sacc[1][3])));
                rmax = fmaxf(rmax, fmaxf(fmaxf(fmaxf(sacc[2][0], sacc[2][1]), fmaxf(sacc[2][2], sacc[2][3])), fmaxf(fmaxf(sacc[3][0], sacc[3][1]), fmaxf(sacc[3][2], sacc[3][3]))));
                rmax = fmaxf(rmax, SHX(rmax, 16)); rmax = fmaxf(rmax, SHX(rmax, 32));
                if (__any(rmax > mrun[s] + 8.0f)) {
                    const float mn = fmaxf(mrun[s], rmax); const float alpha = (mn == NEG_INF) ? 1.0f : __builtin_amdgcn_exp2f(mrun[s] - mn); mrun[s] = mn;
#pragma unroll
                    for (int dt = 0; dt < 8; ++dt) O[s][dt] *= alpha;
                    lacc[s] *= alpha;
                }
                const float mu = (mrun[s] == NEG_INF) ? 0.f : mrun[s];
                float psum = 0.f;
#pragma unroll
                for (int t = 0; t < 4; ++t)
#pragma unroll
                    for (int i = 0; i < 4; ++i) { sacc[t][i] = __builtin_amdgcn_exp2f(sacc[t][i] - mu); if (!MROW) psum += sacc[t][i]; }
                if (!MROW) lacc[s][0] += psum;
                }
#pragma unroll
                for (int s2 = 0; s2 < 2; ++s2) { u32x4 w; w.x = cvt_pk_bf16(sacc[2 * s2][0], sacc[2 * s2][1]); w.y = cvt_pk_bf16(sacc[2 * s2][2], sacc[2 * s2][3]);
                    w.z = cvt_pk_bf16(sacc[2 * s2 + 1][0], sacc[2 * s2 + 1][1]); w.w = cvt_pk_bf16(sacc[2 * s2 + 1][2], sacc[2 * s2 + 1][3]); pf[s][s2] = __builtin_bit_cast(bf16x8, w); }
                if (!AV(2) && MROW)
#pragma unroll
                for (int s2 = 0; s2 < 2; ++s2) lacc[s] = __builtin_amdgcn_mfma_f32_16x16x32_bf16(ones, pf[s][s2], lacc[s], 0, 0, 0);
            }
            if (!AV(2)) {
                bf16x8 vfa[4], vfb[4];
#define ATT_VLOAD(G, DST) { _Pragma("unroll") for (int u4 = 0; u4 < 4; ++u4) { const int dt_ = 2 * (G) + (u4 >> 1), s2_ = u4 & 1; const int row_ = 16 * dt_ + fr; const LAS unsigned char* rp_ = Vt + row_ * 128 + 8 * (fq & 1); const int sw_ = (row_ >> 1) & 7; \
                    const u32x2 va_ = *(const volatile LAS u32x2*)(rp_ + (((4 * s2_ + (fq >> 1)) ^ sw_) << 4)), vb_ = *(const volatile LAS u32x2*)(rp_ + (((4 * s2_ + 2 + (fq >> 1)) ^ sw_) << 4)); \
                    DST[u4] = __builtin_bit_cast(bf16x8, (u32x4){va_.x, va_.y, vb_.x, vb_.y}); } }
#define ATT_VUSE(G, SRC) { __builtin_amdgcn_s_setprio(1); _Pragma("unroll") for (int u4 = 0; u4 < 4; ++u4) { const int dt_ = 2 * (G) + (u4 >> 1), s2_ = u4 & 1; \
                    _Pragma("unroll") for (int s = 0; s < NS; ++s) O[s][dt_] = __builtin_amdgcn_mfma_f32_16x16x32_bf16(SRC[u4], pf[s][s2_], O[s][dt_], 0, 0, 0); } __builtin_amdgcn_s_setprio(0); }
                ATT_VLOAD(0, vfa)
                ATT_VLOAD(1, vfb) ATT_VUSE(0, vfa)
                ATT_VLOAD(2, vfa) ATT_VUSE(1, vfb)
                ATT_VLOAD(3, vfb) ATT_VUSE(2, vfa)
                ATT_VUSE(3, vfb)
#undef ATT_VLOAD
#undef ATT_VUSE
            }
        }
    }
    __syncthreads();
#undef ATT_STAGE
#pragma unroll
    for (int s = 0; s < NS; ++s) { lsum[s] = lacc[s][0]; if (!MROW) { lsum[s] += SHX(lsum[s], 16); lsum[s] += SHX(lsum[s], 32); } }
}
__device__ __forceinline__ void load_btab(const Params& p, LAS float* bt) {
    unsigned char* const wsl = fresh_ptr(p.ws);
    const float* src = (const float*)(wsl + WS_CTL + CTL_BTAB);
    const int tidb = fresh_tid();
    for (int e = tidb; e < 1024; e += 512) bt[e] = src[e];
    __syncthreads();
}
__device__ __forceinline__ void attnA_phase(const Params& p, LAS unsigned char* lds, int l, int var) {
    unsigned char* const wsl = fresh_ptr(p.ws);
    LAS float* bt = (LAS float*)(lds + 98304);
    load_btab(p, bt);
    const bf16_t* H = (const bf16_t*)(wsl + WS_R + R_H); const bf16_t* VT = (const bf16_t*)(wsl + WS_R + R_VT); bf16_t* YA = (bf16_t*)(wsl + WS_YA);
    const float* lamv = (const float*)(wsl + WS_CTL + CTL_LAM); const float lam = lamv[l * 2], lam_init = lamv[l * 2 + 1];
    const float* subln = p.in[I_SUBLN] + l * 128;
    const int tid = fresh_tid(); const int lane = tid & 63, wv = __builtin_amdgcn_readfirstlane(tid >> 6), fr = lane & 15, fq = lane >> 4;
    for (int vb = blockIdx.x; vb < 256; vb += gridDim.x) for (int it = 0; it < 4; ++it) {
        const int xg = vb & 7, sl = vb >> 3;
        const int bh = xg * 8 + (it >> 1) * 4 + (sl >> 3), j = sl & 7; const int qt = (it & 1) ? 15 - j : j;
        const int b = bh >> 2, h = bh & 3;
        AttnArgs a;
        const int qpos_w0 = qt * 128 + wv * 16;
        a.Q = H; a.ldq = HN; a.qcol[0] = HC_QA + h * 128; a.qcol[1] = HC_QA + h * 128 + 64; a.qtok = (size_t)b * SEQ + qpos_w0 + fr; a.qgain = p.in[I_AQG] + l * 64; a.qscale = 0.125f * LOG2E;
        a.K = H; a.ldk = HN; a.krow0 = (size_t)b * SEQ; a.kcol0 = HC_KA + h * 128;
        a.V = VT; a.ldv = T_TOK; a.vrow0 = h * 128; a.vcol0 = (size_t)b * SEQ;
        a.nkt_blk = 2 * qt + 2; a.my_nkt = ((qpos_w0 + 15) >> 6) + 1; a.qpos = qpos_w0 + fr; a.qpos_w0 = qpos_w0; a.bhead[0] = h; a.bhead[1] = h; a.maskrow = nullptr; a.var = var;
        f32x4 O[2][8]; float ls[2];
        attn_core<2, 64, true, 0>(lds, bt, a, O, ls);
        const float i1 = 1.0f / ls[0], i2 = lam / ls[1]; float ss = 0.f;
#pragma unroll
        for (int dt = 0; dt < 8; ++dt)
#pragma unroll
            for (int i = 0; i < 4; ++i) { const float v = O[0][dt][i] * i1 - O[1][dt][i] * i2; O[0][dt][i] = v; ss += v * v; }
        ss += SHX(ss, 16); ss += SHX(ss, 32);
        const float sc = rsqrtf(ss * (1.0f / 128.0f) + EPSF) * (1.0f - lam_init);
        bf16_t* dst = YA + a.qtok * 512 + h * 128 + 4 * fq;
#pragma unroll
        for (int dt = 0; dt < 8; ++dt) { const f32x4 g = *(const f32x4*)(subln + 16 * dt + 4 * fq); u32x2 w; w.x = cvt_pk_bf16(O[0][dt][0] * sc * g[0], O[0][dt][1] * sc * g[1]); w.y = cvt_pk_bf16(O[0][dt][2] * sc * g[2], O[0][dt][3] * sc * g[3]);
            *(u32x2*)(dst + 16 * dt) = w; }
    }
}
__device__ __forceinline__ void attnC_phase(const Params& p, LAS unsigned char* lds, int l, int var) {
    unsigned char* const wsl = fresh_ptr(p.ws);
    LAS float* bt = (LAS float*)(lds + 98304);
    load_btab(p, bt);
    const bf16_t* H = (const bf16_t*)(wsl + WS_R + R_H); const bf16_t* VT = (const bf16_t*)(wsl + WS_R + R_VT); bf16_t* YC = (bf16_t*)(wsl + WS_YC);
    const unsigned short* mask = (const unsigned short*)(wsl + WS_MASK);
    const int tid = fresh_tid(); const int lane = tid & 63, wv = __builtin_amdgcn_readfirstlane(tid >> 6), fr = lane & 15, fq = lane >> 4;
    const int qs = wv & 3, hp = wv >> 2;
    for (int vb = blockIdx.x; vb < 256; vb += gridDim.x) for (int it = 0; it < 2; ++it) {
        const int xg = vb & 7, sl = vb >> 3;
        const int b = xg * 2 + (sl >> 4), j = sl & 15; const int qt = (it == 0) ? j : 31 - j;
        AttnArgs a;
        const int qpos_w0 = qt * 64 + qs * 16;
        a.Q = H; a.ldq = HN; a.qcol[0] = HC_CQ + (2 * hp) * 128; a.qcol[1] = HC_CQ + (2 * hp + 1) * 128; a.qtok = (size_t)b * SEQ + qpos_w0 + fr; a.qgain = p.in[I_CQG] + l * 128; a.qscale = 0.08838834764831845f * LOG2E;
        a.K = H; a.ldk = HN; a.krow0 = (size_t)b * SEQ; a.kcol0 = HC_CK;
        a.V = VT; a.ldv = T_TOK; a.vrow0 = 512; a.vcol0 = (size_t)b * SEQ;
        a.nkt_blk = qt + 1; a.my_nkt = qt + 1; a.qpos = qpos_w0 + fr; a.qpos_w0 = qpos_w0; a.bhead[0] = 4 + 2 * hp; a.bhead[1] = 5 + 2 * hp; a.maskrow = mask + a.qtok * 128; a.var = var;
        f32x4 O[2][8]; float ls[2];
        attn_core<2, 128, false, 1>(lds, bt, a, O, ls);
#pragma unroll
        for (int s = 0; s < 2; ++s) { const float inv = 1.0f / ls[s]; bf16_t* dst = YC + a.qtok * 512 + (2 * hp + s) * 128 + 4 * fq;
#pragma unroll
            for (int dt = 0; dt < 8; ++dt) { u32x2 w; w.x = cvt_pk_bf16(O[s][dt][0] * inv, O[s][dt][1] * inv); w.y = cvt_pk_bf16(O[s][dt][2] * inv, O[s][dt][3] * inv); *(u32x2*)(dst + 16 * dt) = w; } }
    }
}
__device__ __forceinline__ void attnX_phase(const Params& p, LAS unsigned char* lds, int l) {
    unsigned char* const wsl = fresh_ptr(p.ws);
    const int var = 0;
    const bf16_t* QX = (const bf16_t*)(wsl + WS_YA); const bf16_t* MK = (const bf16_t*)(wsl + WS_MK); const bf16_t* MVT = (const bf16_t*)(wsl + WS_MVT); bf16_t* OX = (bf16_t*)(wsl + WS_YB);
    const int tid = fresh_tid(); const int lane = tid & 63, wv = __builtin_amdgcn_readfirstlane(tid >> 6), fr = lane & 15, fq = lane >> 4;
    for (int unit = blockIdx.x; unit < 1024; unit += gridDim.x) {
        const int b = unit >> 6, h = (unit >> 4) & 3, qt = unit & 15;
        AttnArgs a;
        const int qpos_w0 = qt * 128 + wv * 16;
        a.Q = QX; a.ldq = 512; a.qcol[0] = h * 128; a.qcol[1] = h * 128; a.qtok = (size_t)b * SEQ + qpos_w0 + fr; a.qgain = p.in[I_MQG] + l * 128; a.qscale = 0.08838834764831845f * LOG2E;
        a.K = MK; a.ldk = 512; a.krow0 = (size_t)b * MEMLEN; a.kcol0 = h * 128;
        a.V = MVT; a.ldv = NB * MEMLEN; a.vrow0 = h * 128; a.vcol0 = (size_t)b * MEMLEN;
        a.nkt_blk = 4; a.my_nkt = 4; a.qpos = 0; a.qpos_w0 = 0; a.bhead[0] = 0; a.bhead[1] = 0; a.maskrow = nullptr; a.var = var;
        f32x4 O[1][8]; float ls[1];
        attn_core<1, 128, false, 2>(lds, nullptr, a, O, ls);
        const float inv = 1.0f / ls[0]; bf16_t* dst = OX + a.qtok * 512 + h * 128 + 4 * fq;
#pragma unroll
        for (int dt = 0; dt < 8; ++dt) { u32x2 w; w.x = cvt_pk_bf16(O[0][dt][0] * inv, O[0][dt][1] * inv); w.y = cvt_pk_bf16(O[0][dt][2] * inv, O[0][dt][3] * inv); *(u32x2*)(dst + 16 * dt) = w; }
    }
}

__device__ __forceinline__ unsigned dpp_sum_u32(unsigned x) {
    x += (unsigned)__builtin_amdgcn_update_dpp(0, (int)x, 0xB1, 0xF, 0xF, true); x += (unsigned)__builtin_amdgcn_update_dpp(0, (int)x, 0x4E, 0xF, 0xF, true);
    x += (unsigned)__builtin_amdgcn_update_dpp(0, (int)x, 0x141, 0xF, 0xF, true); x += (unsigned)__builtin_amdgcn_update_dpp(0, (int)x, 0x140, 0xF, 0xF, true);
    { auto r = __builtin_amdgcn_permlane16_swap(x, x, false, false); x = r[0] + r[1]; } { auto r = __builtin_amdgcn_permlane32_swap(x, x, false, false); x = r[0] + r[1]; }
    return x;
}
__device__ __forceinline__ unsigned umaxu(unsigned a, unsigned b) { return a > b ? a : b; }
__device__ __forceinline__ unsigned uminu(unsigned a, unsigned b) { return a < b ? a : b; }
__device__ __forceinline__ unsigned dpp_max_u32(unsigned x) {
    x = umaxu(x, (unsigned)__builtin_amdgcn_update_dpp(0, (int)x, 0xB1, 0xF, 0xF, true)); x = umaxu(x, (unsigned)__builtin_amdgcn_update_dpp(0, (int)x, 0x4E, 0xF, 0xF, true));
    x = umaxu(x, (unsigned)__builtin_amdgcn_update_dpp(0, (int)x, 0x141, 0xF, 0xF, true)); x = umaxu(x, (unsigned)__builtin_amdgcn_update_dpp(0, (int)x, 0x140, 0xF, 0xF, true));
    { auto r = __builtin_amdgcn_permlane16_swap(x, x, false, false); x = umaxu(r[0], r[1]); } { auto r = __builtin_amdgcn_permlane32_swap(x, x, false, false); x = umaxu(r[0], r[1]); }
    return x;
}
__device__ __forceinline__ float key2f_full(unsigned k) { return __uint_as_float((k & 0x80000000u) ? (k & 0x7fffffffu) : ~k); }
__device__ __forceinline__ void csel_phase(const Params& p, LAS unsigned char* lds, int var) {
    unsigned char* const wsl = fresh_ptr(p.ws);
#ifdef ATT_PROBE
#define CV(bit) (var & (bit))
#else
#define CV(bit) 0
#endif
    const bf16_t* H = (const bf16_t*)(wsl + WS_R + R_H); unsigned short* mask = (unsigned short*)(wsl + WS_MASK);
    constexpr int SC_ROW = 8208;
    const int tid = fresh_tid(); const int lane = tid & 63, wv = __builtin_amdgcn_readfirstlane(tid >> 6), fr = lane & 15, fq = lane >> 4;
    for (int c = blockIdx.x; c < 256; c += gridDim.x) {
        const int b = c >> 4, j = c & 15;
        for (int it = 0; it < 8; ++it) {
            const int i = (it & 1) ? (32 * (it >> 1) + 31 - j) : (32 * (it >> 1) + j);
            if (!CV(1)) {
                const size_t qtok = (size_t)b * SEQ + 16 * i + fr;
                bf16x8 bq[8][2]; float wq[8];
#pragma unroll
                for (int h = 0; h < 8; ++h)
#pragma unroll
                    for (int ks = 0; ks < 2; ++ks) bq[h][ks] = *(const bf16x8*)(H + qtok * HN + HC_IQ + h * 64 + 32 * ks + 8 * fq);
                { const u32x4 w = *(const u32x4*)(H + qtok * HN + HC_IW); wq[0] = bf_lo(w.x); wq[1] = bf_hi(w.x); wq[2] = bf_lo(w.y); wq[3] = bf_hi(w.y); wq[4] = bf_lo(w.z); wq[5] = bf_hi(w.z); wq[6] = bf_lo(w.w); wq[7] = bf_hi(w.w); }
                const bf16_t* kbase = H + ((size_t)b * SEQ + fr) * HN + HC_IK + 8 * fq;
                bf16x8 ka0, ka1; ka0 = ka1 = (bf16x8){0, 0, 0, 0, 0, 0, 0, 0};
                if (wv <= i) { const bf16_t* kp = kbase + (size_t)(16 * wv) * HN; ka0 = *(const bf16x8*)kp; ka1 = *(const bf16x8*)(kp + 32); }
                for (int st = wv; st <= i; st += 8) {
                    bf16x8 na0 = ka0, na1 = ka1;
                    if (st + 8 <= i) { const bf16_t* kp = kbase + (size_t)(16 * (st + 8)) * HN; na0 = *(const bf16x8*)kp; na1 = *(const bf16x8*)(kp + 32); }
                    f32x4 sc = (f32x4){0.f, 0.f, 0.f, 0.f};
#pragma unroll
                    for (int h = 0; h < 8; ++h) { f32x4 acc = __builtin_amdgcn_mfma_f32_16x16x32_bf16(ka0, bq[h][0], (f32x4){0.f, 0.f, 0.f, 0.f}, 0, 0, 0); acc = __builtin_amdgcn_mfma_f32_16x16x32_bf16(ka1, bq[h][1], acc, 0, 0, 0);
#pragma unroll
                        for (int k = 0; k < 4; ++k) sc[k] = __builtin_fmaf(fmaxf(acc[k], 0.f), wq[h], sc[k]); }
                    *(LAS f32x4*)(lds + fr * SC_ROW + (16 * st + 4 * fq) * 4) = sc;
                    ka0 = na0; ka1 = na1;
                }
            }
            __syncthreads();
#pragma unroll 1
            for (int qq = 0; qq < 2; ++qq) {
                const int q = 2 * wv + qq, qpos = 16 * i + q; const size_t tok = (size_t)b * SEQ + qpos;
                float u[8][4];
#pragma unroll
                for (int j2 = 0; j2 < 8; ++j2) { const f32x4 v = *(const LAS f32x4*)(lds + q * SC_ROW + (j2 * 256 + 4 * lane) * 4);
#pragma unroll
                    for (int k = 0; k < 4; ++k) u[j2][k] = (j2 * 256 + 4 * lane + k <= qpos) ? v[k] : NEG_INF; }
                unsigned qv[8][4]; unsigned T = 65535u;
                if (qpos >= 256 && !CV(2)) {
                    float mx = NEG_INF, mnv = -NEG_INF;
#pragma unroll
                    for (int j2 = 0; j2 < 8; ++j2)
#pragma unroll
                        for (int k = 0; k < 4; ++k) { mx = fmaxf(mx, u[j2][k]); mnv = fminf(mnv, (u[j2][k] == NEG_INF) ? -NEG_INF : u[j2][k]); }
                    mx = key2f_full(dpp_max_u32(ukey(mx))); mnv = key2f_full(~dpp_max_u32(~ukey(mnv)));
                    const float Sc = 255.99f / fmaxf(mx - mnv, 1e-20f);
#pragma unroll
                    for (int j2 = 0; j2 < 8; ++j2)
#pragma unroll
                        for (int k = 0; k < 4; ++k) { const float v = u[j2][k]; const float t = (mx - v) * Sc; const int bn = (int)t; const int bc = bn > 255 ? 255 : bn;
                            int sb = (int)((t - (float)bc) * 256.0f); sb = sb > 255 ? 255 : (sb < 0 ? 0 : sb);
                            qv[j2][k] = (v != NEG_INF) ? (unsigned)(bc * 256 + sb) : 65536u; }
                    LAS unsigned* hist = (LAS unsigned*)(lds + 131584 + wv * 1024);
                    unsigned need = 256u; int B1 = 256, B2 = 256;
#pragma unroll 1
                    for (int lvl = 0; lvl < 2; ++lvl) {
                        *(LAS u32x4*)(hist + 4 * lane) = (u32x4){0u, 0u, 0u, 0u};
#pragma unroll
                        for (int j2 = 0; j2 < 8; ++j2)
#pragma unroll
                            for (int k = 0; k < 4; ++k) { const unsigned q = qv[j2][k];
                                if (lvl == 0) { if (q < 65536u) (void)__hip_atomic_fetch_add(hist + (q >> 8), 1u, __ATOMIC_RELAXED, __HIP_MEMORY_SCOPE_WORKGROUP); }
                                else if ((int)(q >> 8) == B1) (void)__hip_atomic_fetch_add(hist + (q & 255u), 1u, __ATOMIC_RELAXED, __HIP_MEMORY_SCOPE_WORKGROUP); }
                        const u32x4 h4 = *(const LAS u32x4*)(hist + 4 * lane);
                        const unsigned s4 = h4.x + h4.y + h4.z + h4.w; unsigned pre = s4;
                        pre += (unsigned)__builtin_amdgcn_update_dpp(0, (int)pre, 0x111, 0xF, 0xF, true); pre += (unsigned)__builtin_amdgcn_update_dpp(0, (int)pre, 0x112, 0xF, 0xF, true);
                        pre += (unsigned)__builtin_amdgcn_update_dpp(0, (int)pre, 0x114, 0xF, 0xF, true); pre += (unsigned)__builtin_amdgcn_update_dpp(0, (int)pre, 0x118, 0xF, 0xF, true);
                        pre += (unsigned)__builtin_amdgcn_update_dpp(0, (int)pre, 0x142, 0xA, 0xF, false); pre += (unsigned)__builtin_amdgcn_update_dpp(0, (int)pre, 0x143, 0xC, 0xF, false);
                        const unsigned long long bal = __ballot(pre >= need);
                        const int L = bal ? (int)__builtin_ctzll(bal) : 63;
                        unsigned c = (unsigned)__builtin_amdgcn_readlane((int)(pre - s4), L);
                        const unsigned hx = (unsigned)__builtin_amdgcn_readlane((int)h4.x, L), hy = (unsigned)__builtin_amdgcn_readlane((int)h4.y, L), hz = (unsigned)__builtin_amdgcn_readlane((int)h4.z, L);
                        int Bsel = 4 * L + 3;
                        if (c + hx >= need) Bsel = 4 * L; else { c += hx; if (c + hy >= need) Bsel = 4 * L + 1; else { c += hy; if (c + hz >= need) Bsel = 4 * L + 2; else c += hz; } }
                        if (lvl == 0) { B1 = Bsel; need -= c; } else B2 = Bsel;
                    }
                    T = (unsigned)(B1 * 256 + B2);
                } else {
#pragma unroll
                    for (int j2 = 0; j2 < 8; ++j2)
#pragma unroll
                        for (int k = 0; k < 4; ++k) qv[j2][k] = (u[j2][k] != NEG_INF) ? 0u : 65536u;
                }
                if (!CV(4))
#pragma unroll
                for (int j2 = 0; j2 < 8; ++j2) {
                    const int st = j2 * 16 + (lane >> 2);
                    unsigned nib = 0u;
#pragma unroll
                    for (int k = 0; k < 4; ++k) if (qv[j2][k] <= T) nib |= (1u << k);
                    unsigned wd = nib << (4 * (lane & 3));
                    wd |= (unsigned)__builtin_amdgcn_update_dpp(0, (int)wd, 0xB1, 0xF, 0xF, true); wd |= (unsigned)__builtin_amdgcn_update_dpp(0, (int)wd, 0x4E, 0xF, 0xF, true);
                    if ((lane & 3) == 0 && st <= (i | 3)) mask[tok * 128 + st] = (unsigned short)wd;
                }
            }
            __syncthreads();
        }
    }
}
__device__ __forceinline__ void ins16(unsigned (&L)[16], unsigned x) {
#pragma unroll
    for (int j = 0; j < 16; ++j) { const unsigned hi = L[j] > x ? L[j] : x; x = L[j] > x ? x : L[j]; L[j] = hi; }
}
__device__ __forceinline__ float key2f(unsigned k) { return __uint_as_float((k & 0x80000000u) ? (k & 0x7fffffffu) : ~k); }
#define TK_CE(a, b) { const unsigned hi_ = (a) > (b) ? (a) : (b), lo_ = (a) > (b) ? (b) : (a); (a) = hi_; (b) = lo_; }
__device__ __forceinline__ void sort16_desc(unsigned (&x)[16]) {
    TK_CE(x[0], x[1]) TK_CE(x[2], x[3]) TK_CE(x[0], x[2]) TK_CE(x[1], x[3]) TK_CE(x[1], x[2]) TK_CE(x[4], x[5]) TK_CE(x[6], x[7]) TK_CE(x[4], x[6]) TK_CE(x[5], x[7]) TK_CE(x[5], x[6]) TK_CE(x[0], x[4]) TK_CE(x[2], x[6]) TK_CE(x[2], x[4]) TK_CE(x[1], x[5]) TK_CE(x[3], x[7]) TK_CE(x[3], x[5]) TK_CE(x[1], x[2]) TK_CE(x[3], x[4]) TK_CE(x[5], x[6]) TK_CE(x[8], x[9]) TK_CE(x[10], x[11]) TK_CE(x[8], x[10]) TK_CE(x[9], x[11]) TK_CE(x[9], x[10]) TK_CE(x[12], x[13]) TK_CE(x[14], x[15]) TK_CE(x[12], x[14]) TK_CE(x[13], x[15]) TK_CE(x[13], x[14]) TK_CE(x[8], x[12]) TK_CE(x[10], x[14]) TK_CE(x[10], x[12]) TK_CE(x[9], x[13]) TK_CE(x[11], x[15]) TK_CE(x[11], x[13]) TK_CE(x[9], x[10]) TK_CE(x[11], x[12]) TK_CE(x[13], x[14]) TK_CE(x[0], x[8]) TK_CE(x[4], x[12]) TK_CE(x[4], x[8]) TK_CE(x[2], x[10]) TK_CE(x[6], x[14]) TK_CE(x[6], x[10]) TK_CE(x[2], x[4]) TK_CE(x[6], x[8]) TK_CE(x[10], x[12]) TK_CE(x[1], x[9]) TK_CE(x[5], x[13]) TK_CE(x[5], x[9]) TK_CE(x[3], x[11]) TK_CE(x[7], x[15]) TK_CE(x[7], x[11]) TK_CE(x[3], x[5]) TK_CE(x[7], x[9]) TK_CE(x[11], x[13]) TK_CE(x[1], x[2]) TK_CE(x[3], x[4]) TK_CE(x[5], x[6]) TK_CE(x[7], x[8]) TK_CE(x[9], x[10]) TK_CE(x[11], x[12]) TK_CE(x[13], x[14])
}
__device__ __forceinline__ void merge_top16(unsigned (&L)[16], const unsigned (&x)[16]) {
#pragma unroll
    for (int i = 0; i < 16; ++i) L[i] = L[i] > x[15 - i] ? L[i] : x[15 - i];
#pragma unroll
    for (int j = 8; j > 0; j >>= 1)
#pragma unroll
        for (int i = 0; i < 16; ++i) { const int l = i ^ j; if (l > i) TK_CE(L[i], L[l]) }
}
__device__ __forceinline__ float okey16_to_f(unsigned key) {
    const unsigned k = key >> 16; const unsigned h = (k & 0x8000u) ? (k & 0x7fffu) : (~k & 0xffffu);
    return (float)__builtin_bit_cast(_Float16, (unsigned short)h);
}
__device__ __forceinline__ void top16_of_128(const unsigned short* sp, unsigned (&L)[16]) {
#pragma unroll
    for (int c = 0; c < 4; ++c) {
        u32x4 v[4];
#pragma unroll
        for (int q = 0; q < 4; ++q) v[q] = *(const u32x4*)(sp + c * 32 + q * 8);
#pragma unroll
        for (int g = 0; g < 2; ++g) { unsigned x[16];
#pragma unroll
            for (int q = 0; q < 2; ++q)
#pragma unroll
                for (int i = 0; i < 4; ++i) { const unsigned w = v[2 * g + q][i]; const int e0 = c * 32 + g * 16 + q * 8 + 2 * i;
                    x[8 * q + 2 * i] = (w << 16) | (unsigned)(127 - e0); x[8 * q + 2 * i + 1] = (w & 0xffff0000u) | (unsigned)(127 - (e0 + 1)); }
            sort16_desc(x);
            if (c == 0 && g == 0) {
#pragma unroll
                for (int i = 0; i < 16; ++i) L[i] = x[i]; }
            else merge_top16(L, x); }
    }
}
__device__ __forceinline__ void peer_topk_phase(const Params& p, LAS unsigned char* lds) {
    unsigned char* const wsl = fresh_ptr(p.ws);
    const unsigned short* PS = (const unsigned short*)(wsl + WS_R + R_PS); int* EIDX = (int*)(wsl + WS_YC); float* EGATE = (float*)(wsl + WS_YC + 16 * MiB);
    const int tid = fresh_tid();
    for (int item = blockIdx.x * 512 + tid; item < T_TOK * 8; item += gridDim.x * 512) {
        const int tok = item >> 3, h = item & 7;
        const unsigned short* sp = PS + (size_t)tok * 2048 + h * 256;
        unsigned L1[16], L2[16], L3[16];
        top16_of_128(sp, L1);
        top16_of_128(sp + 128, L2);
        float v1[16], v2[16];
#pragma unroll
        for (int j = 0; j < 16; ++j) { v1[j] = okey16_to_f(L1[j]); v2[j] = okey16_to_f(L2[j]); }
        { unsigned t0[16] = {(ukey(v1[0] + v2[0]) & ~255u) | 255u, (ukey(v1[0] + v2[1]) & ~255u) | 254u, (ukey(v1[0] + v2[2]) & ~255u) | 253u, (ukey(v1[0] + v2[3]) & ~255u) | 252u, (ukey(v1[0] + v2[4]) & ~255u) | 251u, (ukey(v1[0] + v2[5]) & ~255u) | 250u, (ukey(v1[0] + v2[6]) & ~255u) | 249u, (ukey(v1[0] + v2[7]) & ~255u) | 248u, (ukey(v1[0] + v2[8]) & ~255u) | 247u, (ukey(v1[0] + v2[9]) & ~255u) | 246u, (ukey(v1[0] + v2[10]) & ~255u) | 245u, (ukey(v1[0] + v2[11]) & ~255u) | 244u, (ukey(v1[0] + v2[12]) & ~255u) | 243u, (ukey(v1[0] + v2[13]) & ~255u) | 242u, (ukey(v1[0] + v2[14]) & ~255u) | 241u, (ukey(v1[0] + v2[15]) & ~255u) | 240u};
          sort16_desc(t0);
#pragma unroll
          for (int j = 0; j < 16; ++j) L3[j] = t0[j]; }
        { unsigned xg[16] = {(ukey(v1[1] + v2[0]) & ~255u) | 239u, (ukey(v1[1] + v2[1]) & ~255u) | 238u, (ukey(v1[1] + v2[2]) & ~255u) | 237u, (ukey(v1[1] + v2[3]) & ~255u) | 236u, (ukey(v1[1] + v2[4]) & ~255u) | 235u, (ukey(v1[1] + v2[5]) & ~255u) | 234u, (ukey(v1[1] + v2[6]) & ~255u) | 233u, (ukey(v1[1] + v2[7]) & ~255u) | 232u, (ukey(v1[2] + v2[0]) & ~255u) | 223u, (ukey(v1[2] + v2[1]) & ~255u) | 222u, (ukey(v1[2] + v2[2]) & ~255u) | 221u, (ukey(v1[2] + v2[3]) & ~255u) | 220u, (ukey(v1[2] + v2[4]) & ~255u) | 219u, (ukey(v1[3] + v2[0]) & ~255u) | 207u, (ukey(v1[3] + v2[1]) & ~255u) | 206u, (ukey(v1[3] + v2[2]) & ~255u) | 205u};
          sort16_desc(xg); merge_top16(L3, xg); }
        { unsigned xg[16] = {(ukey(v1[3] + v2[3]) & ~255u) | 204u, (ukey(v1[4] + v2[0]) & ~255u) | 191u, (ukey(v1[4] + v2[1]) & ~255u) | 190u, (ukey(v1[4] + v2[2]) & ~255u) | 189u, (ukey(v1[5] + v2[0]) & ~255u) | 175u, (ukey(v1[5] + v2[1]) & ~255u) | 174u, (ukey(v1[6] + v2[0]) & ~255u) | 159u, (ukey(v1[6] + v2[1]) & ~255u) | 158u, (ukey(v1[7] + v2[0]) & ~255u) | 143u, (ukey(v1[7] + v2[1]) & ~255u) | 142u, (ukey(v1[8] + v2[0]) & ~255u) | 127u, (ukey(v1[9] + v2[0]) & ~255u) | 111u, (ukey(v1[10] + v2[0]) & ~255u) | 95u, (ukey(v1[11] + v2[0]) & ~255u) | 79u, (ukey(v1[12] + v2[0]) & ~255u) | 63u, (ukey(v1[13] + v2[0]) & ~255u) | 47u};
          sort16_desc(xg); merge_top16(L3, xg); }
        ins16(L3, (ukey(v1[14] + v2[0]) & ~255u) | 31u);
        ins16(L3, (ukey(v1[15] + v2[0]) & ~255u) | 15u);
        int eo[16]; float go[16]; float gsum = 0.f; const float cmax = key2f(L3[0] & ~255u);
        unsigned pk1[4] = {0u, 0u, 0u, 0u}, pk2[4] = {0u, 0u, 0u, 0u};
#pragma unroll
        for (int j = 0; j < 16; ++j) { pk1[j >> 2] |= (L1[j] & 127u) << (8 * (j & 3)); pk2[j >> 2] |= (L2[j] & 127u) << (8 * (j & 3)); }
#pragma unroll
        for (int i = 0; i < 16; ++i) { const int code = 255 - (int)(L3[i] & 255u); const int a = code >> 4, b = code & 15;
            const unsigned wa = (a & 8) ? ((a & 4) ? pk1[3] : pk1[2]) : ((a & 4) ? pk1[1] : pk1[0]), wb = (b & 8) ? ((b & 4) ? pk2[3] : pk2[2]) : ((b & 4) ? pk2[1] : pk2[0]);
            const int e1 = (int)((wa >> (8 * (a & 3))) & 127u), e2 = (int)((wb >> (8 * (b & 3))) & 127u);
            eo[i] = (127 - e1) * 128 + (127 - e2); go[i] = __expf(key2f(L3[i] & ~255u) - cmax); gsum += go[i]; }
        const float ginv = 1.0f / gsum;
        unsigned* ep = (unsigned*)EIDX + (size_t)tok * 128 + h * 16;
#pragma unroll
        for (int q = 0; q < 4; ++q) { u32x4 w;
            w.x = (unsigned)eo[4 * q] | (cvt_pk_bf16(0.f, go[4 * q] * ginv) & 0xffff0000u); w.y = (unsigned)eo[4 * q + 1] | (cvt_pk_bf16(0.f, go[4 * q + 1] * ginv) & 0xffff0000u);
            w.z = (unsigned)eo[4 * q + 2] | (cvt_pk_bf16(0.f, go[4 * q + 2] * ginv) & 0xffff0000u); w.w = (unsigned)eo[4 * q + 3] | (cvt_pk_bf16(0.f, go[4 * q + 3] * ginv) & 0xffff0000u);
            *(u32x4*)(ep + 4 * q) = w; }
    }
}
constexpr size_t PE_US = 0, PE_VS = 8 * MiB, PE_USC = 16 * MiB, PE_VSC = 17 * MiB;
__device__ __forceinline__ u32x4 pack_fp4_32(const f32x4 (&v)[8], float isc) {
    unsigned w[4];
#pragma unroll
    for (int d = 0; d < 4; ++d) { unsigned t = 0u;
        t = __builtin_amdgcn_cvt_scalef32_pk_fp4_f32(t, v[2 * d][0] * isc, v[2 * d][1] * isc, 1.0f, 0); t = __builtin_amdgcn_cvt_scalef32_pk_fp4_f32(t, v[2 * d][2] * isc, v[2 * d][3] * isc, 1.0f, 1);
        t = __builtin_amdgcn_cvt_scalef32_pk_fp4_f32(t, v[2 * d + 1][0] * isc, v[2 * d + 1][1] * isc, 1.0f, 2); t = __builtin_amdgcn_cvt_scalef32_pk_fp4_f32(t, v[2 * d + 1][2] * isc, v[2 * d + 1][3] * isc, 1.0f, 3);
        w[d] = t; }
    return (u32x4){w[0], w[1], w[2], w[3]};
}
__device__ __forceinline__ float fp4_block_scale(const f32x4 (&v)[8]) {
    float am = 0.f;
#pragma unroll
    for (int q = 0; q < 8; ++q) am = fmaxf(am, fmaxf(fmaxf(fabsf(v[q][0]), fabsf(v[q][1])), fmaxf(fabsf(v[q][2]), fabsf(v[q][3]))));
    am = fmaxf(am, 1e-30f);
    const int eb = (int)((__float_as_uint(am) >> 23) & 0xffu);
    float sc = __uint_as_float((unsigned)(eb - 2) << 23);
    if (am > 6.0f * sc) sc *= 2.0f;
    return sc;
}
__device__ __forceinline__ void conv_peer_tables(const float* pu, const float* pv, unsigned char* dst) {
    const int tid = fresh_tid(); const int lane = tid & 63, hl = lane & 31, gw = blockIdx.x * 8 + (tid >> 6), nw = gridDim.x * 8;
    const int q = hl >> 3, c = hl & 7;
    for (int r2 = gw; r2 < 8192; r2 += nw) {
        const int e = 2 * r2 + (lane >> 5);
        f32x4 a[8], b[8];
#pragma unroll
        for (int k = 0; k < 8; ++k) { a[k] = *(const f32x4*)(pu + (size_t)e * 1024 + 32 * hl + 4 * k); b[k] = *(const f32x4*)(pv + (size_t)e * 1024 + 32 * hl + 4 * k); }
        const float su = fp4_block_scale(a), sv = fp4_block_scale(b);
        const size_t row = (size_t)q * 16384 + e;
        *(u32x4*)(dst + PE_US + row * 128 + 16 * c) = pack_fp4_32(a, 1.0f / su);
        *(u32x4*)(dst + PE_VS + row * 128 + 16 * c) = pack_fp4_32(b, 1.0f / sv);
        dst[PE_USC + row * 16 + 2 * (c & 3) + (c >> 2)] = (unsigned char)((__float_as_uint(su) >> 23) & 0xffu);
        dst[PE_VSC + row * 8 + c] = (unsigned char)((__float_as_uint(sv) >> 23) & 0xffu);
    }
}
typedef float f32x2g __attribute__((ext_vector_type(2)));
typedef int v8i_t __attribute__((ext_vector_type(8)));
typedef int v4i_u __attribute__((ext_vector_type(4)));
#define FP4X2(w, b) __builtin_amdgcn_cvt_scalef32_pk_f32_fp4((w), 1.0f, (b))
__device__ __forceinline__ void peer_slice_map(const Params& p, LAS unsigned char* lds, int& q, int& half, int& bx, int& nbx) {
    LAS int* sm = (LAS int*)(lds + LDS_BAR_OFF - 32);
    __syncthreads();
    if (threadIdx.x == 0) {
        unsigned* barw = (unsigned*)(fresh_ptr(p.ws) + WS_CTL);
        const unsigned x = xb_xcc_id(); bool hw = x < 8u; unsigned mine = 0u;
        for (unsigned jx = 0; jx < 16; ++jx) { const unsigned cn = xb_ld(&barw[XB_XCNT(jx)]); if (jx < 8u) hw = hw && (cn > 0u); else hw = hw && (cn == 0u); if (jx == x) mine = cn; }
        const unsigned rk = ((volatile LAS unsigned*)(lds + LDS_BAR_OFF))[2];
        hw = hw && rk >= 1u && rk <= mine;
#if MK_MULTI || defined(MPROBE) || defined(PROBE_CHK) || defined(PROBE_DET) || defined(PROBE_K) || defined(NO_HW_MAP)
        hw = false;
#endif
        const int xcd = hw ? (int)x : (int)(blockIdx.x & 7);
        sm[0] = xcd & 3; sm[1] = xcd >> 2; sm[2] = hw ? (int)(rk - 1u) : (int)(blockIdx.x >> 3); sm[3] = hw ? (int)mine : (int)((gridDim.x + 7 - xcd) >> 3);
    }
    __syncthreads();
    q = sm[0]; half = sm[1]; bx = sm[2]; nbx = sm[3];
    __syncthreads();
}
__device__ __forceinline__ void peer_udot_phase(const Params& p, LAS unsigned char* lds, int var) {
    (void)var;
#ifdef ATT_PROBE
#define PUV(bit) (var & (bit))
#else
#define PUV(bit) 0
#endif
    unsigned char* const wsl = fresh_ptr(p.ws);
    const bf16_t* XN = (const bf16_t*)(wsl + WS_XN); const int* EIDX = (const int*)(wsl + WS_YC); bf16_t* PZ = (bf16_t*)(wsl + WS_R);
    const int tid = fresh_tid(); const int lane = tid & 63, wv = __builtin_amdgcn_readfirstlane(tid >> 6), fr = lane & 15, fq = lane >> 4;
    int q, half, bx, nbx; peer_slice_map(p, lds, q, half, bx, nbx);
    const unsigned char* US = wsl + WS_YA + PE_US + (size_t)q * 16384 * 128; const unsigned char* USC = wsl + WS_YA + PE_USC + (size_t)q * 16384 * 16;
    LAS unsigned* eid = (LAS unsigned*)(lds + wv * 512);
    LAS unsigned char* xb = lds + 4096 + wv * 512;
    LAS unsigned char* usl = lds + 8192 + wv * 2048;
    LAS unsigned char* ub = lds + 24576 + wv * 16384;
    const int stride = nbx * 8, tlim = T_TOK / 2;
    int ti = bx * 8 + wv;
    if (ti >= tlim) return;
    unsigned idr[16], es0, es1;
#define PU_IDS() { _Pragma("unroll") for (int i = 0; i < 16; ++i) idr[i] = eid[8 * i + (lane >> 3)] & 0x3fffu; es0 = eid[lane] & 0x3fffu; es1 = eid[64 + lane] & 0x3fffu; asm volatile("s_waitcnt lgkmcnt(0)" ::: "memory"); }
#define PU_ROWS(i0) { _Pragma("unroll") for (int i = (i0); i < (i0) + 8; ++i) { const int k = 8 * i + (lane >> 3); \
        const unsigned char* src = US + (unsigned)(idr[i] * 128u + 16u * (unsigned)((lane & 7) ^ ((k >> 1) & 7)));     \
        __builtin_amdgcn_global_load_lds((const unsigned*)src, (LAS unsigned*)(ub + i * 1024), 16, 0, 0); } }
#define PU_SMALL(tx, te) if (!PUV(32)) { \
        __builtin_amdgcn_global_load_lds((const unsigned*)(USC + (unsigned)(es0 * 16u)), (LAS unsigned*)usl, 16, 0, 0); __builtin_amdgcn_global_load_lds((const unsigned*)(USC + (unsigned)(es1 * 16u)), (LAS unsigned*)(usl + 1024), 16, 0, 0); \
        if (lane < 32) { __builtin_amdgcn_global_load_lds((const unsigned*)(XN + (size_t)(tx) * 1024 + 256 * q) + 4 * lane, (LAS unsigned*)xb, 16, 0, 0); }          \
        if (lane < 32) { __builtin_amdgcn_global_load_lds((const unsigned*)(EIDX + (size_t)(te) * 128) + 4 * lane, eid, 16, 0, 0); } }
    {   const int tok0 = half * tlim + ti, tn = (ti + stride < tlim) ? tok0 + stride : tok0;
        eid[lane] = (unsigned)EIDX[(size_t)tok0 * 128 + lane]; eid[64 + lane] = (unsigned)EIDX[(size_t)tok0 * 128 + 64 + lane];
        PU_IDS()
        PU_ROWS(0) PU_SMALL(tok0, tn) PU_ROWS(8) }
    bool first = true;
    for (; ti < tlim; ti += stride) {
        const int tok = half * tlim + ti;
        if (first) asm volatile("s_waitcnt vmcnt(8)" ::: "memory"); else asm volatile("s_waitcnt vmcnt(9)" ::: "memory");
        first = false;
        v8i_t xq[2];
#pragma unroll
        for (int k = 0; k < 8; ++k) { const u32x4 w = *(const LAS u32x4*)(xb + 2 * (128 * (k >> 2) + 16 * fq + 64 * ((k >> 1) & 1) + 8 * (k & 1))); unsigned d0 = 0u, d1 = 0u;
            d0 = __builtin_amdgcn_cvt_pk_fp8_f32(bf_lo(w.x), bf_hi(w.x), d0, false); d0 = __builtin_amdgcn_cvt_pk_fp8_f32(bf_lo(w.y), bf_hi(w.y), d0, true);
            d1 = __builtin_amdgcn_cvt_pk_fp8_f32(bf_lo(w.z), bf_hi(w.z), d1, false); d1 = __builtin_amdgcn_cvt_pk_fp8_f32(bf_lo(w.w), bf_hi(w.w), d1, true);
            xq[k >> 2][2 * (k & 3)] = (int)d0; xq[k >> 2][2 * (k & 3) + 1] = (int)d1; }
        unsigned usc[8]; u32x4 a0[4], a1[4];
#pragma unroll
        for (int b = 0; b < 8; ++b) usc[b] = *(const LAS unsigned short*)(usl + 16 * (16 * b + fr) + 2 * fq);
#pragma unroll
        for (int b = 0; b < 4; ++b) { const LAS unsigned char* row = ub + (16 * b + fr) * 128; const int sw = fr >> 1;
            a0[b] = *(const LAS u32x4*)(row + ((fq ^ sw) << 4)); a1[b] = *(const LAS u32x4*)(row + (((4 + fq) ^ sw) << 4)); }
        PU_IDS()
        {   const int tn = (ti + stride < tlim) ? tok + stride : tok, t2 = (ti + 2 * stride < tlim) ? tok + 2 * stride : tok;
            PU_ROWS(0) PU_SMALL(tn, t2) }
        f32x4 keep = (f32x4){0.f, 0.f, 0.f, 0.f};
#define PU_MMA(b, A0, A1) { const v4i_u q0 = (v4i_u){(int)A0.x, (int)A0.y, (int)A0.z, (int)A0.w}, q1 = (v4i_u){(int)A1.x, (int)A1.y, (int)A1.z, (int)A1.w}; \
            const v8i_t av0 = __builtin_shufflevector(q0, q0, 0, 1, 2, 3, -1, -1, -1, -1), av1 = __builtin_shufflevector(q1, q1, 0, 1, 2, 3, -1, -1, -1, -1);     \
            f32x4 dacc = __builtin_amdgcn_mfma_scale_f32_16x16x128_f8f6f4(av0, xq[0], (f32x4){0.f, 0.f, 0.f, 0.f}, 4, 0, 0, (int)usc[b], 0, 127); \
            dacc = __builtin_amdgcn_mfma_scale_f32_16x16x128_f8f6f4(av1, xq[1], dacc, 4, 0, 1, (int)usc[b], 0, 127); \
            if ((fr & 7) == (b)) keep = dacc; }
#pragma unroll
        for (int b = 0; b < 4; ++b) PU_MMA(b, a0[b], a1[b])
        asm volatile("s_waitcnt vmcnt(12)" : "+v"(keep) :: "memory");
#pragma unroll
        for (int b = 0; b < 4; ++b) { const LAS unsigned char* row = ub + (64 + 16 * b + fr) * 128; const int sw = fr >> 1;
            a0[b] = *(const LAS u32x4*)(row + ((fq ^ sw) << 4)); a1[b] = *(const LAS u32x4*)(row + (((4 + fq) ^ sw) << 4)); }
        asm volatile("s_waitcnt lgkmcnt(0)" ::: "memory");
        PU_ROWS(8)
#pragma unroll
        for (int b = 0; b < 4; ++b) PU_MMA(4 + b, a0[b], a1[b])
        asm volatile("" : "+v"(keep));
        if (fr < 8) { u32x2 o; o.x = cvt_pk_bf16(keep[0], keep[1]); o.y = cvt_pk_bf16(keep[2], keep[3]);
            *(u32x2*)(PZ + ((size_t)q * T_TOK + tok) * 128 + 16 * fr + 4 * fq) = o; }
    }
#undef PU_IDS
#undef PU_ROWS
#undef PU_SMALL
#undef PU_MMA
#undef PUV
}
struct PvCoefIn { unsigned w0, w1, w2, w3; f32x2g g; u32x2 e; u32x2 s0, s1; };
typedef int v2i_t __attribute__((ext_vector_type(2)));
typedef int v4i_t __attribute__((ext_vector_type(4)));
typedef unsigned short u16x2_t __attribute__((ext_vector_type(2)));
__device__ __forceinline__ unsigned max_byte8(u32x2 s) {
    const unsigned a = s.x & 0x00ff00ffu, b = (s.x >> 8) & 0x00ff00ffu, c = s.y & 0x00ff00ffu, d = (s.y >> 8) & 0x00ff00ffu;
    const u16x2_t m = __builtin_elementwise_max(__builtin_elementwise_max(__builtin_bit_cast(u16x2_t, a), __builtin_bit_cast(u16x2_t, b)), __builtin_elementwise_max(__builtin_bit_cast(u16x2_t, c), __builtin_bit_cast(u16x2_t, d)));
    return m.x > m.y ? (unsigned)m.x : (unsigned)m.y;
}
__device__ __forceinline__ void peer_vacc_phase(const Params& p, LAS unsigned char* lds, const unsigned char* rb_in, unsigned char* rb_out, float* fout, bool fin, int var) {
#ifdef ATT_PROBE
#define PVV(bit) (var & (bit))
#else
#define PVV(bit) 0
#endif
    unsigned char* const wsl = fresh_ptr(p.ws);
    const int* EIDX = (const int*)(wsl + WS_YC); const float* EGATE = (const float*)(wsl + WS_YC + 16 * MiB); const bf16_t* PZ = (const bf16_t*)(wsl + WS_R);
    const int tid = fresh_tid(); const int lane = tid & 63, wv = __builtin_amdgcn_readfirstlane(tid >> 6), fr = lane & 15, fq = lane >> 4;
    int q, half, bx, nbx; peer_slice_map(p, lds, q, half, bx, nbx);
    const unsigned char* VS = wsl + WS_YA + PE_VS + (size_t)q * 16384 * 128; const unsigned char* VSC = wsl + WS_YA + PE_VSC + (size_t)q * 16384 * 8;
    LAS unsigned char* ec = lds + wv * 1024;
    LAS unsigned* eidr = (LAS unsigned*)(lds + 8192 + wv * 1536);
    LAS unsigned char* ub = lds + 20480 + wv * 16384;
    const int stride = nbx * 8, tlim = T_TOK / 2;
    int ti = bx * 8 + wv;
    if (ti >= tlim) return;
#define PV_TOK(k_) (half * tlim + ((ti + (k_) * stride < tlim) ? ti + (k_) * stride : ti))
#define PV_LDR(tk, R) { const size_t tb = (size_t)(tk) * 128 + 2 * lane; R.w0 = *(const unsigned*)(PZ + tb); R.w1 = *(const unsigned*)(PZ + (size_t)T_TOK * 128 + tb); \
        R.w2 = *(const unsigned*)(PZ + (size_t)2 * T_TOK * 128 + tb); R.w3 = *(const unsigned*)(PZ + (size_t)3 * T_TOK * 128 + tb); }
#define PV_LDS(R, slot) { const u32x2 e2 = *(const LAS u32x2*)(eidr + 128 * (slot) + 2 * lane); R.g = (f32x2g){bf_hi(e2.x), bf_hi(e2.y)};     \
        R.s0 = *(const u32x2*)(VSC + (size_t)(e2.x & 0x3fffu) * 8); R.s1 = *(const u32x2*)(VSC + (size_t)(e2.y & 0x3fffu) * 8); }
#define PV_S2(R, SOUT) { const float z0 = bf_lo(R.w0) + bf_lo(R.w1) + bf_lo(R.w2) + bf_lo(R.w3), z1 = bf_hi(R.w0) + bf_hi(R.w1) + bf_hi(R.w2) + bf_hi(R.w3); \
        const float c0 = gelu1(z0) * R.g.x, c1 = gelu1(z1) * R.g.y; \
        float am = fmaxf(fabsf(c0) * __uint_as_float(max_byte8(R.s0) << 23), fabsf(c1) * __uint_as_float(max_byte8(R.s1) << 23)); \
        am = __uint_as_float(dpp_max_u32(__float_as_uint(am)));            \
        int sx = 134 - (int)((__float_as_uint(am) >> 23) & 255u); sx = sx > 100 ? 100 : (sx < -100 ? -100 : sx); SOUT = sx; \
        const float up = __uint_as_float((unsigned)(127 + sx) << 23); const float f0 = c0 * up, f1 = c1 * up; \
        _Pragma("unroll") for (int cc = 0; cc < 8; ++cc) { const unsigned b0 = ((cc < 4 ? R.s0.x : R.s0.y) >> (8 * (cc & 3))) & 0xffu, b1 = ((cc < 4 ? R.s1.x : R.s1.y) >> (8 * (cc & 3))) & 0xffu; \
            const unsigned w = __builtin_amdgcn_cvt_pk_fp8_f32(f0 * __uint_as_float(b0 << 23), f1 * __uint_as_float(b1 << 23), 0u, false); \
            *(LAS unsigned short*)(ec + 128 * cc + 2 * lane) = (unsigned short)w; } }
#define PV_IDS(slot) { _Pragma("unroll") for (int i = 0; i < 16; ++i) idr[i] = eidr[128 * (slot) + 8 * i + (lane >> 3)] & 0x3fffu; }
#define PV_DMA(slot) { _Pragma("unroll") for (int i = 0; i < 16; ++i) { const int k = 8 * i + (lane >> 3); \
        const unsigned char* src = VS + (unsigned)(idr[i] * 128u + 16u * (unsigned)((lane & 7) ^ ((k >> 1) & 7))); \
        __builtin_amdgcn_global_load_lds((const unsigned*)src, (LAS unsigned*)(ub + i * 1024), 16, 0, 0); } }
#define PV_EDMA(tk, slot) { if (lane < 32) { __builtin_amdgcn_global_load_lds((const unsigned*)(EIDX + (size_t)(tk) * 128) + 4 * lane, eidr + 128 * (slot), 16, 0, 0); } }
#define PV_STORE() { if (fin) *(f32x4*)(fout + pend_eo) = (f32x4){pend[0], pend[1], pend[2], pend[3]}; \
        else { u32x2 w_; w_.x = cvt_pk_bf16(pend[0], pend[1]); w_.y = cvt_pk_bf16(pend[2], pend[3]); *(u32x2*)(rb_out + (pend_eo >> 10) * 4096 + ((pend_eo & 1023) >> 8) * 1024 + (pend_eo & 255) * 2) = w_; } }
#define PV_EB(tk) ((size_t)(tk) * 1024 + 256 * q + 128 * (fq & 1) + 32 * (fr & 3) + 16 * (fq >> 1) + (fr & ~3))
#define PV_XLOAD(eb_) (*(const u32x2*)(rb_in + ((eb_) >> 10) * 4096 + (((eb_) & 1023) >> 8) * 1024 + ((eb_) & 255) * 2))
    PvCoefIn r; u32x2 xn; int s_cur = 0, s_next = 0; unsigned idr[16]; float pend[4] = {0.f, 0.f, 0.f, 0.f}; size_t pend_eo = 0; bool have_pend = false;
    int s0 = 0, s1 = 1, s2 = 2;
    {   const int tokA = PV_TOK(0), tokB = PV_TOK(1), tokC = PV_TOK(2);
        eidr[lane] = (unsigned)EIDX[(size_t)tokA * 128 + lane]; eidr[64 + lane] = (unsigned)EIDX[(size_t)tokA * 128 + 64 + lane];
        eidr[128 + lane] = (unsigned)EIDX[(size_t)tokB * 128 + lane]; eidr[192 + lane] = (unsigned)EIDX[(size_t)tokB * 128 + 64 + lane];
        eidr[256 + lane] = (unsigned)EIDX[(size_t)tokC * 128 + lane]; eidr[320 + lane] = (unsigned)EIDX[(size_t)tokC * 128 + 64 + lane];
        PV_LDR(tokA, r) PV_LDS(r, 0) PV_S2(r, s_cur)
        PV_LDR(tokB, r) PV_LDS(r, 1)
        xn = PV_XLOAD(PV_EB(tokA));
        PV_IDS(0)
        asm volatile("s_waitcnt lgkmcnt(0)" ::: "memory");
        PV_DMA(0) }
    for (; ti < tlim; ti += stride) {
        const int tok = half * tlim + ti;
        const size_t eb = PV_EB(tok);
        v8i_t av;
        { const u32x4 alo = *(const LAS u32x4*)(ec + 128 * (fr & 7) + 16 * fq), ahi = *(const LAS u32x4*)(ec + 128 * (fr & 7) + 64 + 16 * fq);
          av[0] = (int)alo.x; av[1] = (int)alo.y; av[2] = (int)alo.z; av[3] = (int)alo.w; av[4] = (int)ahi.x; av[5] = (int)ahi.y; av[6] = (int)ahi.z; av[7] = (int)ahi.w; }
        asm volatile("s_waitcnt vmcnt(0) lgkmcnt(0)" : "+v"(av) :: "memory");
        if (have_pend && !PVV(64)) PV_STORE()
        const u32x2 xw = xn; const float xv[4] = {bf_lo(xw.x), bf_hi(xw.x), bf_lo(xw.y), bf_hi(xw.y)};
        PvCoefIn rc = r;
        asm volatile("" : "+v"(rc.w0), "+v"(rc.w1), "+v"(rc.w2), "+v"(rc.w3), "+v"(rc.g), "+v"(rc.s0), "+v"(rc.s1));
        { const int tok1 = PV_TOK(1), tok2 = PV_TOK(2);
          if (!PVV(1024)) { PV_LDR(tok2, r) PV_LDS(r, s2) }
          if (!(PVV(64) || PVV(1024))) xn = PV_XLOAD(PV_EB(tok1)); }
        v2i_t bt[16][2];
#pragma unroll
        for (int nt = 0; nt < 16; ++nt)
#pragma unroll
            for (int h = 0; h < 2; ++h) { const int k = 32 * fq + 16 * h + fr;
                if (PVV(128)) bt[nt][h] = (v2i_t){k, nt}; else bt[nt][h] = __builtin_amdgcn_ds_read_tr4_b64_v2i32((LAS v2i_t*)(ub + k * 128 + ((((nt >> 1) ^ (fr >> 1)) & 7) << 4) + 8 * (nt & 1))); }
        PV_IDS(s1)
        asm volatile("s_waitcnt lgkmcnt(0)" ::: "memory");
        if (!PVV(256)) PV_DMA(s1)
        { const int tok3 = PV_TOK(3); PV_EDMA(tok3, s0) }
        if (!PVV(512)) PV_S2(rc, s_next)
        float o[4] = {0.f, 0.f, 0.f, 0.f};
#pragma unroll
        for (int nt = 0; nt < 16; ++nt) {
            const v4i_t b4 = (v4i_t){bt[nt][0].x, bt[nt][0].y, bt[nt][1].x, bt[nt][1].y}; const v8i_t bv = __builtin_shufflevector(b4, b4, 0, 1, 2, 3, -1, -1, -1, -1);
            const f32x4 cacc = PVV(128) ? (f32x4){(float)b4[0], (float)b4[1], (float)b4[2], (float)b4[3]} : __builtin_amdgcn_mfma_scale_f32_16x16x128_f8f6f4(av, bv, (f32x4){0.f, 0.f, 0.f, 0.f}, 0, 4, 0, 127, 0, 127);
            const bool mine = ((nt >> 3) == (fq & 1)) && ((nt & 1) == (fq >> 1));
            o[(nt >> 1) & 3] = mine ? cacc[(nt >> 1) & 3] : o[(nt >> 1) & 3];
        }
        const float dn = __uint_as_float((unsigned)(127 - s_cur) << 23);
#pragma unroll
        for (int i = 0; i < 4; ++i) o[i] *= dn;
        {
            const bool od = (fr & 1) != 0, hi2 = (fr & 2) != 0;
#define PV_XCH(A, B, C, CTL) { const float s_ = (C) ? A : B; const float t_ = __uint_as_float((unsigned)__builtin_amdgcn_update_dpp(0, (int)__float_as_uint(s_), CTL, 0xF, 0xF, true)); if (C) A = t_; else B = t_; }
            PV_XCH(o[0], o[1], od, 0xB1) PV_XCH(o[2], o[3], od, 0xB1) PV_XCH(o[0], o[2], hi2, 0x4E) PV_XCH(o[1], o[3], hi2, 0x4E)
#undef PV_XCH
        }
#pragma unroll
        for (int i = 0; i < 4; ++i) pend[i] = xv[i] + o[i];
        pend_eo = eb; have_pend = true;
        s_cur = s_next;
        { const int tmp = s0; s0 = s1; s1 = s2; s2 = tmp; }
    }
    if (have_pend) PV_STORE()
#undef PV_STORE
#undef PV_EB
#undef PV_XLOAD
#undef PV_TOK
#undef PV_LDR
#undef PV_LDS
#undef PV_EDMA
#undef PV_IDS
#undef PV_S2
#undef PV_DMA
#undef PVV
}
#ifdef PROBE_K
struct DumpSeg { const void* p; size_t n; long long kind; };
__global__ void __launch_bounds__(512) probe_dump(float* out, DumpSeg s0, DumpSeg s1, DumpSeg s2, DumpSeg s3, DumpSeg s4, DumpSeg s5) {
    const DumpSeg segs[6] = {s0, s1, s2, s3, s4, s5};
    const size_t NOUT = (size_t)T_TOK * DM;
    for (size_t i = (size_t)blockIdx.x * 512 + threadIdx.x; i < NOUT; i += (size_t)gridDim.x * 512) {
        float acc = 0.f;
#pragma unroll
        for (int k = 0; k < 6; ++k) { const DumpSeg s = segs[k]; if (s.p == nullptr || s.n == 0) continue;
            for (size_t j = i; j < s.n; j += NOUT) { float v;
                if (s.kind == 0) v = bf2f(((const bf16_t*)s.p)[j]); else if (s.kind == 1) v = ((const float*)s.p)[j]; else if (s.kind == 2) v = (float)((const unsigned short*)s.p)[j] * (1.0f / 65536.0f); else v = (float)(((const int*)s.p)[j] & 0xffff) * (1.0f / 65536.0f);
                if (!(fabsf(v) < 1e30f)) v = 12345.0f;
                acc += v; }
            if (s.n < NOUT) { const size_t j = i % s.n; float v;
                if (s.kind == 0) v = bf2f(((const bf16_t*)s.p)[j]); else if (s.kind == 1) v = ((const float*)s.p)[j]; else if (s.kind == 2) v = (float)((const unsigned short*)s.p)[j] * (1.0f / 65536.0f); else v = (float)(((const int*)s.p)[j] & 0xffff) * (1.0f / 65536.0f);
                if (!(fabsf(v) < 1e30f)) v = 12345.0f;
                if (i >= s.n) acc += v; } }
        out[i] = acc; }
}
#endif
#ifdef PROBE_DET
struct CkSeg { const void* p; size_t nbytes; };
__global__ void __launch_bounds__(512) probe_cksum(unsigned long long* dst, CkSeg s0, CkSeg s1, CkSeg s2, CkSeg s3) {
    const CkSeg segs[4] = {s0, s1, s2, s3};
    unsigned long long h = 0ull;
    for (int k = 0; k < 4; ++k) { const CkSeg s = segs[k]; if (s.p == nullptr) continue; const unsigned* w = (const unsigned*)s.p; const size_t n = s.nbytes / 4;
        for (size_t i = (size_t)blockIdx.x * 512 + threadIdx.x; i < n; i += (size_t)gridDim.x * 512) h += (unsigned long long)w[i] * (unsigned long long)(i * 2654435761ull + 12345ull + (unsigned long long)k * 977ull); }
    for (int o = 32; o; o >>= 1) h += __shfl_xor(h, o);
    if ((threadIdx.x & 63) == 0) atomicAdd(dst, h);
}
__global__ void __launch_bounds__(512) probe_mark(float* out, const unsigned long long* cks, int nph) {
    int code = 0;
    for (int k = nph - 1; k >= 0; --k) if (cks[k] != cks[32 + k] || cks[k] != cks[64 + k]) code = k + 1;
    if (code == 0) return;
    const float f = 2.0f;
    for (size_t i = (size_t)blockIdx.x * 512 + threadIdx.x; i < (size_t)T_TOK * DM; i += (size_t)gridDim.x * 512) out[i] *= f;
}
#endif

#ifdef PROBE_CHK
__device__ __forceinline__ unsigned hsh(unsigned x) { x ^= x >> 16; x *= 0x7feb352du; x ^= x >> 15; x *= 0x846ca68bu; x ^= x >> 16; return x; }
__device__ __forceinline__ void chk_fail(unsigned* flag, int code) { atomicMin(flag, (unsigned)code); }
__device__ __forceinline__ bool close_to(float a, float ref, float atol, float rtol) { return fabsf(a - ref) <= atol + rtol * fabsf(ref) && (a == a); }
__device__ __forceinline__ int h_origcol(int c) { if (c < 1024) return c; if (c < 1536) return c + 512; if (c < 2048) return c + 512; if (c < 2560) return c + 512; if (c < 3072) return c + 768; if (c < 3200) return c; if (c < 3264) return c + 640; return c + 640; }
__device__ __forceinline__ float ref_gelu(float x) { return 0.5f * x * (1.0f + erff(x * 0.70710678f)); }
__global__ void chk_h(Params p, int l, unsigned* flag) {
    const unsigned s = blockIdx.x * blockDim.x + threadIdx.x; const int t = hsh(s * 2 + 1) % T_TOK; const int c = hsh(s * 2 + 2) % 3272;
    const bf16_t* XN = (const bf16_t*)(p.ws + WS_XN); const bf16_t* H = (const bf16_t*)(p.ws + WS_R + R_H); const bf16_t* VT = (const bf16_t*)(p.ws + WS_R + R_VT);
    const float* win = p.in[I_W_IN] + (size_t)l * 1024 * DIN; const int oc = h_origcol(c);
    float r = 0.f; for (int k = 0; k < 1024; ++k) r += bf2f(XN[(size_t)t * 1024 + k]) * win[(size_t)k * DIN + oc];
    if (!close_to(bf2f(H[(size_t)t * HN + c]), r, 0.06f, 0.03f)) chk_fail(flag, 1);
    const int m = hsh(s * 2 + 77) % 640; const int vc = m < 512 ? 1024 + m : 3200 + (m - 512);
    float r2 = 0.f; for (int k = 0; k < 1024; ++k) r2 += bf2f(XN[(size_t)t * 1024 + k]) * win[(size_t)k * DIN + vc];
    if (!close_to(bf2f(VT[(size_t)m * T_TOK + t]), r2, 0.06f, 0.03f)) chk_fail(flag, 2);
}
__global__ void chk_post(Params p, int l, unsigned* flag) {
    const unsigned s = blockIdx.x * blockDim.x + threadIdx.x; const int t = hsh(s * 3 + 1) % T_TOK; const int g = hsh(s * 3 + 2) & 3; const int d = hsh(s * 3 + 3) & 127;
    const bf16_t* H = (const bf16_t*)(p.ws + WS_R + R_H); const bf16_t* YB = (const bf16_t*)(p.ws + WS_YB);
    const int c0 = (t / 128) * 128, tt = t % 128;
    const float* W = p.in[I_BWS] + ((size_t)(l * 4 + g) * 128) * 128; const float* bs = p.in[I_BBS] + (size_t)(l * 4 + g) * 128; const float* vg = p.in[I_BVG] + l * 512 + g * 128;
    float sv = 0.f;
    for (int ss = 0; ss <= tt; ++ss) { const bf16_t* row = H + (size_t)(c0 + ss) * HN + HC_ZV + g * 128; float q = 0.f; for (int dd = 0; dd < 128; ++dd) { const float v = ref_gelu(bf2f(row[dd])); q += v * v; }
        const float vn = ref_gelu(bf2f(row[d])) * rsqrtf(q / 128.f + EPSF) * vg[d]; sv += W[tt * 128 + ss] * vn; }
    sv += bs[tt];
    const float r = ref_gelu(bf2f(H[(size_t)t * HN + HC_ZU + g * 128 + d])) * sv;
    if (!close_to(bf2f(YB[(size_t)t * 512 + g * 128 + d]), r, 0.03f, 0.04f)) chk_fail(flag, 3);
    { const int grp = hsh(s * 3 + 9) & 7; const float* gn = p.in[I_AKG] + l * 64; float q = 0.f; for (int j = 0; j < 64; ++j) { const float v = bf2f(H[(size_t)t * HN + HC_KA + grp * 64 + j]) / gn[j]; q += v * v; }
        if (!close_to(q / 64.f, 1.0f, 0.03f, 0.f)) chk_fail(flag, 5);
        const float* gc = p.in[I_CKG] + l * 128; q = 0.f; for (int j = 0; j < 128; ++j) { const float v = bf2f(H[(size_t)t * HN + HC_CK + j]) / gc[j]; q += v * v; }
        if (!close_to(q / 128.f, 1.0f, 0.03f, 0.f)) chk_fail(flag, 5); }
}
__global__ void chk_mask(Params p, unsigned* flag) {
    const unsigned s = blockIdx.x * blockDim.x + threadIdx.x; const int b = hsh(s * 5 + 1) & 15; const int q = hsh(s * 5 + 2) & 2047;
    const bf16_t* H = (const bf16_t*)(p.ws + WS_R + R_H); const unsigned short* mask = (const unsigned short*)(p.ws + WS_MASK);
    const size_t tq = (size_t)b * SEQ + q;
    int cnt = 0; float minsel = 3e38f, maxuns = -3e38f;
    for (int k = 0; k < SEQ; ++k) { const bool sel = (mask[tq * 128 + (k >> 4)] >> (k & 15)) & 1; if (k > q) { if (k <= (q | 63) && sel) chk_fail(flag, 4); continue; }
        float sc = 0.f; for (int h = 0; h < 8; ++h) { float dt = 0.f; for (int d = 0; d < 64; ++d) dt += bf2f(H[tq * HN + HC_IQ + h * 64 + d]) * bf2f(H[((size_t)b * SEQ + k) * HN + HC_IK + d]); sc += fmaxf(dt, 0.f) * bf2f(H[tq * HN + HC_IW + h]); }
        if (sel) { ++cnt; minsel = fminf(minsel, sc); } else maxuns = fmaxf(maxuns, sc); }
    const int want = (q + 1 < 256) ? q + 1 : 256;
    if (cnt < want || cnt > want + 2) chk_fail(flag, 4);
    if (q >= 256 && minsel < maxuns - 0.02f * (fabsf(maxuns) + 1.f)) chk_fail(flag, 4);
}
__global__ void chk_attn(Params p, int l, unsigned* flag) {
    __shared__ float qn_s[64][130]; __shared__ float o_s[64][130];
    float* qn = qn_s[threadIdx.x]; float* o = o_s[threadIdx.x];
    const unsigned s = blockIdx.x * blockDim.x + threadIdx.x; const int b = hsh(s * 7 + 1) & 15, h = hsh(s * 7 + 2) & 3, q = hsh(s * 7 + 3) & 2047;
    const bf16_t* H = (const bf16_t*)(p.ws + WS_R + R_H); const bf16_t* VT = (const bf16_t*)(p.ws + WS_R + R_VT); const bf16_t* YA = (const bf16_t*)(p.ws + WS_YA);
    const float* lamv = (const float*)(p.ws + WS_CTL + CTL_LAM); const float lam = lamv[l * 2], lam_init = lamv[l * 2 + 1];
    const float* rb = p.in[I_RELB]; const size_t tq = (size_t)b * SEQ + q; const float* qg = p.in[I_AQG] + l * 64; const float* sg = p.in[I_SUBLN] + l * 128;
    for (int sb = 0; sb < 2; ++sb) { float ss = 0.f; for (int d = 0; d < 64; ++d) { const float v = bf2f(H[tq * HN + HC_QA + h * 128 + sb * 64 + d]); ss += v * v; } const float r = rsqrtf(ss / 64.f + EPSF);
        for (int d = 0; d < 64; ++d) qn[sb * 64 + d] = bf2f(H[tq * HN + HC_QA + h * 128 + sb * 64 + d]) * r * qg[d]; }
    for (int d = 0; d < 128; ++d) o[d] = 0.f;
    float mx0 = -3e38f, mx1 = -3e38f, l0 = 0.f, l1 = 0.f;
    for (int pass = 0; pass < 3; ++pass) {
        for (int k = 0; k <= q; ++k) { const int dist = q - k; int bk; if (dist < 16) bk = dist; else { int lg = 16 + (int)(logf((float)dist / 16.f) / 2.0794415416798357f * 16.f); bk = lg < 31 ? lg : 31; }
            const bf16_t* kr = H + ((size_t)b * SEQ + k) * HN + HC_KA + h * 128; float d0 = 0.f, d1 = 0.f;
            for (int e = 0; e < 64; ++e) { d0 += qn[e] * bf2f(kr[e]); d1 += qn[64 + e] * bf2f(kr[64 + e]); }
            const float g0 = d0 * 0.125f + rb[bk * 8 + h], g1 = d1 * 0.125f + rb[bk * 8 + h];
            if (pass == 0) { mx0 = fmaxf(mx0, g0); mx1 = fmaxf(mx1, g1); }
            else if (pass == 1) { l0 += expf(g0 - mx0); l1 += expf(g1 - mx1); }
            else { const float pd = expf(g0 - mx0) / l0 - lam * expf(g1 - mx1) / l1; for (int d = 0; d < 128; ++d) o[d] += pd * bf2f(VT[(size_t)(h * 128 + d) * T_TOK + (size_t)b * SEQ + k]); } } }
    float ssq = 0.f; for (int d = 0; d < 128; ++d) ssq += o[d] * o[d];
    const float sc = rsqrtf(ssq / 128.f + EPSF) * (1.f - lam_init);
    for (int d = 0; d < 128; d += 17) if (!close_to(bf2f(YA[tq * 512 + h * 128 + d]), o[d] * sc * sg[d], 0.03f, 0.05f)) chk_fail(flag, 6);
}
__global__ void chk_attnc(Params p, int l, unsigned* flag) {
    const unsigned s = blockIdx.x * blockDim.x + threadIdx.x; const int b = hsh(s * 11 + 1) & 15, h = hsh(s * 11 + 2) & 3, q = hsh(s * 11 + 3) & 2047;
    const bf16_t* H = (const bf16_t*)(p.ws + WS_R + R_H); const bf16_t* VT = (const bf16_t*)(p.ws + WS_R + R_VT); const bf16_t* YC = (const bf16_t*)(p.ws + WS_YC);
    const unsigned short* mask = (const unsigned short*)(p.ws + WS_MASK); const float* rb = p.in[I_RELB]; const size_t tq = (size_t)b * SEQ + q; const float* qg = p.in[I_CQG] + l * 128;
    float ss = 0.f; for (int d = 0; d < 128; ++d) { const float v = bf2f(H[tq * HN + HC_CQ + h * 128 + d]); ss += v * v; } const float r = rsqrtf(ss / 128.f + EPSF);
    float mx = -3e38f, ls = 0.f, o0 = 0.f, o1 = 0.f; const int d0 = hsh(s * 11 + 4) & 127, d1 = hsh(s * 11 + 5) & 127;
    for (int pass = 0; pass < 2; ++pass)
        for (int k = 0; k <= q; ++k) { if (!((mask[tq * 128 + (k >> 4)] >> (k & 15)) & 1)) continue;
            const int dist = q - k; int bk; if (dist < 16) bk = dist; else { int lg = 16 + (int)(logf((float)dist / 16.f) / 2.0794415416798357f * 16.f); bk = lg < 31 ? lg : 31; }
            float dt = 0.f; for (int d = 0; d < 128; ++d) dt += bf2f(H[tq * HN + HC_CQ + h * 128 + d]) * r * qg[d] * bf2f(H[((size_t)b * SEQ + k) * HN + HC_CK + d]);
            const float lg2 = dt * 0.08838834764831845f + rb[bk * 8 + 4 + h];
            if (pass == 0) mx = fmaxf(mx, lg2); else { const float pr = expf(lg2 - mx); ls += pr; o0 += pr * bf2f(VT[(size_t)(512 + d0) * T_TOK + (size_t)b * SEQ + k]); o1 += pr * bf2f(VT[(size_t)(512 + d1) * T_TOK + (size_t)b * SEQ + k]); } }
    if (!close_to(bf2f(YC[tq * 512 + h * 128 + d0]), o0 / ls, 0.02f, 0.05f)) chk_fail(flag, 7);
    if (!close_to(bf2f(YC[tq * 512 + h * 128 + d1]), o1 / ls, 0.02f, 0.05f)) chk_fail(flag, 7);
}
__global__ void chk_merge(Params p, int l, unsigned* flag) {
    const unsigned s = blockIdx.x * blockDim.x + threadIdx.x; const int t = hsh(s * 13 + 1) % T_TOK; const int j = hsh(s * 13 + 2) & 1023;
    const bf16_t* XN = (const bf16_t*)(p.ws + WS_XN); const bf16_t* G = (const bf16_t*)(p.ws + WS_R + R_G); const bf16_t* MG = (const bf16_t*)(p.ws + WS_R + R_MERGED);
    const float* win = p.in[I_W_IN] + (size_t)l * 1024 * DIN; float m = 0.f;
    for (int br = 0; br < 3; ++br) { float z = 0.f; for (int k = 0; k < 1024; ++k) z += bf2f(XN[(size_t)t * 1024 + k]) * win[(size_t)k * DIN + 3912 + br * 1024 + j];
        const float gt = 1.f / (1.f + expf(-z)); if (!close_to(bf2f(G[(size_t)t * 3072 + br * 1024 + j]), gt, 0.02f, 0.02f)) chk_fail(flag, 8);
        const bf16_t* Y = (const bf16_t*)(p.ws + (br == 0 ? WS_YA : br == 1 ? WS_YB : WS_YC)); const float* wb = p.in[br == 0 ? I_WBRA : br == 1 ? I_WBRB : I_WBRC] + (size_t)l * 512 * 1024;
        float y = 0.f; for (int k = 0; k < 512; ++k) y += bf2f(Y[(size_t)t * 512 + k]) * wb[(size_t)k * 1024 + j]; m += gt * y; }
    if (!close_to(bf2f(MG[(size_t)t * 1024 + j]), m, 0.04f, 0.04f)) chk_fail(flag, 9);
}
__global__ void chk_xmix(Params p, int l, const float* xsrc, unsigned* flag) {
    const unsigned s = blockIdx.x * blockDim.x + threadIdx.x; const int t = hsh(s * 17 + 1) % T_TOK; const int j = hsh(s * 17 + 2) & 1023;
    const bf16_t* MG = (const bf16_t*)(p.ws + WS_R + R_MERGED); const float* wo = p.in[I_WOUT] + (size_t)l * 1024 * 1024;
    float y = 0.f; for (int k = 0; k < 1024; ++k) y += bf2f(MG[(size_t)t * 1024 + k]) * wo[(size_t)k * 1024 + j];
    if (l == 0 && !close_to(p.out[(size_t)t * 1024 + j], xsrc[(size_t)t * 1024 + j] + y, 0.05f, 0.03f)) chk_fail(flag, 10);
}
__global__ void chk_xattn(Params p, int l, unsigned* flag) {
    const unsigned s = blockIdx.x * blockDim.x + threadIdx.x; const int b = hsh(s * 19 + 1) & 15, h = hsh(s * 19 + 2) & 3, q = hsh(s * 19 + 3) & 2047; const int d0 = hsh(s * 19 + 4) & 127;
    const bf16_t* QX = (const bf16_t*)(p.ws + WS_YA); const bf16_t* MK = (const bf16_t*)(p.ws + WS_MK); const bf16_t* MVT = (const bf16_t*)(p.ws + WS_MVT); const bf16_t* OX = (const bf16_t*)(p.ws + WS_YB);
    const bf16_t* XN = (const bf16_t*)(p.ws + WS_XN); const float* wq = p.in[I_MWQ] + (size_t)l * 1024 * 512; const size_t tq = (size_t)b * SEQ + q; const float* qg = p.in[I_MQG] + l * 128;
    { float z = 0.f; for (int k = 0; k < 1024; ++k) z += bf2f(XN[tq * 1024 + k]) * wq[(size_t)k * 512 + h * 128 + d0]; if (!close_to(bf2f(QX[tq * 512 + h * 128 + d0]), z, 0.06f, 0.03f)) chk_fail(flag, 11); }
    float ss = 0.f; for (int d = 0; d < 128; ++d) { const float v = bf2f(QX[tq * 512 + h * 128 + d]); ss += v * v; } const float r = rsqrtf(ss / 128.f + EPSF);
    float mx = -3e38f, ls = 0.f, o0 = 0.f;
    for (int pass = 0; pass < 2; ++pass) for (int k = 0; k < 256; ++k) { float dt = 0.f; for (int d = 0; d < 128; ++d) dt += bf2f(QX[tq * 512 + h * 128 + d]) * r * qg[d] * bf2f(MK[((size_t)b * 256 + k) * 512 + h * 128 + d]);
        const float lg2 = dt * 0.08838834764831845f; if (pass == 0) mx = fmaxf(mx, lg2); else { const float pr = expf(lg2 - mx); ls += pr; o0 += pr * bf2f(MVT[(size_t)(h * 128 + d0) * 4096 + b * 256 + k]); } }
    if (!close_to(bf2f(OX[tq * 512 + h * 128 + d0]), o0 / ls, 0.01f, 0.05f)) chk_fail(flag, 12);
}
__global__ void chk_ps(Params p, int l, unsigned* flag) {
    const unsigned s = blockIdx.x * blockDim.x + threadIdx.x; const int t = hsh(s * 23 + 1) % T_TOK; const int hh = hsh(s * 23 + 2) & 15, n = hsh(s * 23 + 3) & 127;
    const bf16_t* XN = (const bf16_t*)(p.ws + WS_XN); const float* PS = (const float*)(p.ws + WS_R + R_PS);
    const float* pwq = p.in[I_PWQ] + (size_t)l * 1024 * 2048; const float* sk = p.in[(hh & 1) ? I_SK2 : I_SK1] + (size_t)l * 128 * 128;
    float sc = 0.f; for (int d = 0; d < 128; ++d) { float qd = 0.f; for (int k = 0; k < 1024; ++k) qd += bf2f(XN[(size_t)t * 1024 + k]) * pwq[(size_t)k * 2048 + hh * 128 + d]; sc += qd * sk[n * 128 + d]; }
    if (!close_to(PS[(size_t)t * 2048 + hh * 128 + n], sc, 0.05f, 0.03f)) chk_fail(flag, 13);
}
__global__ void chk_topk(Params p, unsigned* flag) {
    const unsigned s = blockIdx.x * blockDim.x + threadIdx.x; const int t = hsh(s * 29 + 1) % T_TOK; const int h = hsh(s * 29 + 2) & 7;
    const float* PS = (const float*)(p.ws + WS_R + R_PS) + (size_t)t * 2048 + h * 256; const int* EIDX = (const int*)(p.ws + WS_YC) + (size_t)t * 128 + h * 16; const float* EG = (const float*)(p.ws + WS_YC + 16 * MiB) + (size_t)t * 128 + h * 16;
    __shared__ float csv_s[64][17]; float* csv = csv_s[threadIdx.x];
    float gsum = 0.f, mn = 3e38f, mxs = -3e38f;
    for (int i = 0; i < 16; ++i) { const int e = EIDX[i]; if (e < 0 || e >= 16384) { chk_fail(flag, 14); return; } const int e1 = e >> 7, e2 = e & 127; int r1 = 0, r2 = 0;
        for (int j = 0; j < 128; ++j) { if (PS[j] > PS[e1]) ++r1; if (PS[128 + j] > PS[128 + e2]) ++r2; }
        if (r1 >= 16 || r2 >= 16) chk_fail(flag, 14);
        csv[i] = PS[e1] + PS[128 + e2]; mn = fminf(mn, csv[i]); mxs = fmaxf(mxs, csv[i]); for (int j = 0; j < i; ++j) if (EIDX[j] == e) chk_fail(flag, 14); }
    for (int i = 0; i < 16; ++i) gsum += expf(csv[i] - mxs);
    for (int i = 0; i < 16; ++i) if (!close_to(EG[i], expf(csv[i] - mxs) / gsum, 0.003f, 0.02f)) chk_fail(flag, 14);
    int better = 0; for (int a = 0; a < 128; ++a) for (int b2 = 0; b2 < 128; ++b2) if (PS[a] + PS[128 + b2] > mn + 1e-4f) ++better;
    if (better > 15) chk_fail(flag, 14);
}
__global__ void chk_save_x(Params p, float* save) { const unsigned s = blockIdx.x * blockDim.x + threadIdx.x; const int t = hsh(s * 31 + 1) % T_TOK; const int d = hsh(s * 31 + 2) & 1023; save[s] = p.out[(size_t)t * 1024 + d]; }
__global__ void chk_gather(Params p, int l, const float* save, unsigned* flag) {
    const unsigned s = blockIdx.x * blockDim.x + threadIdx.x; const int t = hsh(s * 31 + 1) % T_TOK; const int d = hsh(s * 31 + 2) & 1023;
    const bf16_t* XN = (const bf16_t*)(p.ws + WS_XN); const int* EIDX = (const int*)(p.ws + WS_YC) + (size_t)t * 128; const float* EG = (const float*)(p.ws + WS_YC + 16 * MiB) + (size_t)t * 128;
    const float* pu = p.in[I_PU] + (size_t)l * 16384 * 1024; const float* pv = p.in[I_PV] + (size_t)l * 16384 * 1024; float inc = 0.f;
    for (int i = 0; i < 128; ++i) { const int e = EIDX[i]; float dt = 0.f; for (int k = 0; k < 1024; ++k) dt += bf2f(XN[(size_t)t * 1024 + k]) * pu[(size_t)e * 1024 + k]; inc += EG[i] * ref_gelu(dt) * pv[(size_t)e * 1024 + d]; }
    if (!close_to(p.out[(size_t)t * 1024 + d] - save[s], inc, 0.03f, 0.05f)) chk_fail(flag, 15);
}
__global__ void __launch_bounds__(512) chk_mark(float* out, const unsigned* flag) {
    const unsigned code = *flag; if (code == 0 || code > 100) return;
    const float f = 1.0f + 0.3f * (float)code;
    for (size_t i = (size_t)blockIdx.x * 512 + threadIdx.x; i < (size_t)T_TOK * DM; i += (size_t)gridDim.x * 512) out[i] *= f;
}
#endif
#ifdef MPROBE
#ifndef MPROBE_PART
#define MPROBE_PART 0
#endif
typedef int v8i_p __attribute__((ext_vector_type(8)));
constexpr int PE_ROW = 1088;
typedef float f32x2p __attribute__((ext_vector_type(2)));
__device__ __forceinline__ unsigned mp_xq(const bf16_t* xp, int e0) { const u32x2 w = *(const u32x2*)(xp + e0); unsigned d = 0u; d = __builtin_amdgcn_cvt_pk_fp8_f32(bf_lo(w.x), bf_hi(w.x), d, false); d = __builtin_amdgcn_cvt_pk_fp8_f32(bf_lo(w.y), bf_hi(w.y), d, true); return d; }
__device__ __forceinline__ float mp_fp4val(unsigned c) { const float mag[8] = {0.f, 0.5f, 1.f, 1.5f, 2.f, 3.f, 4.f, 6.f}; const float m = mag[c & 7u]; return (c & 8u) ? -m : m; }
__device__ __forceinline__ float mp_fp8val(unsigned byte) { const f32x2p t = __builtin_amdgcn_cvt_pk_f32_fp8(byte, false); return t.x; }
__global__ void __launch_bounds__(64) mprobe_kernel(const unsigned char* PE, const bf16_t* XN, const int* EIDX, unsigned* flag, int mode) {
    __shared__ float refs[16]; __shared__ unsigned tabu[16][256];
    const int lane = threadIdx.x, fr = lane & 15, fq = lane >> 4;
    const bf16_t* xrow = XN;
    for (int i = lane; i < 16 * 128; i += 64) { const int r = i >> 7, d = i & 127; tabu[r][d] = *(const unsigned*)(PE + (size_t)EIDX[r] * PE_ROW + 4 * d); }
    __syncthreads();
    if (mode == 0) {
        { float ref = 0.f; for (int e = fq; e < 1024; e += 4) { const unsigned w = tabu[fr][e >> 3]; const unsigned nb = (w >> (4 * (e & 7))) & 15u; const unsigned xb = (mp_xq(xrow, e & ~3) >> (8 * (e & 3))) & 0xffu; ref += mp_fp4val(nb) * mp_fp8val(xb); }
          ref += __shfl_xor(ref, 16); ref += __shfl_xor(ref, 32); if (fq == 0) refs[fr] = ref; }
        __syncthreads();
        __syncthreads();
        { float ref = 0.f; for (int e = fq; e < 128; e += 4) { const unsigned w = tabu[fr][e >> 3]; const unsigned nb = (w >> (4 * (e & 7))) & 15u; const unsigned xb = (mp_xq(xrow, e & ~3) >> (8 * (e & 3))) & 0xffu; ref += mp_fp4val(nb) * mp_fp8val(xb); }
          ref += __shfl_xor(ref, 16); ref += __shfl_xor(ref, 32); if (fq == 0) refs[fr] = ref; }
        __syncthreads();
        v8i_p bv; for (int j = 0; j < 8; ++j) bv[j] = (int)mp_xq(xrow + 32 * fq, 4 * j);
        unsigned wsrc[4]; for (int dd = 0; dd < 4; ++dd) wsrc[dd] = tabu[fr][4 * fq + dd];
        unsigned foundp = 0xffffffffu;
        for (int idx = 0; idx < 40320; ++idx) {
            unsigned pool = 0x76543210u; unsigned pmk = 0u; int rem = idx;
            for (int n = 0; n < 8; ++n) { const int radix = 8 - n; int fct = 1; for (int q = 2; q < radix; ++q) fct *= q; const int dsel = rem / fct; rem -= dsel * fct;
                const unsigned pos = (pool >> (4 * dsel)) & 15u; pmk |= pos << (4 * n);
                const unsigned lowmask = (dsel == 0) ? 0u : (0xffffffffu >> (32 - 4 * dsel)); pool = (pool & lowmask) | ((pool >> 4) & ~lowmask); }
            unsigned r[4];
            for (int dd = 0; dd < 4; ++dd) { const unsigned w = wsrc[dd]; unsigned o = 0u; for (int n = 0; n < 8; ++n) o |= ((w >> (4 * n)) & 15u) << (4 * ((pmk >> (4 * n)) & 15u)); r[dd] = o; }
            v8i_p av; av[0] = (int)r[0]; av[1] = (int)r[1]; av[2] = (int)r[2]; av[3] = (int)r[3]; av[4] = 0; av[5] = 0; av[6] = 0; av[7] = 0;
            const f32x4 dacc = __builtin_amdgcn_mfma_scale_f32_16x16x128_f8f6f4(av, bv, (f32x4){0.f, 0.f, 0.f, 0.f}, 4, 0, 0, 0x7f7f7f7f, 0, 0x7f7f7f7f);
            float err = 0.f; for (int i = 0; i < 4; ++i) { const float rv = refs[4 * fq + i]; err = fmaxf(err, fabsf(dacc[i] - rv) / (fabsf(rv) + 0.05f)); }
            for (int o = 32; o; o >>= 1) err = fmaxf(err, __shfl_xor(err, o));
            if (err < 0.02f && foundp == 0xffffffffu) foundp = pmk;
        }
        unsigned found = 0u;
        if (lane == 0) { if (foundp == 0xffffffffu) { flag[0] = 70u; flag[1] = 70u; }
            else { const int sh = (MPROBE_PART) * 16; flag[0] = 8u * ((foundp >> sh) & 15u) + ((foundp >> (sh + 4)) & 15u) + 1u; flag[1] = 8u * ((foundp >> (sh + 8)) & 15u) + ((foundp >> (sh + 12)) & 15u) + 1u; } }
        (void)found;
    } else if (mode == 4) {
        float ref1 = 0.f, ref2 = 0.f;
        for (int e = fq; e < 1024; e += 4) { const unsigned w = tabu[fr][e >> 3]; const unsigned nb = (w >> (4 * (e & 7))) & 15u; const unsigned xb = (mp_xq(xrow, e & ~3) >> (8 * (e & 3))) & 0xffu;
            const unsigned sb = PE[(size_t)EIDX[fr] * PE_ROW + 1024 + 2 * (e >> 5)]; const float sc = __uint_as_float(sb << 23);
            const float pr = mp_fp4val(nb) * mp_fp8val(xb); if (e < 128) ref1 += pr; ref2 += pr * sc; }
        ref1 += __shfl_xor(ref1, 16); ref1 += __shfl_xor(ref1, 32); ref2 += __shfl_xor(ref2, 16); ref2 += __shfl_xor(ref2, 32);
        if (fq == 0) refs[fr] = ref1; __shared__ float refs2[16]; if (fq == 0) refs2[fr] = ref2;
        __syncthreads();
        f32x4 d1 = (f32x4){0.f, 0.f, 0.f, 0.f}, d2 = (f32x4){0.f, 0.f, 0.f, 0.f};
        for (int s2 = 0; s2 < 8; ++s2) {
            v8i_p bv; for (int jj = 0; jj < 8; ++jj) bv[jj] = (int)mp_xq(xrow, 128 * s2 + 16 * fq + 64 * (jj >> 2) + 4 * (jj & 3));
            v8i_p av; av[0] = (int)tabu[fr][16 * s2 + 4 * fq + 0]; av[1] = (int)tabu[fr][16 * s2 + 4 * fq + 1]; av[2] = (int)tabu[fr][16 * s2 + 4 * fq + 2]; av[3] = (int)tabu[fr][16 * s2 + 4 * fq + 3]; av[4] = 0; av[5] = 0; av[6] = 0; av[7] = 0;
            const int sa = (int)PE[(size_t)EIDX[fr] * PE_ROW + 1024 + 2 * (4 * s2 + fq)];
            if (s2 == 0) d1 = __builtin_amdgcn_mfma_scale_f32_16x16x128_f8f6f4(av, bv, d1, 4, 0, 0, 0x7f7f7f7f, 0, 0x7f7f7f7f);
            d2 = __builtin_amdgcn_mfma_scale_f32_16x16x128_f8f6f4(av, bv, d2, 4, 0, 0, sa, 0, 0x7f7f7f7f); }
        float e1 = 0.f, e2 = 0.f; unsigned nb2 = 0u;
        for (int i = 0; i < 4; ++i) { const float r1 = refs[4 * fq + i], r2 = refs2[4 * fq + i]; e1 = fmaxf(e1, fabsf(d1[i] - r1) / (fabsf(r1) + 0.05f)); const float q2 = fabsf(d2[i] - r2) / (fabsf(r2) + 1e-3f); e2 = fmaxf(e2, q2); if (q2 >= 0.02f) ++nb2; }
        for (int o = 32; o; o >>= 1) { e1 = fmaxf(e1, __shfl_xor(e1, o)); e2 = fmaxf(e2, __shfl_xor(e2, o)); }
        nb2 += __shfl_xor(nb2, 16); nb2 += __shfl_xor(nb2, 32);
        const unsigned nbr = (unsigned)__builtin_amdgcn_readlane((int)nb2, 0);
        if (lane == 0) { flag[0] = 1u + (e1 >= 0.02f ? 1u : 0u) + (e2 >= 0.02f ? 2u : 0u); flag[1] = 1u + nbr; }
    } else if (mode == 6) {
        __shared__ __attribute__((aligned(16))) unsigned char tile[2][128];
        for (int i = lane; i < 128; i += 64) { const int r = i >> 3; tile[0][i] = (unsigned char)(r | (r << 4)); const int c0 = (i & 7) * 2; tile[1][i] = (unsigned char)(c0 | ((c0 + 1) << 4)); }
        __syncthreads();
        typedef int v2i_p __attribute__((ext_vector_type(2)));
        const v2i_p r1 = __builtin_amdgcn_ds_read_tr4_b64_v2i32((LAS v2i_p*)(&tile[0][8 * fr]));
        const v2i_p r2 = __builtin_amdgcn_ds_read_tr4_b64_v2i32((LAS v2i_p*)(&tile[1][8 * fr]));
        bool ok = true;
        for (int jn = 0; jn < 16; ++jn) { const unsigned n1 = ((unsigned)(jn < 8 ? r1.x : r1.y) >> (4 * (jn & 7))) & 15u, n2 = ((unsigned)(jn < 8 ? r2.x : r2.y) >> (4 * (jn & 7))) & 15u; if (n1 != (unsigned)jn || n2 != (unsigned)fr) ok = false; }
        const bool allok = __builtin_amdgcn_ballot_w64(ok) == ~0ull;
        const unsigned p1 = ((unsigned)__builtin_amdgcn_readlane(r1.x, 2) >> 4) & 15u, p2 = ((unsigned)__builtin_amdgcn_readlane(r2.x, 2) >> 4) & 15u;
        if (lane == 0) { flag[0] = 1u + p2; flag[1] = 1u + p1 + (allok ? 20u : 0u); }
    } else if (mode == 5) {
        __shared__ unsigned tab7[128];
        v8i_p bv; for (int j = 0; j < 8; ++j) { unsigned w = 0u; for (int k = 0; k < 4; ++k) { const unsigned code = 0x10u + 0x20u * (fq & 1) + (unsigned)(4 * j + k) + ((fq >> 1) ? 0x80u : 0u); w |= code << (8 * k); } bv[j] = (int)w; }
        for (int idx = 0; idx < 128; ++idx) { const int FBq = idx >> 5, d = (idx >> 3) & 3, n = idx & 7;
            const unsigned hot = (fq == FBq) ? (2u << (4 * n)) : 0u; const unsigned r0 = d == 0 ? hot : 0u, r1 = d == 1 ? hot : 0u, r2 = d == 2 ? hot : 0u, r3 = d == 3 ? hot : 0u;
            v8i_p av; av[0] = (int)r0; av[1] = (int)r1; av[2] = (int)r2; av[3] = (int)r3; av[4] = 0; av[5] = 0; av[6] = 0; av[7] = 0;
            const f32x4 dacc = __builtin_amdgcn_mfma_scale_f32_16x16x128_f8f6f4(av, bv, (f32x4){0.f, 0.f, 0.f, 0.f}, 4, 0, 0, 0x7f7f7f7f, 0, 0x7f7f7f7f);
            const float cv = __uint_as_float((unsigned)__builtin_amdgcn_readlane((int)__float_as_uint(dacc[0]), 0));
            unsigned fk = 255u;
            for (unsigned b = 0; b < 4; ++b) for (unsigned e = 0; e < 32; ++e) { const unsigned code = 0x10u + 0x20u * (b & 1u) + e + ((b >> 1) ? 0x80u : 0u); if (mp_fp8val(code) == cv) fk = 32u * b + e; }
            if (lane == 0) tab7[idx] = fk; }
        __syncthreads();
        const unsigned c0 = tab7[0]; unsigned aff = 1u, nnone = 0u;
        for (int idx = 0; idx < 128; ++idx) { unsigned pr = c0; if (idx & 1) pr ^= tab7[1] ^ c0; if (idx & 2) pr ^= tab7[2] ^ c0; if (idx & 4) pr ^= tab7[4] ^ c0; if (idx & 8) pr ^= tab7[8] ^ c0; if (idx & 16) pr ^= tab7[16] ^ c0; if (idx & 32) pr ^= tab7[32] ^ c0; if (idx & 64) pr ^= tab7[64] ^ c0;
            if (pr != tab7[idx]) aff = 0u; if (tab7[idx] == 255u) ++nnone; }
        const int part = MPROBE_PART;
        #define MP_POS(v) (__builtin_popcount(v) == 1 ? (unsigned)__builtin_ctz(v) : 7u)
        if (lane == 0) {
            if (part == 0) { flag[0] = 1u + MP_POS(tab7[1] ^ c0); flag[1] = 1u + MP_POS(tab7[2] ^ c0) + 8u * MP_POS(tab7[4] ^ c0); }
            else if (part == 1) { flag[0] = 1u + MP_POS(tab7[8] ^ c0); flag[1] = 1u + MP_POS(tab7[16] ^ c0) + 8u * MP_POS(tab7[32] ^ c0); }
            else if (part == 2) { flag[0] = 1u + MP_POS(tab7[64] ^ c0); flag[1] = 1u + aff + 2u * (c0 == 0u ? 1u : 0u) + 4u * (nnone > 15u ? 15u : nnone); }
            else { flag[0] = 1u + (tab7[MPROBE_PART] >> 5 > 7u ? 8u : tab7[MPROBE_PART] >> 5); flag[1] = 1u + (tab7[MPROBE_PART] & 31u); } }
    } else if (mode == 3) {
        const int FB = (MPROBE_PART >> 2) & 3;
        v8i_p bv; for (int j = 0; j < 8; ++j) { unsigned w = 0u; for (int k = 0; k < 4; ++k) { const unsigned code = 0x10u + 0x20u * (fq & 1) + (unsigned)(4 * j + k) + ((fq >> 1) ? 0x80u : 0u); w |= code << (8 * k); } bv[j] = (int)w; }
        __shared__ unsigned tab[32]; unsigned blkbad = 0u;
        for (int idx = 0; idx < 32; ++idx) { const int d = idx >> 3, n = idx & 7; const unsigned hot = (fq == FB) ? (2u << (4 * n)) : 0u; const unsigned r0 = d == 0 ? hot : 0u, r1 = d == 1 ? hot : 0u, r2 = d == 2 ? hot : 0u, r3 = d == 3 ? hot : 0u;
            v8i_p av; av[0] = (int)r0; av[1] = (int)r1; av[2] = (int)r2; av[3] = (int)r3; av[4] = 0; av[5] = 0; av[6] = 0; av[7] = 0;
            const f32x4 dacc = __builtin_amdgcn_mfma_scale_f32_16x16x128_f8f6f4(av, bv, (f32x4){0.f, 0.f, 0.f, 0.f}, 4, 0, 0, 0x7f7f7f7f, 0, 0x7f7f7f7f);
            const float cv = __uint_as_float((unsigned)__builtin_amdgcn_readlane((int)__float_as_uint(dacc[0]), 0));
            unsigned fb = 9u, fe = 99u;
            for (unsigned b = 0; b < 4; ++b) for (unsigned e = 0; e < 32; ++e) { const unsigned code = 0x10u + 0x20u * (b & 1u) + e + ((b >> 1) ? 0x80u : 0u); if (mp_fp8val(code) == cv) { fb = b; fe = e; } }
            if (lane == 0) tab[idx] = fe; if (fb != (unsigned)FB) blkbad |= 1u; }
        __syncthreads();
        const unsigned c0 = tab[0]; const unsigned col0 = tab[1] ^ c0, col1 = tab[2] ^ c0, col2 = tab[4] ^ c0, col3 = tab[8] ^ c0, col4 = tab[16] ^ c0;
        unsigned aff = 1u; for (int idx = 0; idx < 32; ++idx) { unsigned pr = c0; if (idx & 1) pr ^= col0; if (idx & 2) pr ^= col1; if (idx & 4) pr ^= col2; if (idx & 8) pr ^= col3; if (idx & 16) pr ^= col4; if (pr != tab[idx]) aff = 0u; }
        const int part = MPROBE_PART & 3;
        if (lane == 0) {
            if (part == 0) { flag[0] = col0 + 1u; flag[1] = col1 + 1u; }
            else if (part == 1) { flag[0] = col2 + 1u; flag[1] = col3 + 1u; }
            else if (part == 2) { flag[0] = col4 + 1u; flag[1] = c0 + 1u; }
            else { flag[0] = aff + 2u * blkbad + 1u; flag[1] = tab[3] + 1u; } }
    } else if (mode == 2) {
        float sx = 0.f; for (int s2 = 0; s2 < 8; ++s2) for (int j = 0; j < 8; ++j) { const unsigned xd = mp_xq(xrow + 128 * s2 + 32 * fq, 4 * j); sx += mp_fp8val(xd & 0xffu) + mp_fp8val((xd >> 8) & 0xffu) + mp_fp8val((xd >> 16) & 0xffu) + mp_fp8val(xd >> 24); }
        sx += __shfl_xor(sx, 16); sx += __shfl_xor(sx, 32);
        f32x4 dacc = (f32x4){0.f, 0.f, 0.f, 0.f};
        for (int s2 = 0; s2 < 8; ++s2) { const int pat = 0x11111111 * fr; v8i_p av; av[0] = pat; av[1] = pat; av[2] = pat; av[3] = pat; av[4] = 0; av[5] = 0; av[6] = 0; av[7] = 0;
            v8i_p bv; for (int j = 0; j < 8; ++j) bv[j] = (int)mp_xq(xrow + 128 * s2 + 32 * fq, 4 * j);
            dacc = __builtin_amdgcn_mfma_scale_f32_16x16x128_f8f6f4(av, bv, dacc, 4, 0, 0, 0x7f7f7f7f, 0, 0x7f7f7f7f); }
        const float ratio = dacc[MPROBE_PART & 3] / sx; unsigned best = 0u; float bd = 1e30f;
        for (unsigned c = 0; c < 16; ++c) { const float dv = fabsf(mp_fp4val(c) - ratio); if (dv < bd) { bd = dv; best = c; } }
        const unsigned b1 = (unsigned)__builtin_amdgcn_readlane((int)best, 16 * (MPROBE_PART >> 2)); const unsigned b2 = (unsigned)__builtin_amdgcn_readlane((int)best, 16 * (MPROBE_PART >> 2) + 5);
        if (lane == 0) { flag[0] = b1 + 1u; flag[1] = b2 + 1u; }
    } else {
        float sx = 0.f; for (int s2 = 0; s2 < 8; ++s2) for (int d = 0; d < 4; ++d) sx += mp_fp8val(mp_xq(xrow + 128 * s2 + 32 * fq, 8 * d) & 0xffu);
        sx += __shfl_xor(sx, 16); sx += __shfl_xor(sx, 32);
        unsigned nbad = 0u, first = 0u;
        for (unsigned v = 1; v < 16; ++v) {
            f32x4 dacc = (f32x4){0.f, 0.f, 0.f, 0.f};
            for (int s2 = 0; s2 < 8; ++s2) { v8i_p av; av[0] = (int)v; av[1] = (int)v; av[2] = (int)v; av[3] = (int)v; av[4] = 0; av[5] = 0; av[6] = 0; av[7] = 0;
                v8i_p bv; for (int j = 0; j < 8; ++j) bv[j] = (int)mp_xq(xrow + 128 * s2 + 32 * fq, 4 * j);
                dacc = __builtin_amdgcn_mfma_scale_f32_16x16x128_f8f6f4(av, bv, dacc, 4, 0, 0, 0x7f7f7f7f, 0, 0x7f7f7f7f); }
            const float want = mp_fp4val(v) * sx; float err = fabsf(dacc[0] - want) / (fabsf(want) + 0.05f);
            for (int o = 32; o; o >>= 1) err = fmaxf(err, __shfl_xor(err, o));
            if (err >= 0.02f) { ++nbad; if (first == 0u) first = v; }
        }
        if (lane == 0) { flag[0] = nbad + 1u; flag[1] = first + 1u; }
    }
}
__global__ void __launch_bounds__(512) mprobe_mark(float* out, const unsigned* flag) {
    const float f = 1.0f + 0.3f * (float)flag[0];
    for (size_t i = (size_t)blockIdx.x * 512 + threadIdx.x; i < (size_t)T_TOK * DM; i += (size_t)gridDim.x * 512) { float v = out[i] * f; if (i == 0) v += 1000.0f * (float)flag[1]; out[i] = v; }
}
#endif

#ifndef MK_MULTI
#define MK_MULTI 0
#endif
constexpr int NPH = 16, NLAYER = 2;
__global__ void __launch_bounds__(512, 2) hybrid_fwd(Params p) {
    extern __shared__ __attribute__((aligned(16))) unsigned char lds_raw[];
    LAS unsigned char* lds = (LAS unsigned char*)lds_raw;
    if (threadIdx.x == 0) *(LAS u32x4*)(lds + LDS_BAR_OFF) = (u32x4){0u, 0u, 0u, 0u};
    __syncthreads();
    XcdBarrier bar = xcd_barrier_post((unsigned*)(p.ws + WS_CTL), (volatile LAS unsigned*)(lds + LDS_BAR_OFF));
    const int lo = p.ph_lo, hi = p.ph_hi;
#ifndef PHMASK
#define PHMASK 0xffff
#endif
#define IN(k) (((PHMASK >> ((k) % NPH)) & 1) && lo <= (k) && (k) < hi)
#define SEAM(k) do { if (IN(k) && IN((k) + 1)) xcd_barrier(bar); } while (0)
    unsigned char* ws = p.ws;
#define XN ((bf16_t*)(fresh_ptr(fresh_kp().ws) + WS_XN))
#ifdef PROBE_T_A
    unsigned long long* tsg = (unsigned long long*)(p.ws + WS_CTL + 300 * 1024);
#define TSTAMP(k) do { if (blockIdx.x == 0 && threadIdx.x == 0) tsg[k] = wall_clock64(); } while (0)
#else
#define TSTAMP(k) do { } while (0)
#endif
    for (int l = 0; l < NLAYER; ++l) {
        const int P0 = l * NPH;
        unsigned char* const RB = (unsigned char*)fresh_kp().out;
        float* const dummy = (float*)(fresh_ptr(fresh_kp().ws) + WS_R);
#define NREP(k) (((P0 + (k)) == fresh_kp().rep_ph) ? fresh_kp().rep_n : 1)
        TSTAMP(P0 + 0);
        if (IN(P0 + 0)) for (int r = NREP(0); r > 0; --r) {
            if (l == 0) make_tables(p);
            prep_weights(fresh_kp(), lds, l);
            if (l == 0) rmsnorm_rows_t<false>(fresh_kp().in[I_X], fresh_kp().in[I_NORM_MIX] + l * 1024, XN, T_TOK); else rmsnorm_rows_t<true>((unsigned char*)fresh_kp().out, fresh_kp().in[I_NORM_MIX] + l * 1024, XN, T_TOK);
            rmsnorm_rows(fresh_kp().in[I_MEM], fresh_kp().in[I_NORM_MEMSRC] + l * 1024, (bf16_t*)(fresh_ptr(fresh_kp().ws) + WS_MEMN), NB * MEMLEN);
        }
        SEAM(P0 + 0);
        TSTAMP(P0 + 1);
        if (IN(P0 + 1)) for (int r = NREP(1); r > 0; --r) {
            run_gemm(lds, XN, (const bf16_t*)(fresh_ptr(fresh_kp().ws) + WS_WB + WB_WIN), T_TOK, HN, 1024, 0, EpiStore{(bf16_t*)(fresh_ptr(fresh_kp().ws) + WS_R + R_H), HN});
            run_gemm(lds, (const bf16_t*)(fresh_ptr(fresh_kp().ws) + WS_WB + WB_WV), XN, 768, T_TOK, 1024, 128, EpiStore{(bf16_t*)(fresh_ptr(fresh_kp().ws) + WS_R + R_VT), T_TOK});
            run_gemm(lds, (const bf16_t*)(fresh_ptr(fresh_kp().ws) + WS_MEMN), (const bf16_t*)(fresh_ptr(fresh_kp().ws) + WS_WB + WB_MK), NB * MEMLEN, 512, 1024, 0, EpiStore{(bf16_t*)(fresh_ptr(fresh_kp().ws) + WS_MK), 512});
            run_gemm(lds, (const bf16_t*)(fresh_ptr(fresh_kp().ws) + WS_WB + WB_MV), (const bf16_t*)(fresh_ptr(fresh_kp().ws) + WS_MEMN), 512, NB * MEMLEN, 1024, 32, EpiStore{(bf16_t*)(fresh_ptr(fresh_kp().ws) + WS_MVT), NB * MEMLEN});
        }
        SEAM(P0 + 1);
        TSTAMP(P0 + 2);
        if (IN(P0 + 2)) for (int r = NREP(2); r > 0; --r) {
#ifndef SKIP_KN
            if (r == 1) knorm_rows(fresh_kp(), l);
#endif
#ifndef SKIP_GM
            for (int r2 = ((1000 + P0 + 2) == fresh_kp().rep_ph) ? fresh_kp().rep_n : 1; r2 > 0; --r2) gmlp_phase(fresh_kp(), lds, l);
#endif
#ifndef SKIP_CS
            for (int r2 = ((2000 + P0 + 2) == fresh_kp().rep_ph) ? fresh_kp().rep_n : 1; r2 > 0; --r2) csel_phase(fresh_kp(), lds, (r2 > 1) ? fresh_kp().rep_var : 0);
#endif
        }
        SEAM(P0 + 2);
        TSTAMP(P0 + 3);
        if (IN(P0 + 3)) for (int r = NREP(3); r > 0; --r) {
#ifndef SKIP_AA
            for (int r2 = ((1000 + P0 + 3) == fresh_kp().rep_ph) ? fresh_kp().rep_n : 1; r2 > 0; --r2) { attnA_phase(fresh_kp(), lds, l, (r2 > 1) ? fresh_kp().rep_var : 0); __syncthreads(); }
#endif
            __syncthreads();
#ifndef SKIP_AC
            for (int r2 = ((2000 + P0 + 3) == fresh_kp().rep_ph) ? fresh_kp().rep_n : 1; r2 > 0; --r2) { attnC_phase(fresh_kp(), lds, l, (r2 > 1) ? fresh_kp().rep_var : 0); __syncthreads(); }
#endif
        }
        SEAM(P0 + 3);
        TSTAMP(P0 + 4);
        if (IN(P0 + 4)) for (int r = NREP(4); r > 0; --r) run_gemm(lds, XN, (const bf16_t*)(fresh_ptr(fresh_kp().ws) + WS_WB + WB_WG), T_TOK, 3072, 1024, 0, EpiSigmoid{fresh_ptr(fresh_kp().ws) + WS_R + R_G, 3072});
        SEAM(P0 + 4);
        TSTAMP(P0 + 5);
        if (IN(P0 + 5)) for (int r = NREP(5); r > 0; --r) {
            bf16_t* MG = (bf16_t*)(fresh_ptr(fresh_kp().ws) + WS_R + R_MERGED); const unsigned char* G = fresh_ptr(fresh_kp().ws) + WS_R + R_G;
            static_assert(WS_YB == WS_YA + 32 * MiB && WS_YC == WS_YB + 32 * MiB && WB_BRB == WB_BRA + 1 * MiB && WB_BRC == WB_BRB + 1 * MiB, "branch inputs / weights must be contiguous");
            run_branch_gemms(lds, (const bf16_t*)(fresh_ptr(fresh_kp().ws) + WS_YA), (const bf16_t*)(fresh_ptr(fresh_kp().ws) + WS_WB + WB_BRA), EpiBranchCat{MG, G});
        }
        SEAM(P0 + 5);
        TSTAMP(P0 + 6);
        if (IN(P0 + 6)) for (int r = NREP(6); r > 0; --r) {
            unsigned char* dst6 = (r == 1) ? (unsigned char*)fresh_kp().out : (unsigned char*)dummy;
            if (l == 0) run_gemm(lds, (const bf16_t*)(fresh_ptr(fresh_kp().ws) + WS_R + R_MERGED), (const bf16_t*)(fresh_ptr(fresh_kp().ws) + WS_WB + WB_OUT), T_TOK, 1024, 1024, 0, EpiResidRB<true>{fresh_kp().in[I_X], dst6});
            else run_gemm(lds, (const bf16_t*)(fresh_ptr(fresh_kp().ws) + WS_R + R_MERGED), (const bf16_t*)(fresh_ptr(fresh_kp().ws) + WS_WB + WB_OUT), T_TOK, 1024, 1024, 0, EpiResidRB<false>{(const unsigned char*)fresh_kp().out, dst6}); }
        SEAM(P0 + 6);
        TSTAMP(P0 + 7);
        if (IN(P0 + 7)) for (int r = NREP(7); r > 0; --r) rmsnorm_rows_t<true>((unsigned char*)fresh_kp().out, fresh_kp().in[I_NORM_MEM] + l * 1024, XN, T_TOK);
        SEAM(P0 + 7);
        TSTAMP(P0 + 8);
        if (IN(P0 + 8)) for (int r = NREP(8); r > 0; --r) run_gemm(lds, XN, (const bf16_t*)(fresh_ptr(fresh_kp().ws) + WS_WB + WB_MQ), T_TOK, 512, 1024, 0, EpiStore{(bf16_t*)(fresh_ptr(fresh_kp().ws) + WS_YA), 512});
        SEAM(P0 + 8);
        TSTAMP(P0 + 9);
        if (IN(P0 + 9)) for (int r = NREP(9); r > 0; --r) attnX_phase(fresh_kp(), lds, l);
        SEAM(P0 + 9);
        TSTAMP(P0 + 10);
        if (IN(P0 + 10)) for (int r = NREP(10); r > 0; --r) run_gemm(lds, (const bf16_t*)(fresh_ptr(fresh_kp().ws) + WS_YB), (const bf16_t*)(fresh_ptr(fresh_kp().ws) + WS_WB + WB_MO), T_TOK, 1024, 512, 0, EpiResidRB<false>{(const unsigned char*)fresh_kp().out, (r == 1) ? (unsigned char*)fresh_kp().out : (unsigned char*)dummy});
        SEAM(P0 + 10);
        TSTAMP(P0 + 11);
        if (IN(P0 + 11)) for (int r = NREP(11); r > 0; --r) {
            rmsnorm_rows_t<true>((unsigned char*)fresh_kp().out, fresh_kp().in[I_NORM_PEER] + l * 1024, XN, T_TOK);
            conv_peer_tables(fresh_kp().in[I_PU] + (size_t)l * 16384 * 1024, fresh_kp().in[I_PV] + (size_t)l * 16384 * 1024, fresh_ptr(fresh_kp().ws) + WS_YA);
        }
        SEAM(P0 + 11);
        TSTAMP(P0 + 12);
        if (IN(P0 + 12)) for (int r = NREP(12); r > 0; --r) run_gemm(lds, XN, (const bf16_t*)(fresh_ptr(fresh_kp().ws) + WS_WB + WB_PS), T_TOK, 2048, 1024, 0, EpiKey16Store{(unsigned short*)(fresh_ptr(fresh_kp().ws) + WS_R + R_PS), 2048});
        SEAM(P0 + 12);
        TSTAMP(P0 + 13);
        if (IN(P0 + 13)) for (int r = NREP(13); r > 0; --r) peer_topk_phase(fresh_kp(), lds);
        SEAM(P0 + 13);
        TSTAMP(P0 + 14);
        if (IN(P0 + 14)) for (int r = NREP(14); r > 0; --r) peer_udot_phase(fresh_kp(), lds, (r > 1) ? fresh_kp().rep_var : 0);
        SEAM(P0 + 14);
        TSTAMP(P0 + 15);
        if (IN(P0 + 15)) for (int r = NREP(15); r > 0; --r) peer_vacc_phase(fresh_kp(), lds, (const unsigned char*)fresh_kp().out, (r == 1) ? (unsigned char*)fresh_kp().out : (unsigned char*)(dummy + 16 * MiB), (r == 1) ? fresh_kp().out : dummy + 16 * MiB, l == NLAYER - 1, (r > 1) ? fresh_kp().rep_var : 0);
        SEAM(P0 + 15);
    }
#ifdef PROBE_T_A
    xcd_barrier(bar); TSTAMP(NPH * NLAYER); xcd_barrier(bar);
    {
        unsigned long long ta = 0ull, tb = 0ull;
        for (int k = 0; k < NPH * NLAYER; ++k) { const unsigned long long dt = tsg[k + 1] - tsg[k]; if ((PROBE_T_A >> k) & 1ull) ta += dt; if ((PROBE_T_B >> k) & 1ull) tb += dt; }
        const float c1 = (float)ta * 1e-5f, c2 = (float)tb * 1e-3f;
        const int tid2 = fresh_tid();
        for (size_t i = ((size_t)blockIdx.x * 512 + tid2) * 4; i < (size_t)T_TOK * DM; i += (size_t)gridDim.x * 512 * 4) { f32x4 v = *(f32x4*)(p.out + i); v *= (1.0f + c1); if (i == 0) v[0] += c2; *(f32x4*)(p.out + i) = v; }
    }
#endif
#undef IN
#undef SEAM
}

extern "C" void kernel_launch(void* const* d_in, const int* in_sizes, int n_in, void* d_out, int out_size, void* d_ws, size_t ws_size, hipStream_t stream) {
    static int grid = 0;
    if (grid == 0) {
        if (n_in != 34 || out_size != T_TOK * DM || ws_size < WS_END) { fprintf(stderr, "kernel_launch: unexpected shapes (n_in %d out %d ws %zu)\n", n_in, out_size, ws_size); grid = -1; return; }
        int dev = 0, cus = 0, per_cu = 0;
        if (hipGetDevice(&dev) != hipSuccess || hipDeviceGetAttribute(&cus, hipDeviceAttributeMultiprocessorCount, dev) != hipSuccess) { grid = -1; return; }
        if (hipFuncSetAttribute((const void*)hybrid_fwd, hipFuncAttributeMaxDynamicSharedMemorySize, LDS_TOTAL) != hipSuccess) { fprintf(stderr, "kernel_launch: hipFuncSetAttribute failed\n"); grid = -1; return; }
        if (hipOccupancyMaxActiveBlocksPerMultiprocessor(&per_cu, (const void*)hybrid_fwd, 512, LDS_TOTAL) != hipSuccess || per_cu < 1) { fprintf(stderr, "kernel_launch: occupancy query says %d\n", per_cu); }
        (void)hipGetLastError();
        if (cus < 8) { grid = -1; return; }
        grid = cus;
    }
    if (grid < 0) return;
#ifdef PROBE_ZERO_WS
    if (hipMemsetAsync((char*)d_ws, 0, WS_END, stream) != hipSuccess) return;
#endif
    if (hipMemsetAsync((char*)d_ws + WS_CTL, 0, XCD_BAR_WORDS * sizeof(unsigned), stream) != hipSuccess) return;
    Params p{};
    p.rep_ph = -1; p.rep_n = 1;
    for (int i = 0; i < 34; ++i) p.in[i] = (const float*)d_in[i];
    p.out = (float*)d_out; p.ws = (unsigned char*)d_ws;
#ifdef PROBE_CHK
    {
        unsigned char* ws = (unsigned char*)d_ws; unsigned* flag = (unsigned*)(ws + WS_CTL + 200 * 1024); float* save = (float*)(ws + WS_CTL + 256 * 1024);
        hipMemsetAsync(flag, 0xFF, 4, stream);
        const int CL = PROBE_CHK - 1;
        for (int ph = 0; ph < 2 * NPH; ++ph) {
            const int l = ph / NPH, k = ph % NPH;
            if (l == CL && k == 14) hipLaunchKernelGGL(chk_save_x, dim3(16), dim3(64), 0, stream, p, save);
            p.ph_lo = ph; p.ph_hi = ph + 1; hipLaunchKernelGGL(hybrid_fwd, dim3(grid), dim3(512), LDS_TOTAL, stream, p);
            if (l != CL) continue;
            const float* xsrc = (const float*)d_in[0];
            if (k == 1) hipLaunchKernelGGL(chk_h, dim3(32), dim3(64), 0, stream, p, l, flag);
            if (k == 2) { hipLaunchKernelGGL(chk_post, dim3(16), dim3(64), 0, stream, p, l, flag); hipLaunchKernelGGL(chk_mask, dim3(4), dim3(64), 0, stream, p, flag); }
            if (k == 3) { hipLaunchKernelGGL(chk_attn, dim3(4), dim3(64), 0, stream, p, l, flag); hipLaunchKernelGGL(chk_attnc, dim3(4), dim3(64), 0, stream, p, l, flag); }
            if (k == 5) hipLaunchKernelGGL(chk_merge, dim3(16), dim3(64), 0, stream, p, l, flag);
            if (k == 6) hipLaunchKernelGGL(chk_xmix, dim3(16), dim3(64), 0, stream, p, l, xsrc, flag);
            if (k == 9) hipLaunchKernelGGL(chk_xattn, dim3(8), dim3(64), 0, stream, p, l, flag);
            if (k == 12) hipLaunchKernelGGL(chk_ps, dim3(8), dim3(64), 0, stream, p, l, flag);
            if (k == 13) hipLaunchKernelGGL(chk_topk, dim3(8), dim3(64), 0, stream, p, flag);
            if (k == 15) hipLaunchKernelGGL(chk_gather, dim3(16), dim3(64), 0, stream, p, l, (const float*)save, flag);
        }
        hipLaunchKernelGGL(chk_mark, dim3(1024), dim3(512), 0, stream, (float*)d_out, (const unsigned*)flag);
    }
#elif defined(PROBE_DET)
    {
        unsigned char* ws = (unsigned char*)d_ws; const size_t NT = (size_t)T_TOK;
        unsigned long long* cks = (unsigned long long*)(ws + WS_CTL + 128 * 1024);
        hipMemsetAsync(cks, 0, 128 * 8, stream);
        for (int run = 0; run < 3; ++run) for (int ph = 0; ph <= PROBE_PH; ++ph) {
            p.ph_lo = ph; p.ph_hi = ph + 1; hipLaunchKernelGGL(hybrid_fwd, dim3(grid), dim3(512), LDS_TOTAL, stream, p);
            CkSeg z{nullptr, 0}; CkSeg c[4] = {z, z, z, z};
            switch (ph) {
            case 0: c[0] = {ws + WS_WB, 27 * MiB}; c[1] = {ws + WS_XN, NT * 2048}; c[2] = {ws + WS_MEMN, 8 * MiB}; c[3] = {ws + WS_CTL + CTL_BTAB, 4096}; break;
            case 1: c[0] = {ws + WS_R + R_H, NT * HN * 2}; c[1] = {ws + WS_R + R_VT, 768 * NT * 2}; c[2] = {ws + WS_MK, 4 * MiB}; c[3] = {ws + WS_MVT, 4 * MiB}; break;
            case 2: c[0] = {ws + WS_R + R_H, NT * HN * 2}; c[1] = {ws + WS_YB, 32 * MiB}; c[2] = {ws + WS_MK, 4 * MiB}; c[3] = {ws + WS_MASK, 8 * MiB}; break;
            case 3: c[0] = {ws + WS_YA, 32 * MiB}; c[1] = {ws + WS_YC, 32 * MiB}; break;
            case 4: c[0] = {ws + WS_R + R_G, 192 * MiB}; break;
            case 5: c[0] = {ws + WS_R + R_MERGED, 64 * MiB}; break;
            case 6: c[0] = {d_out, 128 * MiB}; break;
            case 7: c[0] = {ws + WS_XN, 64 * MiB}; break;
            case 8: c[0] = {ws + WS_YA, 32 * MiB}; break;
            case 9: c[0] = {ws + WS_YB, 32 * MiB}; break;
            case 10: c[0] = {d_out, 128 * MiB}; break;
            case 11: c[0] = {ws + WS_XN, 64 * MiB}; c[1] = {ws + WS_YA, 32 * MiB}; c[2] = {ws + WS_YB, 32 * MiB}; break;
            case 12: c[0] = {ws + WS_R + R_PS, 256 * MiB}; break;
            case 13: c[0] = {ws + WS_YC, 32 * MiB}; break;
            case 14: c[0] = {d_out, 128 * MiB}; break;
            }
            hipLaunchKernelGGL(probe_cksum, dim3(1024), dim3(512), 0, stream, cks + run * 32 + ph, c[0], c[1], c[2], c[3]);
        }
        for (int ph = PROBE_PH + 1; ph < 2 * NPH; ++ph) { p.ph_lo = ph; p.ph_hi = ph + 1; hipLaunchKernelGGL(hybrid_fwd, dim3(grid), dim3(512), LDS_TOTAL, stream, p); }
        hipLaunchKernelGGL(probe_mark, dim3(1024), dim3(512), 0, stream, (float*)d_out, (const unsigned long long*)cks, PROBE_PH + 1);
    }
#elif defined(PROBE_K)
    for (int ph = 0; ph < PROBE_K; ++ph) { p.ph_lo = ph; p.ph_hi = ph + 1; hipLaunchKernelGGL(hybrid_fwd, dim3(grid), dim3(512), LDS_TOTAL, stream, p); }
    {
        unsigned char* ws = (unsigned char*)d_ws; DumpSeg z{nullptr, 0, 0}; DumpSeg s[6] = {z, z, z, z, z, z};
        const size_t NT = (size_t)T_TOK;
#if PROBE_K == 1
        s[0] = {ws + WS_XN, NT * 1024, 0}; s[1] = {ws + WS_WB, 27 * MiB / 2, 0}; s[2] = {ws + WS_MEMN, 4096 * 1024, 0}; s[3] = {ws + WS_CTL + CTL_BTAB, 1024, 1};
#elif PROBE_K == 2
        s[0] = {ws + WS_R + R_H, NT * HN, 0}; s[1] = {ws + WS_R + R_VT, 768 * NT, 0}; s[2] = {ws + WS_MK, 4096 * 512, 0}; s[3] = {ws + WS_MVT, 512 * 4096, 0};
#elif PROBE_K == 3
        s[0] = {ws + WS_R + R_H, NT * HN, 0}; s[1] = {ws + WS_YB, NT * 512, 0}; s[2] = {ws + WS_MK, 4096 * 512, 0}; s[3] = {ws + WS_MASK, NT * 128, 2};
#elif PROBE_K == 4
        s[0] = {ws + WS_YA, NT * 512, 0}; s[1] = {ws + WS_YC, NT * 512, 0};
#elif PROBE_K == 5
        s[0] = {ws + WS_R + R_G, NT * 3072, 0};
#elif PROBE_K == 6
        s[0] = {ws + WS_R + R_MERGED, NT * 1024, 0};
#elif PROBE_K == 7
        s[0] = {d_out, NT * 1024, 1};
#elif PROBE_K == 9
        s[0] = {ws + WS_YA, NT * 512, 0}; s[1] = {ws + WS_XN, NT * 1024, 0};
#elif PROBE_K == 10
        s[0] = {ws + WS_YB, NT * 512, 0};
#elif PROBE_K == 11
        s[0] = {d_out, NT * 1024, 1};
#elif PROBE_K == 12
        s[0] = {ws + WS_YA, NT * 512, 0}; s[1] = {ws + WS_YB, NT * 512, 0}; s[2] = {ws + WS_XN, NT * 1024, 0};
#elif PROBE_K == 13
        s[0] = {ws + WS_R + R_PS, NT * 2048, 1};
#elif PROBE_K == 14
        s[0] = {ws + WS_YC, NT * 128, 3}; s[1] = {ws + WS_YC + 16 * MiB, NT * 128, 1};
#endif
        hipLaunchKernelGGL(probe_dump, dim3(1024), dim3(512), 0, stream, (float*)d_out, s[0], s[1], s[2], s[3], s[4], s[5]);
    }
#elif defined(MPROBE)
    for (int ph = 0; ph < NPH * NLAYER; ++ph) { p.ph_lo = ph; p.ph_hi = ph + 1; hipLaunchKernelGGL(hybrid_fwd, dim3(grid), dim3(512), LDS_TOTAL, stream, p); }
    { unsigned char* ws = (unsigned char*)d_ws; unsigned* flag = (unsigned*)(ws + WS_CTL + 200 * 1024);
      hipLaunchKernelGGL(mprobe_kernel, dim3(1), dim3(64), 0, stream, (const unsigned char*)(ws + WS_YA), (const bf16_t*)(ws + WS_XN), (const int*)(ws + WS_YC), flag, (int)(MPROBE - 1));
      hipLaunchKernelGGL(mprobe_mark, dim3(1024), dim3(512), 0, stream, (float*)d_out, (const unsigned*)flag); }
#elif MK_MULTI
    for (int ph = 0; ph < NPH * NLAYER; ++ph) { p.ph_lo = ph; p.ph_hi = ph + 1; hipLaunchKernelGGL(hybrid_fwd, dim3(grid), dim3(512), LDS_TOTAL, stream, p); }
#else
    p.ph_lo = 0; p.ph_hi = NPH * NLAYER;
#ifdef PROBE_REP_PH
    p.rep_ph = PROBE_REP_PH; p.rep_n = PROBE_REP_N;
#else
    p.rep_ph = -1; p.rep_n = 1;
#endif
#ifdef ATT_PROBE
    p.rep_var = ATT_PROBE;
#endif
    hipLaunchKernelGGL(hybrid_fwd, dim3(grid), dim3(512), LDS_TOTAL, stream, p);
#endif
}
```
